# Optimizing an MI355X kernel written in HIP

```python
import math
import jax
import jax.numpy as jnp
from jax import lax
import numpy as np


D_MODEL = 1024
BATCH = 8
SEQ = 4096
DEPTH = 2
DEC_BATCH = 2
DEC_SEQ = 16384
PAST_LEN = 128

N_META = 16
GRID_W = 64
HEAD_DIM = 64
D_MIX = 2 * D_MODEL

SSD_HEADS = 16
SSD_HEAD_DIM = 64
SSD_INNER = SSD_HEADS * SSD_HEAD_DIM
SSD_GROUPS = 2
SSD_STATE = 128
SSD_XBC = SSD_INNER + 2 * SSD_GROUPS * SSD_STATE
SSD_CONV = 5
SSD_CHUNK = 128

WIN_Q_HEADS = 8
WIN_KV_HEADS = 2
WIN_RADIUS = 128
WIN_BLOCK = 128
ROPE_THETA = 500000.0
ROPE_DIM = HEAD_DIM // 4

NA_HEADS = 8
NA_KR = 8
NA_KC = 16
NA_QC = 16
NA_KCB = 2 * NA_KC

D_FF = 2816
FFN_CONV = 3
EPS = 1e-6

D_IN_PROJ = SSD_INNER + SSD_XBC + 2 * SSD_HEADS + (WIN_Q_HEADS + 2 * WIN_KV_HEADS) * HEAD_DIM + 3 * NA_HEADS * HEAD_DIM

kernel_name = 'hybrid_bidir_ssd_window_natten_encoder'


def _rmsnorm(x, w):
    xf = x.astype(jnp.float32)
    y = xf * lax.rsqrt(jnp.mean(xf * xf, axis=-1, keepdims=True) + EPS)
    return (y * w.astype(jnp.float32)).astype(x.dtype)


def _depthwise_conv(x, w, b):
    k_w = w.shape[0]
    pad = k_w // 2
    n = x.shape[1]
    xp = jnp.pad(x, ((0, 0), (pad, pad), (0, 0)))
    y = xp[:, 0:n] * w[0] + b
    for j in range(1, k_w):
        y = y + xp[:, j:j + n] * w[j]
    return y


def _partial_rope(x, pos):
    half = ROPE_DIM // 2
    inv = jnp.power(ROPE_THETA, -jnp.arange(half, dtype=jnp.float32) / half)
    ang = pos.astype(jnp.float32)[:, None] * inv[None, :]
    cos = jnp.cos(ang)[None, :, None, :]
    sin = jnp.sin(ang)[None, :, None, :]
    xr = x[..., :ROPE_DIM].astype(jnp.float32)
    x1, x2 = xr[..., :half], xr[..., half:]
    rot = jnp.concatenate([x1 * cos - x2 * sin, x2 * cos + x1 * sin], axis=-1).astype(x.dtype)
    return jnp.concatenate([rot, x[..., ROPE_DIM:]], axis=-1)


def _split_in_proj(u):
    sizes = [SSD_INNER, SSD_XBC, 2 * SSD_HEADS, WIN_Q_HEADS * HEAD_DIM, WIN_KV_HEADS * HEAD_DIM,
             WIN_KV_HEADS * HEAD_DIM, NA_HEADS * HEAD_DIM, NA_HEADS * HEAD_DIM, NA_HEADS * HEAD_DIM]
    idx = np.cumsum(sizes)[:-1].tolist()
    return jnp.split(u, idx, axis=-1)


def _ssd_scan(xh, dt, a_neg, bm, cm):
    bsz, t_len, n_heads, p_dim = xh.shape
    n_grp, n_state = bm.shape[-2], bm.shape[-1]
    rep = n_heads // n_grp
    q = SSD_CHUNK
    nc = t_len // q
    f32 = jnp.float32
    x = (xh.astype(f32) * dt[..., None]).reshape(bsz, nc, q, n_grp, rep, p_dim)
    a = (dt * a_neg).reshape(bsz, nc, q, n_grp, rep)
    b = bm.astype(f32).reshape(bsz, nc, q, n_grp, n_state)
    c = cm.astype(f32).reshape(bsz, nc, q, n_grp, n_state)
    acs = jnp.cumsum(a, axis=2)
    tri = jnp.tril(jnp.ones((q, q), dtype=bool))[:, :, None, None]
    decay = jnp.exp(jnp.where(tri, acs[:, :, :, None] - acs[:, :, None, :], -jnp.inf))
    cb = jnp.einsum('bclgn,bcsgn->bclsg', c, b)
    y_diag = jnp.einsum('bclsgr,bcsgrp->bclgrp', cb[..., None] * decay, x)
    decay_states = jnp.exp(acs[:, :, -1:] - acs)
    states = jnp.einsum('bclgn,bclgrp->bcgrpn', b, x * decay_states[..., None])
    chunk_decay = jnp.exp(acs[:, :, -1])

    def step(h, inp):
        s_c, d_c = inp
        return d_c[..., None, None] * h + s_c, h

    h0 = jnp.zeros((bsz, n_grp, rep, p_dim, n_state), f32)
    _, h_in = lax.scan(step, h0, (jnp.moveaxis(states, 1, 0), jnp.moveaxis(chunk_decay, 1, 0)))
    h_in = jnp.moveaxis(h_in, 0, 1)
    y_off = jnp.einsum('bclgn,bcgrpn->bclgrp', c, h_in) * jnp.exp(acs)[..., None]
    return (y_diag + y_off).reshape(bsz, t_len, n_heads, p_dim)


def _ssd_mixer(z, xbc, dt_raw, conv_w, conv_b, dt_bias, a_log, d_skip, norm_w):
    bsz, seq_len, _ = xbc.shape
    f32 = jnp.float32
    xbc = jax.nn.silu(_depthwise_conv(xbc, conv_w, conv_b))
    xs = xbc[..., :SSD_INNER].reshape(bsz, seq_len, SSD_HEADS, SSD_HEAD_DIM)
    bm = xbc[..., SSD_INNER:SSD_INNER + SSD_GROUPS * SSD_STATE].reshape(bsz, seq_len, SSD_GROUPS, SSD_STATE)
    cm = xbc[..., SSD_INNER + SSD_GROUPS * SSD_STATE:].reshape(bsz, seq_len, SSD_GROUPS, SSD_STATE)
    dt_raw = dt_raw.astype(f32)
    dt_f = jax.nn.softplus(dt_raw[..., :SSD_HEADS] + dt_bias[0].astype(f32))
    dt_b = jax.nn.softplus(dt_raw[..., SSD_HEADS:] + dt_bias[1].astype(f32))
    a_f = -jnp.exp(a_log[0].astype(f32))
    a_b = -jnp.exp(a_log[1].astype(f32))
    pad = SSD_CHUNK - N_META

    def lay(t):
        zeros = jnp.zeros((bsz, pad) + t.shape[2:], t.dtype)
        return jnp.concatenate([t[:, :N_META], zeros, t[:, N_META:]], axis=1)

    xh, bp, cp = lay(xs), lay(bm), lay(cm)
    dtf, dtb = lay(dt_f), lay(dt_b)
    y_f = _ssd_scan(xh, dtf, a_f, bp, cp)
    flip = lambda t: jnp.flip(t, axis=1)
    y_b = flip(_ssd_scan(flip(xh), flip(dtb), a_b, flip(bp), flip(cp)))
    y = y_f + y_b
    y = jnp.concatenate([y[:, :N_META], y[:, SSD_CHUNK:]], axis=1)
    y = y + d_skip.astype(f32)[:, None] * xs.astype(f32)
    y = y.reshape(bsz, seq_len, SSD_INNER) * jax.nn.silu(z.astype(f32))
    return _rmsnorm(y, norm_w).astype(z.dtype)


def _window_attention(q, k, v, sink):
    bsz, seq_len, n_q, hd = q.shape
    n_kv = k.shape[2]
    rep = n_q // n_kv
    w = WIN_BLOCK
    nb = -(-seq_len // w)
    lp = nb * w
    f32 = jnp.float32
    scale = hd ** -0.5
    qb = jnp.pad(q, ((0, 0), (0, lp - seq_len), (0, 0), (0, 0))).reshape(bsz, nb, w, n_kv, rep, hd)

    def kwin(t):
        tp = jnp.pad(t, ((0, 0), (w, lp - seq_len + w), (0, 0), (0, 0))).reshape(bsz, nb + 2, w, n_kv, hd)
        return jnp.concatenate([tp[:, :-2], tp[:, 1:-1], tp[:, 2:]], axis=2)

    kw, vw = kwin(k), kwin(v)
    km, vm = k[:, :N_META], v[:, :N_META]
    s_w = jnp.einsum('bnqgrd,bnkgd->bngrqk', qb, kw).astype(f32) * scale
    s_m = jnp.einsum('bnqgrd,bmgd->bngrqm', qb, km).astype(f32) * scale
    qi = jnp.arange(nb)[:, None, None] * w + jnp.arange(w)[None, :, None]
    kj = jnp.arange(nb)[:, None, None] * w - w + jnp.arange(3 * w)[None, None, :]
    ok = (jnp.abs(qi - kj) <= WIN_RADIUS) & (kj >= N_META) & (kj < seq_len)
    s_w = jnp.where(ok[None, :, None, None], s_w, -jnp.inf)
    sink_l = jnp.broadcast_to(sink.astype(f32).reshape(n_kv, rep)[None, None, :, :, None, None], s_w.shape[:-1] + (1,))
    p = jax.nn.softmax(jnp.concatenate([s_w, s_m, sink_l], axis=-1), axis=-1)
    p_w = p[..., :3 * w].astype(v.dtype)
    p_m = p[..., 3 * w:3 * w + N_META].astype(v.dtype)
    o = jnp.einsum('bngrqk,bnkgd->bnqgrd', p_w, vw) + jnp.einsum('bngrqm,bmgd->bnqgrd', p_m, vm)
    return o.reshape(bsz, lp, n_q * hd)[:, :seq_len]


def _na_attention(q, k, v, rpb, meta_bias):
    bsz, seq_len, n_heads, hd = q.shape
    n_tok = seq_len - N_META
    rows = n_tok // GRID_W
    kr = min(NA_KR, rows)
    ncb = GRID_W // NA_QC
    scale = hd ** -0.5
    f32 = jnp.float32
    qm, km, vm = q[:, :N_META], k[:, :N_META], v[:, :N_META]
    qg = q[:, N_META:].reshape(bsz, rows, GRID_W, n_heads, hd)
    kg = k[:, N_META:].reshape(bsz, rows, GRID_W, n_heads, hd)
    vg = v[:, N_META:].reshape(bsz, rows, GRID_W, n_heads, hd)
    qcol = np.arange(GRID_W).reshape(ncb, NA_QC)
    qcs = np.clip(qcol - NA_KC // 2, 0, GRID_W - NA_KC)
    kcol = np.clip(np.arange(ncb) * NA_QC - NA_KC // 2, 0, GRID_W - NA_KCB)[:, None] + np.arange(NA_KCB)[None, :]
    col_ok = jnp.asarray((kcol[:, None, :] >= qcs[:, :, None]) & (kcol[:, None, :] < qcs[:, :, None] + NA_KC))
    dc = jnp.asarray(np.clip(kcol[:, None, :] - qcol[:, :, None] + NA_KC - 1, 0, 2 * NA_KC - 2))
    col_idx = jnp.asarray(kcol)
    rpb32 = rpb.astype(f32)
    mb = meta_bias.astype(f32)

    def one_row(r):
        rs = jnp.clip(r - kr // 2, 0, rows - kr)
        k_rows = lax.dynamic_slice_in_dim(kg, rs, kr, axis=1)
        v_rows = lax.dynamic_slice_in_dim(vg, rs, kr, axis=1)
        kb = k_rows[:, :, col_idx]
        vb = v_rows[:, :, col_idx]
        qr = lax.dynamic_index_in_dim(qg, r, axis=1, keepdims=False).reshape(bsz, ncb, NA_QC, n_heads, hd)
        dr = rs + jnp.arange(kr) - r + NA_KR - 1
        bias = rpb32[:, dr[None, None, :, None], dc[:, :, None, :]]
        s_w = jnp.einsum('bcqhd,bicjhd->bhcqij', qr, kb).astype(f32) * scale + bias[None]
        s_w = jnp.where(col_ok[:, :, None, :], s_w, -jnp.inf).reshape(bsz, n_heads, ncb, NA_QC, kr * NA_KCB)
        s_m = jnp.einsum('bcqhd,bmhd->bhcqm', qr, km).astype(f32) * scale + mb[None, :, None, None, :]
        p = jax.nn.softmax(jnp.concatenate([s_w, s_m], axis=-1), axis=-1)
        p_w = p[..., :kr * NA_KCB].reshape(bsz, n_heads, ncb, NA_QC, kr, NA_KCB).astype(v.dtype)
        p_m = p[..., kr * NA_KCB:].astype(v.dtype)
        o = jnp.einsum('bhcqij,bicjhd->bcqhd', p_w, vb) + jnp.einsum('bhcqm,bmhd->bcqhd', p_m, vm)
        return o.reshape(bsz, GRID_W, n_heads * hd)

    o_grid = lax.map(one_row, jnp.arange(rows))
    o_grid = jnp.moveaxis(o_grid, 0, 1).reshape(bsz, n_tok, n_heads * hd)
    bias0 = rpb32[:, NA_KR - 1:NA_KR - 1 + kr, NA_KC - 1:NA_KC - 1 + NA_KC]
    k0, v0 = kg[:, :kr, :NA_KC], vg[:, :kr, :NA_KC]
    s0 = jnp.einsum('bmhd,bijhd->bhmij', qm, k0).astype(f32) * scale + bias0[None, :, None]
    smm = jnp.einsum('bmhd,bnhd->bhmn', qm, km).astype(f32) * scale + mb[None, :, None, :]
    p0 = jax.nn.softmax(jnp.concatenate([s0.reshape(bsz, n_heads, N_META, kr * NA_KC), smm], axis=-1), axis=-1)
    p0w = p0[..., :kr * NA_KC].reshape(bsz, n_heads, N_META, kr, NA_KC).astype(v.dtype)
    p0m = p0[..., kr * NA_KC:].astype(v.dtype)
    o_meta = jnp.einsum('bhmij,bijhd->bmhd', p0w, v0) + jnp.einsum('bhmn,bnhd->bmhd', p0m, vm)
    o_meta = o_meta.reshape(bsz, N_META, n_heads * hd)
    return jnp.concatenate([o_meta, o_grid], axis=1)


def _encode(x, meta_tokens, norm_mix_pre, norm_mix_post, w_in, ssd_conv_w, ssd_conv_b, ssd_dt_bias, ssd_a_log,
            ssd_d, ssd_norm_w, win_sink, na_rpb, na_meta_bias, w_out, norm_ffn_pre, norm_ffn_post, ffn_w_up,
            ffn_conv_w, ffn_conv_b, ffn_w_down):
    bsz, n_tok, _ = x.shape
    seq_len = n_tok + N_META
    meta = jnp.broadcast_to(meta_tokens.astype(x.dtype)[None], (bsz, N_META, D_MODEL))
    h = jnp.concatenate([meta, x], axis=1)
    pos = jnp.arange(seq_len)
    for i in range(DEPTH):
        a = _rmsnorm(h, norm_mix_pre[i])
        u = a @ w_in[i]
        z, xbc, dt_raw, wq, wk, wv, nq, nk, nv = _split_in_proj(u)
        y_ssd = _ssd_mixer(z, xbc, dt_raw, ssd_conv_w[i], ssd_conv_b[i], ssd_dt_bias[i], ssd_a_log[i],
                           ssd_d[i], ssd_norm_w[i])
        q = _partial_rope(wq.reshape(bsz, seq_len, WIN_Q_HEADS, HEAD_DIM), pos)
        k = _partial_rope(wk.reshape(bsz, seq_len, WIN_KV_HEADS, HEAD_DIM), pos)
        v = wv.reshape(bsz, seq_len, WIN_KV_HEADS, HEAD_DIM)
        y_win = _window_attention(q, k, v, win_sink[i])
        y_na = _na_attention(nq.reshape(bsz, seq_len, NA_HEADS, HEAD_DIM), nk.reshape(bsz, seq_len, NA_HEADS, HEAD_DIM),
                             nv.reshape(bsz, seq_len, NA_HEADS, HEAD_DIM), na_rpb[i], na_meta_bias[i])
        mix = jnp.concatenate([y_ssd, y_win, y_na], axis=-1) @ w_out[i]
        h = h + _rmsnorm(mix, norm_mix_post[i])
        f = _rmsnorm(h, norm_ffn_pre[i])
        g = _depthwise_conv(f @ ffn_w_up[i], ffn_conv_w[i], ffn_conv_b[i])
        gate, up = jnp.split(g, 2, axis=-1)
        f = (jax.nn.gelu(gate, approximate=True) * up) @ ffn_w_down[i]
        h = h + _rmsnorm(f, norm_ffn_post[i])
    return h[:, N_META:]


def setup_inputs(seed: int = 0) -> dict:
    key = jax.random.key(seed)
    ks = jax.random.split(key, 24)
    f32 = jnp.float32
    nrm = lambda k, shape, s: jax.random.normal(k, shape, f32) * s
    gain = lambda k, shape: 1.0 + 0.02 * jax.random.normal(k, shape, f32)
    dt0 = jnp.exp(jax.random.uniform(ks[8], (DEPTH, 2, SSD_HEADS), f32, math.log(1e-3), math.log(1e-1)))
    return {
        'x_prompt': nrm(ks[0], (BATCH, SEQ, D_MODEL), 1.0),
        'x_sample': nrm(ks[1], (DEC_BATCH, DEC_SEQ, D_MODEL), 1.0),
        'meta_tokens': nrm(ks[2], (N_META, D_MODEL), 1.0),
        'norm_mix_pre': gain(ks[3], (DEPTH, D_MODEL)),
        'norm_mix_post': gain(ks[4], (DEPTH, D_MODEL)),
        'w_in': nrm(ks[5], (DEPTH, D_MODEL, D_IN_PROJ), D_MODEL ** -0.5),
        'ssd_conv_w': nrm(ks[6], (DEPTH, SSD_CONV, SSD_XBC), SSD_CONV ** -0.5),
        'ssd_conv_b': nrm(ks[7], (DEPTH, SSD_XBC), 0.01),
        'ssd_dt_bias': dt0 + jnp.log(-jnp.expm1(-dt0)),
        'ssd_a_log': jnp.log(jax.random.uniform(ks[9], (DEPTH, 2, SSD_HEADS), f32, 1.0, 16.0)),
        'ssd_d': gain(ks[10], (DEPTH, SSD_HEADS)),
        'ssd_norm_w': gain(ks[11], (DEPTH, SSD_INNER)),
        'win_sink': nrm(ks[12], (DEPTH, WIN_Q_HEADS), 0.5),
        'na_rpb': nrm(ks[13], (DEPTH, NA_HEADS, 2 * NA_KR - 1, 2 * NA_KC - 1), 0.02),
        'na_meta_bias': nrm(ks[14], (DEPTH, NA_HEADS, N_META), 0.02),
        'w_out': nrm(ks[15], (DEPTH, D_MIX, D_MODEL), D_MIX ** -0.5),
        'norm_ffn_pre': gain(ks[16], (DEPTH, D_MODEL)),
        'norm_ffn_post': gain(ks[17], (DEPTH, D_MODEL)),
        'ffn_w_up': nrm(ks[18], (DEPTH, D_MODEL, 2 * D_FF), D_MODEL ** -0.5),
        'ffn_conv_w': nrm(ks[19], (DEPTH, FFN_CONV, 2 * D_FF), FFN_CONV ** -0.5),
        'ffn_conv_b': nrm(ks[20], (DEPTH, 2 * D_FF), 0.01),
        'ffn_w_down': nrm(ks[21], (DEPTH, D_FF, D_MODEL), D_FF ** -0.5),
    }


def reference(x_prompt, x_sample, meta_tokens, norm_mix_pre, norm_mix_post, w_in, ssd_conv_w, ssd_conv_b,
              ssd_dt_bias, ssd_a_log, ssd_d, ssd_norm_w, win_sink, na_rpb, na_meta_bias, w_out, norm_ffn_pre,
              norm_ffn_post, ffn_w_up, ffn_conv_w, ffn_conv_b, ffn_w_down):
    y_prompt = _encode(x_prompt, meta_tokens, norm_mix_pre, norm_mix_post, w_in, ssd_conv_w, ssd_conv_b, ssd_dt_bias,
                       ssd_a_log, ssd_d, ssd_norm_w, win_sink, na_rpb, na_meta_bias, w_out, norm_ffn_pre,
                       norm_ffn_post, ffn_w_up, ffn_conv_w, ffn_conv_b, ffn_w_down)
    y_sample = _encode(x_sample, meta_tokens, norm_mix_pre, norm_mix_post, w_in, ssd_conv_w, ssd_conv_b, ssd_dt_bias,
                       ssd_a_log, ssd_d, ssd_norm_w, win_sink, na_rpb, na_meta_bias, w_out, norm_ffn_pre,
                       norm_ffn_post, ffn_w_up, ffn_conv_w, ffn_conv_b, ffn_w_down)
    return (y_prompt, y_sample)
```

```cpp
#include <hip/hip_runtime.h>
#include <hip/hip_cooperative_groups.h>
#include <cstdio>
namespace cg = cooperative_groups;

typedef unsigned short u16;
typedef __attribute__((ext_vector_type(8))) short bf16x8;
typedef __attribute__((ext_vector_type(4))) float f32x4;
typedef __attribute__((ext_vector_type(4))) unsigned int u32x4;
#define DEVI __device__ __forceinline__

constexpr int DM = 1024, DIN = 4896, DINP = 5120, DMIX = 2048, DFF = 2816, DUP = 5632;
constexpr int C_XBC = 1024, C_DT = 2560, C_WQ = 2592, C_WK = 3104, C_WV = 3232, C_NQ = 3360, C_NK = 3872, C_NV = 4384;
constexpr size_t RMAX = 16896;
constexpr int TMAX = 132;
constexpr float EPS = 1e-6f;
constexpr int LDS_BYTES = 77824;

constexpr size_t SZ_WIN = (size_t)2 * DINP * DM * 2;
constexpr size_t SZ_WOUT = (size_t)2 * DM * DMIX * 2;
constexpr size_t SZ_WUP = (size_t)2 * DUP * DM * 2;
constexpr size_t SZ_WDN = (size_t)2 * DM * DFF * 2;
constexpr size_t OFF_WIN = 0;
constexpr size_t OFF_WOUT = OFF_WIN + SZ_WIN;
constexpr size_t OFF_WUP = OFF_WOUT + SZ_WOUT;
constexpr size_t OFF_WDN = OFF_WUP + SZ_WUP;
constexpr size_t OFF_HMETA = OFF_WDN + SZ_WDN;
constexpr size_t OFF_HB = OFF_HMETA + (size_t)10 * 16 * DM * 4;
constexpr size_t OFF_U = OFF_HB + RMAX * DM * 2;
constexpr size_t OFF_XC = OFF_U + RMAX * DIN * 2;
constexpr size_t OFF_DT = OFF_XC + RMAX * 1536 * 2;
constexpr size_t OFF_ST = OFF_DT + RMAX * 32 * 4;
constexpr size_t OFF_YMIX = OFF_ST + (size_t)TMAX * 16 * 2 * 8192 * 2;
constexpr size_t OFF_SSQA = OFF_YMIX + RMAX * DMIX * 2;
constexpr size_t OFF_SSQB = OFF_SSQA + RMAX * 16 * 4;
constexpr size_t OFF_RS = OFF_SSQB + RMAX * 16 * 4;
constexpr size_t OFF_DEC = OFF_RS + RMAX * 4;
constexpr size_t WS_TOTAL = OFF_DEC + (size_t)TMAX * 16 * 2 * 4;
constexpr size_t OFF_BAR = (WS_TOTAL + 255) / 256 * 256;
constexpr size_t WS_NEED = OFF_BAR + 3456 * 4;
static_assert(RMAX * DUP * 2 <= RMAX * DIN * 2 + RMAX * 1536 * 2, "g alias");
static_assert(RMAX * DFF * 2 <= (size_t)TMAX * 16 * 2 * 8192 * 2 + RMAX * DMIX * 2, "act alias");
static_assert(WS_NEED < (size_t)512 * 1024 * 1024, "ws");

__constant__ float c_inv[8] = {1.0f, 0.1939227447486858f, 0.03760603093086394f, 0.007292664737217109f,
                               0.0014142135623730955f, 0.00027424817567620724f, 5.318295896944988e-05f,
                               1.0313385377212461e-05f};

struct Params {
  const float *xp, *xs, *meta, *n_mix_pre, *n_mix_post, *w_in, *conv_w, *conv_b, *dt_bias, *a_log, *ssd_d, *ssd_nw,
      *sink, *rpb, *mbias, *w_out, *n_ffn_pre, *n_ffn_post, *w_up, *fconv_w, *fconv_b, *w_down;
  float* out;
  char* ws;
};

typedef __attribute__((ext_vector_type(2))) __bf16 bf16x2_t;
typedef __attribute__((ext_vector_type(2))) float f32x2_t;
DEVI unsigned cvt_pk_bf16(float a, float b) {
  f32x2_t v = {a, b};
  return __builtin_bit_cast(unsigned, __builtin_convertvector(v, bf16x2_t));
}
DEVI u16 f2bf(float f) { return (u16)(cvt_pk_bf16(f, 0.f) & 0xffffu); }
DEVI float bf2f(u16 h) { return __uint_as_float(((unsigned)h) << 16); }
DEVI float silu_f(float x) { return x * __builtin_amdgcn_rcpf(1.f + __expf(-x)); }
DEVI void unpack8(uint4 v, float* f) {
  f[0] = __uint_as_float(v.x << 16); f[1] = __uint_as_float(v.x & 0xffff0000u);
  f[2] = __uint_as_float(v.y << 16); f[3] = __uint_as_float(v.y & 0xffff0000u);
  f[4] = __uint_as_float(v.z << 16); f[5] = __uint_as_float(v.z & 0xffff0000u);
  f[6] = __uint_as_float(v.w << 16); f[7] = __uint_as_float(v.w & 0xffff0000u);
}
DEVI unsigned pack2(float a, float b) { return cvt_pk_bf16(a, b); }
DEVI uint4 pack8(const float* f) {
  uint4 v; v.x = pack2(f[0], f[1]); v.y = pack2(f[2], f[3]); v.z = pack2(f[4], f[5]); v.w = pack2(f[6], f[7]);
  return v;
}
DEVI void ginfo(int g, int& nseq, int& tps, int& seq0) {
  if (g < 2) { nseq = 4; tps = 33; seq0 = 4 * g; } else { nseq = 1; tps = 129; seq0 = 8 + (g - 2); }
}
DEVI size_t seq_outrow(int seq) { return seq < 8 ? (size_t)seq * 4096 : (size_t)32768 + (size_t)(seq - 8) * 16384; }
template <int N>
DEVI float dpp_ror(float v) {
  return __builtin_bit_cast(float, __builtin_amdgcn_update_dpp(0, __builtin_bit_cast(int, v), 0x120 + N, 0xf, 0xf, false));
}
DEVI float red16_sum(float v) {
  v += dpp_ror<8>(v); v += dpp_ror<4>(v); v += dpp_ror<2>(v); v += dpp_ror<1>(v); return v;
}
DEVI float red16_max(float v) {
  v = fmaxf(v, dpp_ror<8>(v)); v = fmaxf(v, dpp_ror<4>(v)); v = fmaxf(v, dpp_ror<2>(v)); v = fmaxf(v, dpp_ror<1>(v));
  return v;
}
DEVI float red64_sum(float v) {
  v = red16_sum(v);
  v += __shfl_xor(v, 16); v += __shfl_xor(v, 32); return v;
}

DEVI int otid() { int t = threadIdx.x; asm volatile("" : "+v"(t)); return t; }
DEVI int obid() { return blockIdx.x; }

template <int MT, int NT, int KT>
DEVI void wave_mma(f32x4 (&acc)[MT][NT], const u16* A, int lda, int mstep, const u16* B, int ldb, int nstep, int lane) {
  const int fr = lane & 15, fq = lane >> 4;
  const u16* ap = A + fr * lda + fq * 8;
  const u16* bp = B + fr * ldb + fq * 8;
#pragma unroll
  for (int ks = 0; ks < KT; ++ks) {
    bf16x8 a[MT], b[NT];
#pragma unroll
    for (int m = 0; m < MT; ++m) a[m] = *reinterpret_cast<const bf16x8*>(ap + m * mstep + ks * 32);
#pragma unroll
    for (int n = 0; n < NT; ++n) b[n] = *reinterpret_cast<const bf16x8*>(bp + n * nstep + ks * 32);
    __builtin_amdgcn_s_setprio(1);
#pragma unroll
    for (int m = 0; m < MT; ++m)
#pragma unroll
      for (int n = 0; n < NT; ++n) acc[m][n] = __builtin_amdgcn_mfma_f32_16x16x32_bf16(a[m], b[n], acc[m][n], 0, 0, 0);
    __builtin_amdgcn_s_setprio(0);
  }
}

__device__ void prep_one(const float* src, u16* dst, int K, int N, int tk, int tn, const float* kscale, int klim,
                         char* smem) {
  float* tile = (float*)smem;
  const int tid = otid();
  const int k0 = tk * 64, n0 = tn * 64;
#pragma unroll 4
  for (int i = 0; i < 16; ++i) {
    int k = i * 4 + (tid >> 6), n = tid & 63;
    float v = 0.f;
    if (n0 + n < N) {
      v = src[(size_t)(k0 + k) * N + n0 + n];
      if (kscale && (k0 + k) < klim) v *= kscale[k0 + k];
    }
    tile[k * 65 + n] = v;
  }
  __syncthreads();
#pragma unroll 4
  for (int i = 0; i < 16; ++i) {
    int n = i * 4 + (tid >> 6), k = tid & 63;
    dst[(size_t)(n0 + n) * K + k0 + k] = f2bf(tile[k * 65 + n]);
  }
  __syncthreads();
}

__device__ void phase_prep(const Params& p, char* smem) {
  for (int it = obid(); it < 2 * 3904; it += gridDim.x) {
    int layer = it / 3904, r = it % 3904;
    if (r < 1280) {
      prep_one(p.w_in + (size_t)layer * DM * DIN, (u16*)(p.ws + OFF_WIN) + (size_t)layer * DINP * DM, DM, DIN, r / 80,
               r % 80, p.n_mix_pre + layer * DM, DM, smem);
    } else if (r < 1792) {
      r -= 1280;
      prep_one(p.w_out + (size_t)layer * DMIX * DM, (u16*)(p.ws + OFF_WOUT) + (size_t)layer * DM * DMIX, DMIX, DM,
               r / 16, r % 16, p.ssd_nw + layer * 1024, 1024, smem);
    } else if (r < 3200) {
      r -= 1792;
      prep_one(p.w_up + (size_t)layer * DM * DUP, (u16*)(p.ws + OFF_WUP) + (size_t)layer * DUP * DM, DM, DUP, r / 88,
               r % 88, p.n_ffn_pre + layer * DM, DM, smem);
    } else {
      r -= 3200;
      prep_one(p.w_down + (size_t)layer * DFF * DM, (u16*)(p.ws + OFF_WDN) + (size_t)layer * DM * DFF, DFF, DM, r / 16,
               r % 16, nullptr, 0, smem);
    }
  }
}

__device__ void phase_rowupd(const Params& p, int g, int mode, const u16* src, const float* w) {
  int nseq, tps, seq0; ginfo(g, nseq, tps, seq0);
  const int nrows = nseq * tps * 128;
  const int tid_ = otid(); const int lane = tid_ & 63, wid = tid_ >> 6;
  u16* hb = (u16*)(p.ws + OFF_HB);
  float* rs = (float*)(p.ws + OFF_RS);
  for (int R = obid() * 4 + wid; R < nrows; R += gridDim.x * 4) {
    int T = R >> 7, r = R & 127, sl = T / tps, c = T - sl * tps, seq = seq0 + sl;
    u16* hbrow = hb + (size_t)R * DM;
    bool valid = (c > 0) || (r < 16);
    if (!valid) {
      if (mode == 0) {
        uint4 z = make_uint4(0, 0, 0, 0);
        *reinterpret_cast<uint4*>(hbrow + lane * 16) = z;
        *reinterpret_cast<uint4*>(hbrow + lane * 16 + 8) = z;
        if (lane == 0) rs[R] = 0.f;
      }
      continue;
    }
    float4 v[4];
    if (mode == 0) {
      const float* xr;
      if (c == 0) xr = p.meta + (size_t)r * DM;
      else if (seq < 8) xr = p.xp + ((size_t)seq * 4096 + (size_t)(c - 1) * 128 + r) * DM;
      else xr = p.xs + ((size_t)(seq - 8) * 16384 + (size_t)(c - 1) * 128 + r) * DM;
#pragma unroll
      for (int i = 0; i < 4; ++i) v[i] = *reinterpret_cast<const float4*>(xr + lane * 4 + i * 256);
    } else {
      if (mode == 2 && c == 0) continue;
      const u16* sr = src + (size_t)R * DM;
      uint2 sv[4];
      float tot = 0.f;
#pragma unroll
      for (int i = 0; i < 4; ++i) {
        sv[i] = *reinterpret_cast<const uint2*>(sr + lane * 4 + i * 256);
        float a0 = __uint_as_float(sv[i].x << 16), a1 = __uint_as_float(sv[i].x & 0xffff0000u);
        float a2 = __uint_as_float(sv[i].y << 16), a3 = __uint_as_float(sv[i].y & 0xffff0000u);
        tot += a0 * a0 + a1 * a1 + a2 * a2 + a3 * a3;
      }
      tot = red64_sum(tot);
      float sc = rsqrtf(tot * (1.f / 1024.f) + EPS);
#pragma unroll
      for (int i = 0; i < 4; ++i) {
        uint2 hv = *reinterpret_cast<const uint2*>(hbrow + lane * 4 + i * 256);
        float4 wv = *reinterpret_cast<const float4*>(w + lane * 4 + i * 256);
        float4 o;
        o.x = __uint_as_float(hv.x << 16) + __uint_as_float(sv[i].x << 16) * sc * wv.x;
        o.y = __uint_as_float(hv.x & 0xffff0000u) + __uint_as_float(sv[i].x & 0xffff0000u) * sc * wv.y;
        o.z = __uint_as_float(hv.y << 16) + __uint_as_float(sv[i].y << 16) * sc * wv.z;
        o.w = __uint_as_float(hv.y & 0xffff0000u) + __uint_as_float(sv[i].y & 0xffff0000u) * sc * wv.w;
        v[i] = o;
      }
    }
    if (mode == 2) {
      float* op = p.out + (seq_outrow(seq) + (size_t)(c - 1) * 128 + r) * DM;
#pragma unroll
      for (int i = 0; i < 4; ++i) *reinterpret_cast<float4*>(op + lane * 4 + i * 256) = v[i];
      continue;
    }
    float ss = 0.f;
#pragma unroll
    for (int i = 0; i < 4; ++i) {
      ss += v[i].x * v[i].x + v[i].y * v[i].y + v[i].z * v[i].z + v[i].w * v[i].w;
      uint2 bb; bb.x = pack2(v[i].x, v[i].y); bb.y = pack2(v[i].z, v[i].w);
      *reinterpret_cast<uint2*>(hbrow + lane * 4 + i * 256) = bb;
    }
    ss = red64_sum(ss);
    if (lane == 0) rs[R] = rsqrtf(ss * (1.f / 1024.f) + EPS);
  }
}

struct GemmCursor { int it, kt; const u16* ap; const u16* bp; };
struct GemmMap { int bid, G, ntm, ntn, ntnp, swz, ni; };
DEVI int gemm_T(int tm, int tpr) { return tm + tm / tpr + 1; }
DEVI bool gemm_map(const GemmMap& M, int it, int& tm, int& tn) {
  if (M.swz == 2) {
    const int xcd = M.bid & 7, j = M.bid >> 3;
    const int P = it * 8 + xcd;
    const int ptm = P / M.ntnp, ptn = P - ptm * M.ntnp;
    tm = ptm * 8 + (j & 7);
    tn = ptn * 8 + (j >> 3);
    bool v = tn < M.ntn;
    if (!v) tn = M.ntn - 1;
    return v;
  }
  if (M.swz) {
    const int xcd = M.bid & 7, j = M.bid >> 3, half = j >> 5, q = j & 31;
    const int P = (it * 8 + xcd) * 2 + half;
    const int ptm = P / M.ntnp, ptn = P - ptm * M.ntnp;
    tm = ptm * 8 + (q & 7);
    tn = ptn * 4 + (q >> 3);
    bool v = tn < M.ntn;
    if (!v) tn = M.ntn - 1;
    return v;
  }
  int item = M.bid + it * M.G;
  bool v = item < M.ntm * M.ntn;
  if (!v) item = M.ntm * M.ntn - 1;
  tm = item / M.ntn; tn = item - tm * M.ntn;
  return v;
}
DEVI void gemm_gload(u32x4 (&RA)[4], u32x4 (&RB)[4], GemmCursor& L, const GemmMap& M, const u16* A, int lda, const u16* Bt,
                     int K, int nk, int lrow, int lkc, int tpr) {
#pragma unroll
  for (int i = 0; i < 4; ++i) {
    RA[i] = *reinterpret_cast<const u32x4*>(L.ap + (size_t)(32 * i) * lda);
    RB[i] = *reinterpret_cast<const u32x4*>(L.bp + (size_t)(32 * i) * K);
  }
  L.ap += 64; L.bp += 64;
  if (++L.kt == nk) {
    L.kt = 0;
    if (L.it + 1 < M.ni) L.it += 1;
    int tm_, tn_;
    gemm_map(M, L.it, tm_, tn_);
    L.ap = A + ((size_t)gemm_T(tm_, tpr) * 128 + lrow) * lda + lkc * 8;
    L.bp = Bt + ((size_t)tn_ * 128 + lrow) * K + lkc * 8;
  }
}
DEVI void gemm_sstore(const u32x4 (&RA)[4], const u32x4 (&RB)[4], char* As, char* Bs, const int (&soff)[4]) {
#pragma unroll
  for (int i = 0; i < 4; ++i) {
    *reinterpret_cast<u32x4*>(As + soff[i]) = RA[i];
    *reinterpret_cast<u32x4*>(Bs + soff[i]) = RB[i];
  }
}
DEVI void gemm_frags(bf16x8 (&a_)[2][4], bf16x8 (&b_)[2][4], const char* As, const char* Bs, const int (&aoff)[2],
                     const int (&boff)[2]) {
#pragma unroll
  for (int ks = 0; ks < 2; ++ks) {
#pragma unroll
    for (int m = 0; m < 4; ++m) a_[ks][m] = *reinterpret_cast<const bf16x8*>(As + aoff[ks] + m * 256);
#pragma unroll
    for (int n = 0; n < 4; ++n) b_[ks][n] = *reinterpret_cast<const bf16x8*>(Bs + boff[ks] + n * 256);
  }
}
template <int KS>
DEVI void gemm_mfma(f32x4 (&acc)[4][4], const bf16x8 (&a_)[2][4], const bf16x8 (&b_)[2][4]) {
  __builtin_amdgcn_s_setprio(1);
#pragma unroll
  for (int m = 0; m < 4; ++m)
#pragma unroll
    for (int n = 0; n < 4; ++n)
      acc[m][n] = __builtin_amdgcn_mfma_f32_16x16x32_bf16(a_[KS][m], b_[KS][n], acc[m][n], 0, 0, 0);
  __builtin_amdgcn_s_setprio(0);
}

template <int MODE>
__device__ void phase_gemm(const u16* __restrict__ A, int lda, const u16* __restrict__ Bt, int K, int ntm, int ntn,
                           int nvalid, const float* rowscale, u16* outb, int ldo, int tpr,
                           const float* ssqk, char* smem) {
  char* As = smem;
  char* Bs = smem + 32768;
  float* rsv = (float*)(smem + 65536);
  const int tid = otid(), lane = tid & 63, wid = tid >> 6, wr = wid >> 1, wc = wid & 1;
  const int fr = lane & 15, fq = lane >> 4;
  u16* Cw = (u16*)(smem + 66048) + wid * (16 * 72);
  const int lrow = tid >> 3, lkc = tid & 7;
  const int nk = K / 64;
  GemmMap M;
  M.bid = obid(); M.G = gridDim.x; M.ntm = ntm; M.ntn = ntn; M.ntnp = (ntn + 3) >> 2;
  M.swz = (M.G == 512 && ntm == 128) ? 1 : 0;
  if (M.swz && ((ntn + 7) >> 3) * 2 == M.ntnp) { M.swz = 2; M.ntnp = (ntn + 7) >> 3; }
  M.ni = (M.swz == 2) ? 2 * M.ntnp : (M.swz ? M.ntnp : (ntm * ntn + M.G - 1) / M.G);
  const int S = M.ni * nk;
  int soff[4];
#pragma unroll
  for (int i = 0; i < 4; ++i) soff[i] = lkc * 2048 + (((lrow + 32 * i) ^ lkc) * 16);
  int aoff[2], boff[2];
#pragma unroll
  for (int ks = 0; ks < 2; ++ks) {
    int kc = ks * 4 + fq;
    aoff[ks] = kc * 2048 + ((wr * 64 + (fr ^ kc)) * 16);
    boff[ks] = kc * 2048 + ((wc * 64 + (fr ^ kc)) * 16);
  }
  GemmCursor L;
  L.it = 0; L.kt = 0;
  {
    int tm, tn;
    gemm_map(M, 0, tm, tn);
    L.ap = A + ((size_t)gemm_T(tm, tpr) * 128 + lrow) * lda + lkc * 8;
    L.bp = Bt + ((size_t)tn * 128 + lrow) * K + lkc * 8;
  }
  u32x4 r0a[4], r0b[4], r1a[4], r1b[4];
  f32x4 acc[4][4];
#define GLOAD(RA, RB) gemm_gload(RA, RB, L, M, A, lda, Bt, K, nk, lrow, lkc, tpr)
#define SSTORE(RA, RB, BUF) gemm_sstore(RA, RB, As + (BUF) * 16384, Bs + (BUF) * 16384, soff)
#define FRAGS(BUF) gemm_frags(fa, fb, As + (BUF) * 16384, Bs + (BUF) * 16384, aoff, boff)
#define MFMAS(KS) gemm_mfma<KS>(acc, fa, fb)
  bf16x8 fa[2][4], fb[2][4];
  int cit = 0, ckt = 0;
  float rs_reg = 0.f;
  GLOAD(r0a, r0b);
  GLOAD(r1a, r1b);
  SSTORE(r0a, r0b, 0);
  __syncthreads();
  for (int s = 0; s < S; s += 2) {
    FRAGS(0);
    if (ckt == 0) {
#pragma unroll
      for (int m = 0; m < 4; ++m)
#pragma unroll
        for (int n = 0; n < 4; ++n) acc[m][n] = f32x4{0.f, 0.f, 0.f, 0.f};
      if (MODE == 0 && tid < 128) {
        int tmr_, tn_;
        gemm_map(M, cit, tmr_, tn_);
        rs_reg = rowscale[(size_t)gemm_T(tmr_, tpr) * 128 + tid];
      }
      if (MODE == 1 && ssqk != nullptr && tid < 128) {
        int tmr_, tn_;
        gemm_map(M, cit, tmr_, tn_);
        const int tm = gemm_T(tmr_, tpr);
        const float* q = ssqk + ((size_t)tm * 128 + tid) * 16;
        float t = 0.f;
#pragma unroll
        for (int i = 0; i < 16; ++i) t += q[i];
        rsv[tid] = rsqrtf(t * (1.f / 1024.f) + EPS);
      }
    }
    if (MODE == 0 && ckt == 2 && tid < 128) rsv[tid] = rs_reg;
    if (MODE == 1 && ssqk != nullptr && ckt == 16) {
#pragma unroll
      for (int m = 0; m < 4; ++m)
#pragma unroll
        for (int j = 0; j < 4; ++j) {
          float sc = rsv[wr * 64 + m * 16 + fq * 4 + j];
#pragma unroll
          for (int n = 0; n < 4; ++n) acc[m][n][j] *= sc;
        }
    }
    SSTORE(r1a, r1b, 1);
    MFMAS(0);
    MFMAS(1);
    GLOAD(r0a, r0b);
    __syncthreads();
    FRAGS(1);
    SSTORE(r0a, r0b, 0);
    MFMAS(0);
    MFMAS(1);
    GLOAD(r1a, r1b);
    ckt += 2;
    if (ckt == nk) {
      int tmr, tn;
      const bool valid = gemm_map(M, cit, tmr, tn);
      const int tm = gemm_T(tmr, tpr);
      if (!valid) {
      } else if (MODE == 0) {
#pragma unroll
        for (int m = 0; m < 4; ++m) {
#pragma unroll
          for (int j = 0; j < 4; ++j) {
            float sc = rsv[wr * 64 + m * 16 + fq * 4 + j];
#pragma unroll
            for (int n = 0; n < 4; ++n) Cw[(fq * 4 + j) * 72 + n * 16 + fr] = f2bf(acc[m][n][j] * sc);
          }
#pragma unroll
          for (int i = 0; i < 2; ++i) {
            int c = lane + 64 * i, row = c >> 3, ch = c & 7;
            int col = tn * 128 + wc * 64 + ch * 8;
            uint4 v = *reinterpret_cast<const uint4*>(Cw + row * 72 + ch * 8);
            if (col < nvalid)
              *reinterpret_cast<uint4*>(outb + ((size_t)tm * 128 + wr * 64 + m * 16 + row) * ldo + col) = v;
          }
        }
      } else {
#pragma unroll
        for (int m = 0; m < 4; ++m) {
#pragma unroll
          for (int j = 0; j < 4; ++j) {
#pragma unroll
            for (int n = 0; n < 4; ++n) Cw[(fq * 4 + j) * 72 + n * 16 + fr] = f2bf(acc[m][n][j]);
          }
#pragma unroll
          for (int i = 0; i < 2; ++i) {
            int c = lane + 64 * i, row = c >> 3, ch = c & 7;
            int col = tn * 128 + wc * 64 + ch * 8;
            uint4 v = *reinterpret_cast<const uint4*>(Cw + row * 72 + ch * 8);
            *reinterpret_cast<uint4*>(outb + ((size_t)tm * 128 + wr * 64 + m * 16 + row) * ldo + col) = v;
          }
        }
      }
      cit += 1; ckt = 0;
    }
    __syncthreads();
  }
#undef GLOAD
#undef SSTORE
#undef FRAGS
#undef MFMAS
}

template <int MODE>
__device__ void phase_gemm_w(const u16* __restrict__ A, int lda, const u16* __restrict__ Bt, int K, int ntm, int ntn,
                             int nvalid, const float* rowscale, u16* outb, int ldo, int tpr,
                             const float* ssqk, char* smem) {
  char* As = smem;
  char* Bs = smem + 16384;
  float* rsv = (float*)(smem + 49152);
  const int tid = otid(), lane = tid & 63, wid = tid >> 6, wr = wid >> 1, wc = wid & 1;
  const int fr = lane & 15, fq = lane >> 4;
  u16* Cw = (u16*)(smem + 49664) + wid * (16 * 136);
  const int lrow = tid >> 2, lkc = tid & 3;
  const int nk = K / 32;
  GemmMap M;
  M.bid = obid(); M.G = gridDim.x; M.ntm = ntm; M.ntn = ntn; M.ntnp = (ntn + 3) >> 2;
  M.swz = (M.G == 512 && ntm == 128) ? 1 : 0;
  M.ni = M.swz ? M.ntnp : (ntm * ntn + M.G - 1) / M.G;
  const int S = M.ni * nk;
  const int sa0 = lkc * 2048 + ((lrow ^ (lkc << 1)) * 16);
  const int sb0 = lkc * 4096 + ((lrow ^ (lkc << 1)) * 16);
  const int aoff = fq * 2048 + ((wr * 64 + (fr ^ (fq << 1))) * 16);
  const int boff = fq * 4096 + ((wc * 128 + (fr ^ (fq << 1))) * 16);
  int lit = 0, lkt = 0;
  const u16* ap; const u16* bp;
  {
    int tm, tn;
    gemm_map(M, 0, tm, tn);
    ap = A + ((size_t)gemm_T(tm, tpr) * 128 + lrow) * lda + lkc * 8;
    bp = Bt + ((size_t)tn * 256 + lrow) * K + lkc * 8;
  }
  u32x4 ra[2], rb[4];
  f32x4 acc[4][8];
  bf16x8 fa[4], fb[8];
  auto gload = [&]() __attribute__((always_inline)) {
#pragma unroll
    for (int i = 0; i < 2; ++i) ra[i] = *reinterpret_cast<const u32x4*>(ap + (size_t)(64 * i) * lda);
#pragma unroll
    for (int i = 0; i < 4; ++i) rb[i] = *reinterpret_cast<const u32x4*>(bp + (size_t)(64 * i) * K);
    ap += 32; bp += 32;
    if (++lkt == nk) {
      lkt = 0;
      if (lit + 1 < M.ni) lit += 1;
      int tm_, tn_;
      gemm_map(M, lit, tm_, tn_);
      ap = A + ((size_t)gemm_T(tm_, tpr) * 128 + lrow) * lda + lkc * 8;
      bp = Bt + ((size_t)tn_ * 256 + lrow) * K + lkc * 8;
    }
  };
  auto sstore = [&](int buf) __attribute__((always_inline)) {
#pragma unroll
    for (int i = 0; i < 2; ++i) *reinterpret_cast<u32x4*>(As + buf * 8192 + sa0 + i * 1024) = ra[i];
#pragma unroll
    for (int i = 0; i < 4; ++i) *reinterpret_cast<u32x4*>(Bs + buf * 16384 + sb0 + i * 1024) = rb[i];
  };
  auto frags = [&](int buf) __attribute__((always_inline)) {
#pragma unroll
    for (int m = 0; m < 4; ++m) fa[m] = *reinterpret_cast<const bf16x8*>(As + buf * 8192 + aoff + m * 256);
#pragma unroll
    for (int n = 0; n < 8; ++n) fb[n] = *reinterpret_cast<const bf16x8*>(Bs + buf * 16384 + boff + n * 256);
  };
  auto mfmas = [&]() __attribute__((always_inline)) {
    __builtin_amdgcn_s_setprio(1);
#pragma unroll
    for (int m = 0; m < 4; ++m)
#pragma unroll
      for (int n = 0; n < 8; ++n) acc[m][n] = __builtin_amdgcn_mfma_f32_16x16x32_bf16(fa[m], fb[n], acc[m][n], 0, 0, 0);
    __builtin_amdgcn_s_setprio(0);
  };
  int cit = 0, ckt = 0;
  float rs_reg = 0.f;
  gload();
  sstore(0);
  gload();
  __syncthreads();
  for (int s = 0; s < S; s += 2) {
    frags(0);
    if (ckt == 0) {
#pragma unroll
      for (int m = 0; m < 4; ++m)
#pragma unroll
        for (int n = 0; n < 8; ++n) acc[m][n] = f32x4{0.f, 0.f, 0.f, 0.f};
      if (tid < 128) {
        int tmr_, tn_;
        gemm_map(M, cit, tmr_, tn_);
        const size_t R = (size_t)gemm_T(tmr_, tpr) * 128 + tid;
        if (MODE == 0) rs_reg = rowscale[R];
        if (MODE == 1 && ssqk != nullptr) {
          const float* q = ssqk + R * 16;
          float t = 0.f;
#pragma unroll
          for (int i = 0; i < 16; ++i) t += q[i];
          rsv[tid] = rsqrtf(t * (1.f / 1024.f) + EPS);
        }
      }
    }
    if (MODE == 0 && ckt == 2 && tid < 128) rsv[tid] = rs_reg;
    if (MODE == 1 && ssqk != nullptr && ckt == 32) {
#pragma unroll
      for (int m = 0; m < 4; ++m)
#pragma unroll
        for (int j = 0; j < 4; ++j) {
          float sc = rsv[wr * 64 + m * 16 + fq * 4 + j];
#pragma unroll
          for (int n = 0; n < 8; ++n) acc[m][n][j] *= sc;
        }
    }
    sstore(1);
    mfmas();
    gload();
    __syncthreads();
    frags(1);
    sstore(0);
    mfmas();
    gload();
    ckt += 2;
    if (ckt == nk) {
      int tmr, tn;
      const bool valid = gemm_map(M, cit, tmr, tn);
      const int tm = gemm_T(tmr, tpr);
      if (valid) {
#pragma unroll
        for (int m = 0; m < 4; ++m) {
#pragma unroll
          for (int j = 0; j < 4; ++j) {
            float sc = 1.f;
            if (MODE == 0) sc = rsv[wr * 64 + m * 16 + fq * 4 + j];
#pragma unroll
            for (int n = 0; n < 8; ++n) Cw[(fq * 4 + j) * 136 + n * 16 + fr] = f2bf(acc[m][n][j] * sc);
          }
#pragma unroll
          for (int i = 0; i < 4; ++i) {
            int c = lane + 64 * i, row = c >> 4, ch = c & 15;
            int col = tn * 256 + wc * 128 + ch * 8;
            uint4 v = *reinterpret_cast<const uint4*>(Cw + row * 136 + ch * 8);
            if (col < nvalid)
              *reinterpret_cast<uint4*>(outb + ((size_t)tm * 128 + wr * 64 + m * 16 + row) * ldo + col) = v;
          }
        }
      }
      cit += 1; ckt = 0;
    }
    __syncthreads();
  }
}

template <int MODE, int BATCH>
DEVI void gemm_meta_items(const u16* __restrict__ A, int lda, const u16* __restrict__ Bt, int K, int tps, int nn16,
                          const float* rowscale, u16* outb, int ldo, const float* ssqk, int wid, int fr, int fq) {
  const int G = gridDim.x, bid = obid();
  const size_t R0 = (size_t)wid * tps * 128;
  const u16* ap = A + (R0 + fr) * lda + fq * 8;
  const int nks = K / 32;
  for (int it = G - 1 - bid; it < nn16; it += G) {
    const u16* bp = Bt + ((size_t)it * 16 + fr) * K + fq * 8;
    f32x4 acc = f32x4{0.f, 0.f, 0.f, 0.f};
    for (int ks0 = 0; ks0 < nks; ks0 += BATCH) {
      bf16x8 a[BATCH], b[BATCH];
#pragma unroll
      for (int i = 0; i < BATCH; ++i) {
        a[i] = *reinterpret_cast<const bf16x8*>(ap + (ks0 + i) * 32);
        b[i] = *reinterpret_cast<const bf16x8*>(bp + (ks0 + i) * 32);
      }
      if (MODE == 1 && ssqk != nullptr && ks0 == 32) {
#pragma unroll
        for (int j = 0; j < 4; ++j) {
          const float* q = ssqk + (R0 + fq * 4 + j) * 16;
          float t = 0.f;
#pragma unroll
          for (int i = 0; i < 16; ++i) t += q[i];
          acc[j] *= rsqrtf(t * (1.f / 1024.f) + EPS);
        }
      }
#pragma unroll
      for (int i = 0; i < BATCH; ++i) acc = __builtin_amdgcn_mfma_f32_16x16x32_bf16(a[i], b[i], acc, 0, 0, 0);
    }
#pragma unroll
    for (int j = 0; j < 4; ++j) {
      size_t R = R0 + fq * 4 + j;
      float v = acc[j];
      if (MODE == 0) v *= rowscale[R];
      outb[R * ldo + it * 16 + fr] = f2bf(v);
    }
  }
}
template <int MODE>
__device__ void phase_gemm_meta(const u16* __restrict__ A, int lda, const u16* __restrict__ Bt, int K, int nseq, int tps,
                                int nn16, const float* rowscale, u16* outb, int ldo, const float* ssqk) {
  const int tid = otid(), lane = tid & 63, wid = tid >> 6, fr = lane & 15, fq = lane >> 4;
  if (wid >= nseq) return;
  if (((K / 32) & 15) == 0) gemm_meta_items<MODE, 16>(A, lda, Bt, K, tps, nn16, rowscale, outb, ldo, ssqk, wid, fr, fq);
  else gemm_meta_items<MODE, 11>(A, lda, Bt, K, tps, nn16, rowscale, outb, ldo, ssqk, wid, fr, fq);
}

__device__ void phase_conv(const Params& p, int g, int layer) {
  int nseq, tps, seq0; ginfo(g, nseq, tps, seq0);
  const int ntiles = nseq * tps;
  const int L = (tps - 1) * 128 + 16;
  const u16* u = (const u16*)(p.ws + OFF_U);
  u16* xc = (u16*)(p.ws + OFF_XC);
  float* dtb = (float*)(p.ws + OFF_DT);
  const float* cw = p.conv_w + (size_t)layer * 5 * 1536;
  const float* cb = p.conv_b + (size_t)layer * 1536;
  const int total = ntiles * 8 * 192;
  for (int id = obid() * 256 + otid(); id < total; id += gridDim.x * 256) {
    const int ch = id % 192, ts = id / 192, seg = ts & 7, T = ts >> 3;
    const int sl = T / tps, c = T - sl * tps;
    const int col = ch * 8;
    const size_t Rseq = (size_t)sl * tps * 128;
    u16* orow = xc + ((size_t)T * 128 + seg * 16) * 1536 + col;
    const int nvalid = (c > 0) ? 16 : (seg == 0 ? 16 : 0);
    if (nvalid == 0) {
      uint4 z = make_uint4(0, 0, 0, 0);
#pragma unroll 4
      for (int r = 0; r < 16; ++r) *reinterpret_cast<uint4*>(orow + (size_t)r * 1536) = z;
      continue;
    }
    const int pos0 = (c == 0) ? 0 : 16 + (c - 1) * 128 + seg * 16;
    float w[5][8], bias[8];
#pragma unroll
    for (int j = 0; j < 5; ++j) {
      float4 w0 = *reinterpret_cast<const float4*>(cw + j * 1536 + col), w1 = *reinterpret_cast<const float4*>(cw + j * 1536 + col + 4);
      w[j][0] = w0.x; w[j][1] = w0.y; w[j][2] = w0.z; w[j][3] = w0.w; w[j][4] = w1.x; w[j][5] = w1.y; w[j][6] = w1.z; w[j][7] = w1.w;
    }
    {
      float4 b0 = *reinterpret_cast<const float4*>(cb + col), b1 = *reinterpret_cast<const float4*>(cb + col + 4);
      bias[0] = b0.x; bias[1] = b0.y; bias[2] = b0.z; bias[3] = b0.w; bias[4] = b1.x; bias[5] = b1.y; bias[6] = b1.z; bias[7] = b1.w;
    }
    float win[5][8];
    auto ldrow = [&](int pp, float* dst) {
      if (pp >= 0 && pp < L) {
        int prow = (pp < 16) ? pp : 112 + pp;
        uint4 v = *reinterpret_cast<const uint4*>(u + (Rseq + prow) * DIN + C_XBC + col);
        unpack8(v, dst);
      } else {
#pragma unroll
        for (int i = 0; i < 8; ++i) dst[i] = 0.f;
      }
    };
    ldrow(pos0 - 2, win[0]); ldrow(pos0 - 1, win[1]); ldrow(pos0, win[2]); ldrow(pos0 + 1, win[3]);
#pragma unroll
    for (int r = 0; r < 16; ++r) {
      ldrow(pos0 + r + 2, win[(r + 4) % 5]);
      float acc[8];
#pragma unroll
      for (int i = 0; i < 8; ++i) {
        float a = bias[i];
#pragma unroll
        for (int j = 0; j < 5; ++j) a += win[(r + j) % 5][i] * w[j][i];
        acc[i] = silu_f(a);
      }
      *reinterpret_cast<uint4*>(orow + (size_t)r * 1536) = pack8(acc);
    }
  }
  const int nrows = ntiles * 128;
  for (int id = obid() * 256 + otid(); id < nrows * 4; id += gridDim.x * 256) {
    const int R = id >> 2, h0 = (id & 3) * 8;
    const int T = R >> 7, r = R & 127, sl = T / tps, c = T - sl * tps;
    const bool valid = (c > 0) || (r < 16);
    float o[8];
    uint4 v = *reinterpret_cast<const uint4*>(u + (size_t)R * DIN + C_DT + h0);
    float f[8]; unpack8(v, f);
#pragma unroll
    for (int i = 0; i < 8; ++i) {
      float x = f[i] + p.dt_bias[layer * 32 + h0 + i];
      float sp = (x > 20.f) ? x : log1pf(__expf(x));
      o[i] = valid ? sp : 0.f;
    }
    *reinterpret_cast<float4*>(dtb + (size_t)R * 32 + h0) = make_float4(o[0], o[1], o[2], o[3]);
    *reinterpret_cast<float4*>(dtb + (size_t)R * 32 + h0 + 4) = make_float4(o[4], o[5], o[6], o[7]);
  }
}

DEVI void ssd_cumsums(const float* dt, size_t R0, int hd, float Af, float Ab, float* acsf, float* rcs, float* dtf,
                      float* dtbk, int tid_) {
  const int lane = tid_ & 63, wid = tid_ >> 6;
  if (wid < 2) {
    const int dir = wid;
    float d0 = dt[(R0 + 2 * lane) * 32 + dir * 16 + hd], d1 = dt[(R0 + 2 * lane + 1) * 32 + dir * 16 + hd];
    float A_ = dir ? Ab : Af;
    float a0 = d0 * A_, a1 = d1 * A_;
    float s = a0 + a1, inc = s;
#pragma unroll
    for (int o = 1; o < 64; o <<= 1) {
      float t = __shfl_up(inc, o);
      if (lane >= o) inc += t;
    }
    float excl = inc - s;
    if (dir == 0) {
      acsf[2 * lane] = excl + a0; acsf[2 * lane + 1] = inc;
      dtf[2 * lane] = d0; dtf[2 * lane + 1] = d1;
    } else {
      float tot = __shfl(inc, 63);
      rcs[2 * lane] = tot - excl; rcs[2 * lane + 1] = tot - (excl + a0);
      dtbk[2 * lane] = d0; dtbk[2 * lane + 1] = d1;
    }
  }
}

__device__ void phase_ssdA(const Params& p, int g, int layer, char* smem) {
  int nseq, tps, seq0; ginfo(g, nseq, tps, seq0);
  const int ntiles = nseq * tps;
  u16* Bt = (u16*)smem;
  u16* Xt = Bt + 128 * 136;
  float* arr = (float*)(Xt + 64 * 136);
  float *acsf = arr, *rcs = arr + 128, *dtf = arr + 256, *dtbk = arr + 384;
  const int tid = otid(), lane = tid & 63, wid = tid >> 6, fr = lane & 15, fq = lane >> 4;
  const u16* xc = (const u16*)(p.ws + OFF_XC);
  const float* dt = (const float*)(p.ws + OFF_DT);
  u16* st = (u16*)(p.ws + OFF_ST);
  float* dec = (float*)(p.ws + OFF_DEC);
  for (int item = obid(); item < ntiles * 16; item += gridDim.x) {
    const int T = item >> 4, hd = item & 15, grp = hd >> 3;
    const size_t R0 = (size_t)T * 128;
    const float Af = -1.4426950408889634f * __expf(p.a_log[layer * 32 + hd]), Ab = -1.4426950408889634f * __expf(p.a_log[layer * 32 + 16 + hd]);
    ssd_cumsums(dt, R0, hd, Af, Ab, acsf, rcs, dtf, dtbk, tid);
    for (int id = tid; id < 128 * 16; id += 256) {
      int l = id & 127, ch = id >> 7;
      uint4 v = *reinterpret_cast<const uint4*>(xc + (R0 + l) * 1536 + 1024 + grp * 128 + ch * 8);
      u16* d = Bt + (ch * 8) * 136 + l;
      d[0 * 136] = (u16)(v.x & 0xffff); d[1 * 136] = (u16)(v.x >> 16);
      d[2 * 136] = (u16)(v.y & 0xffff); d[3 * 136] = (u16)(v.y >> 16);
      d[4 * 136] = (u16)(v.z & 0xffff); d[5 * 136] = (u16)(v.z >> 16);
      d[6 * 136] = (u16)(v.w & 0xffff); d[7 * 136] = (u16)(v.w >> 16);
    }
    __syncthreads();
#pragma unroll 1
    for (int dir = 0; dir < 2; ++dir) {
      const float ref = dir ? rcs[0] : acsf[127];
      for (int id = tid; id < 128 * 8; id += 256) {
        int l = id & 127, ch = id >> 7;
        uint4 v = *reinterpret_cast<const uint4*>(xc + (R0 + l) * 1536 + hd * 64 + ch * 8);
        float f[8]; unpack8(v, f);
        float w = dir ? dtbk[l] * __builtin_amdgcn_exp2f(ref - rcs[l]) : dtf[l] * __builtin_amdgcn_exp2f(ref - acsf[l]);
        u16* d = Xt + (ch * 8) * 136 + l;
#pragma unroll
        for (int i = 0; i < 8; ++i) d[i * 136] = f2bf(f[i] * w);
      }
      __syncthreads();
      f32x4 acc[4][2];
#pragma unroll
      for (int m = 0; m < 4; ++m)
#pragma unroll
        for (int n = 0; n < 2; ++n) acc[m][n] = f32x4{0.f, 0.f, 0.f, 0.f};
      wave_mma<4, 2, 4>(acc, Xt, 136, 16 * 136, Bt + (wid * 32) * 136, 136, 16 * 136, lane);
      u16* so = st + ((size_t)(T * 16 + hd) * 2 + dir) * 8192;
#pragma unroll
      for (int m = 0; m < 4; ++m)
#pragma unroll
        for (int n = 0; n < 2; ++n)
#pragma unroll
          for (int j = 0; j < 4; ++j) so[(16 * m + fq * 4 + j) * 128 + wid * 32 + 16 * n + fr] = f2bf(acc[m][n][j]);
      __syncthreads();
    }
    if (tid == 0) {
      dec[(size_t)(T * 16 + hd) * 2] = __builtin_amdgcn_exp2f(acsf[127]);
      dec[(size_t)(T * 16 + hd) * 2 + 1] = __builtin_amdgcn_exp2f(rcs[0]);
    }
    __syncthreads();
  }
}

__device__ void phase_scan(const Params& p, int g) {
  int nseq, tps, seq0; ginfo(g, nseq, tps, seq0);
  u16* st = (u16*)(p.ws + OFF_ST);
  const float* dec = (const float*)(p.ws + OFF_DEC);
  const int total = nseq * 32 * 4096;
  for (int i = obid() * 256 + otid(); i < total; i += gridDim.x * 256) {
    const int e2 = i & 4095, chn = i >> 12, dir = chn & 1, hd = (chn >> 1) & 15, sl = chn >> 5;
    float r0 = 0.f, r1 = 0.f;
    for (int cc = 0; cc < tps; cc += 16) {
      unsigned v[16]; float dc[16];
#pragma unroll
      for (int q = 0; q < 16; ++q) {
        int c = cc + q;
        v[q] = 0; dc[q] = 0.f;
        if (c < tps) {
          int ct = dir ? (tps - 1 - c) : c;
          size_t idx = ((size_t)(sl * tps + ct) * 16 + hd) * 2 + dir;
          v[q] = *reinterpret_cast<const unsigned*>(st + idx * 8192 + e2 * 2);
          dc[q] = dec[idx];
        }
      }
#pragma unroll
      for (int q = 0; q < 16; ++q) {
        int c = cc + q;
        if (c < tps) {
          int ct = dir ? (tps - 1 - c) : c;
          size_t idx = ((size_t)(sl * tps + ct) * 16 + hd) * 2 + dir;
          float s0 = __uint_as_float(v[q] << 16), s1 = __uint_as_float(v[q] & 0xffff0000u);
          *reinterpret_cast<unsigned*>(st + idx * 8192 + e2 * 2) = pack2(r0, r1);
          r0 = dc[q] * r0 + s0; r1 = dc[q] * r1 + s1;
        }
      }
    }
  }
}

__device__ void phase_ssdC(const Params& p, int g, int layer, char* smem) {
  int nseq, tps, seq0; ginfo(g, nseq, tps, seq0);
  const int ntiles = nseq * tps;
  u16* R0b = (u16*)smem;
  u16* R1b = R0b + 128 * 136;
  float* arr = (float*)(R1b + 128 * 136);
  float *acsf = arr, *rcs = arr + 128, *dtf = arr + 256, *dtbk = arr + 384;
  const int tid = otid(), lane = tid & 63, wid = tid >> 6, fr = lane & 15, fq = lane >> 4;
  const u16* xc = (const u16*)(p.ws + OFF_XC);
  const u16* u = (const u16*)(p.ws + OFF_U);
  const float* dt = (const float*)(p.ws + OFF_DT);
  const u16* st = (const u16*)(p.ws + OFF_ST);
  u16* ymix = (u16*)(p.ws + OFF_YMIX);
  float* ssqa = (float*)(p.ws + OFF_SSQA);
  for (int item = obid(); item < ntiles * 16; item += gridDim.x) {
    const int T = item >> 4, hd = item & 15, grp = hd >> 3;
    const size_t Rb = (size_t)T * 128;
    const float Af = -1.4426950408889634f * __expf(p.a_log[layer * 32 + hd]), Ab = -1.4426950408889634f * __expf(p.a_log[layer * 32 + 16 + hd]);
    const float Dh = p.ssd_d[layer * 16 + hd];
    ssd_cumsums(dt, Rb, hd, Af, Ab, acsf, rcs, dtf, dtbk, tid);
    for (int id = tid; id < 128 * 16; id += 256) {
      int l = id >> 4, ch = id & 15;
      const u16* s = xc + (Rb + l) * 1536 + 1024 + grp * 128 + ch * 8;
      *reinterpret_cast<uint4*>(R1b + l * 136 + ch * 8) = *reinterpret_cast<const uint4*>(s);
      *reinterpret_cast<uint4*>(R0b + l * 136 + ch * 8) = *reinterpret_cast<const uint4*>(s + 256);
    }
    __syncthreads();
    f32x4 cb[2][8];
#pragma unroll
    for (int m = 0; m < 2; ++m)
#pragma unroll
      for (int n = 0; n < 8; ++n) cb[m][n] = f32x4{0.f, 0.f, 0.f, 0.f};
    wave_mma<2, 8, 4>(cb, R0b + (wid * 32) * 136, 136, 16 * 136, R1b, 136, 16 * 136, lane);
    __syncthreads();
    for (int id = tid; id < 2 * 64 * 16; id += 256) {
      int d = id >> 10, pp = (id >> 4) & 63, ch = id & 15;
      *reinterpret_cast<uint4*>(R1b + (d * 64 + pp) * 136 + ch * 8) =
          *reinterpret_cast<const uint4*>(st + ((size_t)(T * 16 + hd) * 2 + d) * 8192 + pp * 128 + ch * 8);
    }
    __syncthreads();
    f32x4 y[2][4];
    {
      f32x4 yf[2][4], yb[2][4];
#pragma unroll
      for (int m = 0; m < 2; ++m)
#pragma unroll
        for (int n = 0; n < 4; ++n) { yf[m][n] = f32x4{0.f, 0.f, 0.f, 0.f}; yb[m][n] = f32x4{0.f, 0.f, 0.f, 0.f}; }
      {
        const u16* ap_ = R0b + (wid * 32 + fr) * 136 + fq * 8;
        const u16* bp_ = R1b + fr * 136 + fq * 8;
#pragma unroll
        for (int ks = 0; ks < 4; ++ks) {
          bf16x8 a_[2], f_[4], b_[4];
#pragma unroll
          for (int m = 0; m < 2; ++m) a_[m] = *reinterpret_cast<const bf16x8*>(ap_ + m * 16 * 136 + ks * 32);
#pragma unroll
          for (int n = 0; n < 4; ++n) {
            f_[n] = *reinterpret_cast<const bf16x8*>(bp_ + n * 16 * 136 + ks * 32);
            b_[n] = *reinterpret_cast<const bf16x8*>(bp_ + (64 + n * 16) * 136 + ks * 32);
          }
          __builtin_amdgcn_s_setprio(1);
#pragma unroll
          for (int m = 0; m < 2; ++m)
#pragma unroll
            for (int n = 0; n < 4; ++n) {
              yf[m][n] = __builtin_amdgcn_mfma_f32_16x16x32_bf16(a_[m], f_[n], yf[m][n], 0, 0, 0);
              yb[m][n] = __builtin_amdgcn_mfma_f32_16x16x32_bf16(a_[m], b_[n], yb[m][n], 0, 0, 0);
            }
          __builtin_amdgcn_s_setprio(0);
        }
      }
#pragma unroll
      for (int m = 0; m < 2; ++m)
#pragma unroll
        for (int j = 0; j < 4; ++j) {
          int l = wid * 32 + 16 * m + fq * 4 + j;
          float ef = __builtin_amdgcn_exp2f(acsf[l]), eb = __builtin_amdgcn_exp2f(rcs[l]);
#pragma unroll
          for (int n = 0; n < 4; ++n) y[m][n][j] = ef * yf[m][n][j] + eb * yb[m][n][j];
        }
    }
    __syncthreads();
    int frv = fr, lbase = wid * 32 + fq * 4;
    asm volatile("" : "+v"(frv), "+v"(lbase));
#pragma unroll
    for (int m = 0; m < 2; ++m) {
      float afl[4], rbl[4];
#pragma unroll
      for (int j = 0; j < 4; ++j) { afl[j] = acsf[lbase + 16 * m + j]; rbl[j] = rcs[lbase + 16 * m + j]; }
#pragma unroll
      for (int n = 0; n < 8; ++n) {
        const int s = 16 * n + frv;
        const int rel = 16 * n - (wid * 32 + 16 * m);
        if (rel < 0) {
          const float as_ = acsf[s], dfs = dtf[s];
#pragma unroll
          for (int j = 0; j < 4; ++j)
            R0b[(lbase + 16 * m + j) * 136 + s] = f2bf(cb[m][n][j] * (__builtin_amdgcn_exp2f(afl[j] - as_) * dfs));
        } else if (rel > 0) {
          const float rs_ = rcs[s], dbs = dtbk[s];
#pragma unroll
          for (int j = 0; j < 4; ++j)
            R0b[(lbase + 16 * m + j) * 136 + s] = f2bf(cb[m][n][j] * (__builtin_amdgcn_exp2f(rbl[j] - rs_) * dbs));
        } else {
          const float as_ = acsf[s], rs_ = rcs[s], dfs = dtf[s], dbs = dtbk[s];
#pragma unroll
          for (int j = 0; j < 4; ++j) {
            const int l = lbase + 16 * m + j;
            float gsum = 0.f;
            if (s <= l) gsum += __builtin_amdgcn_exp2f(afl[j] - as_) * dfs;
            if (s >= l) gsum += __builtin_amdgcn_exp2f(rbl[j] - rs_) * dbs;
            float val = cb[m][n][j] * gsum + ((s == l) ? Dh : 0.f);
            R0b[l * 136 + s] = f2bf(val);
          }
        }
      }
    }
    for (int id = tid; id < 128 * 8; id += 256) {
      int l = id & 127, ch = id >> 7;
      uint4 v = *reinterpret_cast<const uint4*>(xc + (Rb + l) * 1536 + hd * 64 + ch * 8);
      u16* d = R1b + (ch * 8) * 136 + l;
      d[0 * 136] = (u16)(v.x & 0xffff); d[1 * 136] = (u16)(v.x >> 16);
      d[2 * 136] = (u16)(v.y & 0xffff); d[3 * 136] = (u16)(v.y >> 16);
      d[4 * 136] = (u16)(v.z & 0xffff); d[5 * 136] = (u16)(v.z >> 16);
      d[6 * 136] = (u16)(v.w & 0xffff); d[7 * 136] = (u16)(v.w >> 16);
    }
    __syncthreads();
    wave_mma<2, 4, 4>(y, R0b + (wid * 32) * 136, 136, 16 * 136, R1b, 136, 16 * 136, lane);
#pragma unroll
    for (int m = 0; m < 2; ++m)
#pragma unroll
      for (int j = 0; j < 4; ++j) {
        size_t R = Rb + wid * 32 + 16 * m + fq * 4 + j;
        float sq = 0.f;
#pragma unroll
        for (int n = 0; n < 4; ++n) {
          int pc = hd * 64 + 16 * n + fr;
          float z = bf2f(u[R * DIN + pc]);
          float val = y[m][n][j] * silu_f(z);
          sq += val * val;
          ymix[R * DMIX + pc] = f2bf(val);
        }
        sq = red16_sum(sq);
        if (fr == 0) ssqa[R * 16 + hd] = sq;
      }
    __syncthreads();
  }
}

__device__ void phase_rope(const Params& p, int g) {
  int nseq, tps, seq0; ginfo(g, nseq, tps, seq0);
  const int nrows = nseq * tps * 128;
  u16* u = (u16*)(p.ws + OFF_U);
  for (int id = obid() * 256 + otid(); id < nrows * 10; id += gridDim.x * 256) {
    const int R = id / 10, hh = id - R * 10;
    const int T = R >> 7, r = R & 127, sl = T / tps, c = T - sl * tps;
    if (c == 0 && r >= 16) continue;
    const int pos = (c == 0) ? r : 16 + (c - 1) * 128 + r;
    u16* s = u + (size_t)R * DIN + (hh < 8 ? C_WQ + hh * 64 : C_WK + (hh - 8) * 64);
    uint4 v0 = *reinterpret_cast<const uint4*>(s), v1 = *reinterpret_cast<const uint4*>(s + 8);
    float x1[8], x2[8], o1[8], o2[8];
    unpack8(v0, x1); unpack8(v1, x2);
    const float posf = (float)pos;
#pragma unroll
    for (int i = 0; i < 8; ++i) {
      float ang = posf * c_inv[i];
      double rev = (double)ang * 0.15915494309189535;
      rev -= rint(rev);
      float rv = (float)rev;
      float sn = __builtin_amdgcn_sinf(rv), cs = __builtin_amdgcn_cosf(rv);
      o1[i] = x1[i] * cs - x2[i] * sn;
      o2[i] = x2[i] * cs + x1[i] * sn;
    }
    *reinterpret_cast<uint4*>(s) = pack8(o1);
    *reinterpret_cast<uint4*>(s + 8) = pack8(o2);
  }
}

DEVI void kv_prefetch(u32x4 (&pk)[2], u32x4 (&pv)[2], const u16* ksrc, const u16* vsrc, int tid) {
#pragma unroll
  for (int i = 0; i < 2; ++i) {
    int id = tid + i * 256;
    pk[i] = *reinterpret_cast<const u32x4*>(ksrc + (size_t)(id >> 3) * DIN + (id & 7) * 8);
    pv[i] = *reinterpret_cast<const u32x4*>(vsrc + (size_t)(id & 63) * DIN + (id >> 6) * 8);
  }
}
DEVI void kv_commit(const u32x4 (&pk)[2], const u32x4 (&pv)[2], u16* Ks, u16* Vt, int tid) {
#pragma unroll
  for (int i = 0; i < 2; ++i) {
    int id = tid + i * 256;
    *reinterpret_cast<u32x4*>(Ks + (id >> 3) * 72 + (id & 7) * 8) = pk[i];
    u16* d = Vt + ((id >> 6) * 8) * 72 + (id & 63);
    d[0 * 72] = (u16)(pv[i][0] & 0xffff); d[1 * 72] = (u16)(pv[i][0] >> 16);
    d[2 * 72] = (u16)(pv[i][1] & 0xffff); d[3 * 72] = (u16)(pv[i][1] >> 16);
    d[4 * 72] = (u16)(pv[i][2] & 0xffff); d[5 * 72] = (u16)(pv[i][2] >> 16);
    d[6 * 72] = (u16)(pv[i][3] & 0xffff); d[7 * 72] = (u16)(pv[i][3] >> 16);
  }
}
DEVI void stage_rope(u16* dst, const u16* src, int nrows, int pos0, int tid) {
  for (int id = tid; id < nrows * 7; id += 256) {
    int r = id / 7, cz = id - r * 7;
    const u16* s = src + (size_t)r * DIN;
    if (cz > 0) {
      *reinterpret_cast<uint4*>(dst + r * 72 + (cz + 1) * 8) = *reinterpret_cast<const uint4*>(s + (cz + 1) * 8);
    } else {
      uint4 v0 = *reinterpret_cast<const uint4*>(s), v1 = *reinterpret_cast<const uint4*>(s + 8);
      float x1[8], x2[8], o1[8], o2[8];
      unpack8(v0, x1); unpack8(v1, x2);
      float pos = (float)(pos0 + r);
#pragma unroll
      for (int i = 0; i < 8; ++i) {
        float ang = pos * c_inv[i];
        double rev = (double)ang * 0.15915494309189535;
        rev -= rint(rev);
        float rv = (float)rev;
        float sn = __builtin_amdgcn_sinf(rv), cs = __builtin_amdgcn_cosf(rv);
        o1[i] = x1[i] * cs - x2[i] * sn;
        o2[i] = x2[i] * cs + x1[i] * sn;
      }
      *reinterpret_cast<uint4*>(dst + r * 72) = pack8(o1);
      *reinterpret_cast<uint4*>(dst + r * 72 + 8) = pack8(o2);
    }
  }
}
DEVI void stage_plain(u16* dst, const u16* src, int nrows, int tid) {
  for (int id = tid; id < nrows * 8; id += 256) {
    int r = id >> 3, ch = id & 7;
    *reinterpret_cast<uint4*>(dst + r * 72 + ch * 8) = *reinterpret_cast<const uint4*>(src + (size_t)r * DIN + ch * 8);
  }
}
DEVI void stage_vt(u16* dst, const u16* src, int tid) {
  for (int id = tid; id < 64 * 8; id += 256) {
    int key = id & 63, ch = id >> 6;
    uint4 v = *reinterpret_cast<const uint4*>(src + (size_t)key * DIN + ch * 8);
    u16* d = dst + (ch * 8) * 72 + key;
    d[0 * 72] = (u16)(v.x & 0xffff); d[1 * 72] = (u16)(v.x >> 16);
    d[2 * 72] = (u16)(v.y & 0xffff); d[3 * 72] = (u16)(v.y >> 16);
    d[4 * 72] = (u16)(v.z & 0xffff); d[5 * 72] = (u16)(v.z >> 16);
    d[6 * 72] = (u16)(v.w & 0xffff); d[7 * 72] = (u16)(v.w >> 16);
  }
}

__device__ void phase_win(const Params& p, int g, int layer, char* smem) {
  int nseq, tps, seq0; ginfo(g, nseq, tps, seq0);
  const int ntiles = nseq * tps;
  u16* Qs = (u16*)smem;
  u16* Ks = Qs + 128 * 72;
  u16* Vt = Ks + 64 * 72;
  u16* Ps = Vt + 64 * 72;
  const int tid = otid(), lane = tid & 63, wid = tid >> 6, fr = lane & 15, fq = lane >> 4;
  const float C2 = 0.125f * 1.4426950408889634f;
  const u16* u = (const u16*)(p.ws + OFF_U);
  u16* ymix = (u16*)(p.ws + OFF_YMIX);
  for (int item = (obid() + gridDim.x - 64) % gridDim.x; item < ntiles * 8; item += gridDim.x) {
    const int T = item >> 3, qh = item & 7, kvh = qh >> 2;
    const int sl = T / tps, c = T - sl * tps, Ts0 = sl * tps;
    const int qpos0 = (c == 0) ? 0 : 16 + (c - 1) * 128;
    u32x4 pk[2], pv[2];
    kv_prefetch(pk, pv, u + (size_t)Ts0 * 128 * DIN + C_WK + kvh * 64, u + (size_t)Ts0 * 128 * DIN + C_WV + kvh * 64, tid);
    stage_plain(Qs, u + (size_t)T * 128 * DIN + C_WQ + qh * 64, 128, tid);
    float mrow[2][4], lrow[2][4];
    f32x4 o[2][4];
#pragma unroll
    for (int m = 0; m < 2; ++m) {
#pragma unroll
      for (int j = 0; j < 4; ++j) { mrow[m][j] = -1e30f; lrow[m][j] = 0.f; }
#pragma unroll
      for (int n = 0; n < 4; ++n) o[m][n] = f32x4{0.f, 0.f, 0.f, 0.f};
    }
    int kb = 0;
    while (kb < 7) {
      int kt = 0, half = 0;
      const bool meta = (kb == 0);
      if (!meta) { kt = c - 1 + ((kb - 1) >> 1); half = (kb - 1) & 1; }
      const int kpos0 = (kt == 0) ? 0 : 16 + (kt - 1) * 128 + half * 64;
      kv_commit(pk, pv, Ks, Vt, tid);
      __syncthreads();
      int nkb = kb + 1;
      while (nkb < 7) {
        int kt2 = c - 1 + ((nkb - 1) >> 1);
        if (kt2 >= 1 && kt2 < tps) break;
        ++nkb;
      }
      if (nkb < 7) {
        const int kt2 = c - 1 + ((nkb - 1) >> 1), half2 = (nkb - 1) & 1;
        const size_t krow2 = (size_t)(Ts0 + kt2) * 128 + half2 * 64;
        kv_prefetch(pk, pv, u + krow2 * DIN + C_WK + kvh * 64, u + krow2 * DIN + C_WV + kvh * 64, tid);
      }
      f32x4 s[2][4];
#pragma unroll
      for (int m = 0; m < 2; ++m)
#pragma unroll
        for (int n = 0; n < 4; ++n) s[m][n] = f32x4{0.f, 0.f, 0.f, 0.f};
      wave_mma<2, 4, 2>(s, Qs + (wid * 32) * 72, 72, 16 * 72, Ks, 72, 16 * 72, lane);
#pragma unroll
      for (int m = 0; m < 2; ++m)
#pragma unroll
        for (int j = 0; j < 4; ++j) {
          const int qrow = wid * 32 + 16 * m + fq * 4 + j;
          const int dbase = qpos0 + qrow - kpos0 - fr + 128;
          float mx = mrow[m][j];
#pragma unroll
          for (int n = 0; n < 4; ++n) {
            bool ok = meta ? (n == 0) : ((unsigned)(dbase - 16 * n) <= 256u);
            float v = ok ? s[m][n][j] : -1e30f;
            s[m][n][j] = v;
            mx = fmaxf(mx, v);
          }
          mx = red16_max(mx);
          const float mxc = mx * C2;
          float alpha = __builtin_amdgcn_exp2f(mrow[m][j] * C2 - mxc);
          float rsum = 0.f;
#pragma unroll
          for (int n = 0; n < 4; ++n) {
            float pv = __builtin_amdgcn_exp2f(s[m][n][j] * C2 - mxc);
            rsum += pv;
            Ps[(wid * 32 + 16 * m + fq * 4 + j) * 72 + 16 * n + fr] = f2bf(pv);
          }
          rsum = red16_sum(rsum);
          lrow[m][j] = lrow[m][j] * alpha + rsum;
          mrow[m][j] = mx;
#pragma unroll
          for (int n = 0; n < 4; ++n) o[m][n][j] *= alpha;
        }
      __syncthreads();
      wave_mma<2, 4, 2>(o, Ps + (wid * 32) * 72, 72, 16 * 72, Vt, 72, 16 * 72, lane);
      __syncthreads();
      kb = nkb;
    }
    const float sk = p.sink[layer * 8 + qh];
#pragma unroll
    for (int m = 0; m < 2; ++m)
#pragma unroll
      for (int j = 0; j < 4; ++j) {
        const float ms = mrow[m][j] * 0.125f;
        float mx = fmaxf(ms, sk);
        float a = __expf(ms - mx);
        float l = lrow[m][j] * a + __expf(sk - mx);
        float inv = a / l;
        size_t R = (size_t)T * 128 + wid * 32 + 16 * m + fq * 4 + j;
#pragma unroll
        for (int n = 0; n < 4; ++n) ymix[R * DMIX + 1024 + qh * 64 + 16 * n + fr] = f2bf(o[m][n][j] * inv);
      }
  }
}

__device__ void phase_na(const Params& p, int g, int layer, char* smem) {
  int nseq, tps, seq0; ginfo(g, nseq, tps, seq0);
  const int ntiles = nseq * tps;
  const int rows_total = (tps - 1) * 2;
  u16* Qs = (u16*)smem;
  u16* Ks = Qs + 128 * 72;
  u16* Vt = Ks + 64 * 72;
  u16* Ps = Vt + 64 * 72;
  float* rp = (float*)(Ps + 4 * 32 * 40);
  float* mb = rp + 480;
  const int tid = otid(), lane = tid & 63, wid = tid >> 6, fr = lane & 15, fq = lane >> 4;
  const float C2 = 0.125f * 1.4426950408889634f;
  const u16* u = (const u16*)(p.ws + OFF_U);
  u16* ymix = (u16*)(p.ws + OFF_YMIX);
  for (int item = (obid() + gridDim.x - 96) % gridDim.x; item < ntiles * 8; item += gridDim.x) {
    const int T = item >> 3, h = item & 7;
    const int sl = T / tps, c = T - sl * tps, Ts0 = sl * tps;
    u32x4 pk[2], pv[2];
    kv_prefetch(pk, pv, u + (size_t)Ts0 * 128 * DIN + C_NK + h * 64, u + (size_t)Ts0 * 128 * DIN + C_NV + h * 64, tid);
    stage_plain(Qs, u + (size_t)T * 128 * DIN + C_NQ + h * 64, 128, tid);
    for (int i = tid; i < 465; i += 256) rp[i] = 8.f * p.rpb[(size_t)(layer * 8 + h) * 465 + i];
    if (tid < 16) mb[tid] = 8.f * p.mbias[(layer * 8 + h) * 16 + tid];
    const int r0 = (c == 0) ? 0 : 2 * (c - 1);
    int qr[2], rsm[2];
#pragma unroll
    for (int m = 0; m < 2; ++m) {
      qr[m] = (c == 0) ? 0 : r0 + m;
      rsm[m] = min(max(qr[m] - 4, 0), rows_total - 8);
    }
    const int krlo = rsm[0], krhi = rsm[1] + 7;
    const int kc0w = min(max(16 * wid - 8, 0), 32);
    float mrow[2][4], lrow[2][4];
    f32x4 o[2][4];
#pragma unroll
    for (int m = 0; m < 2; ++m) {
#pragma unroll
      for (int j = 0; j < 4; ++j) { mrow[m][j] = -1e30f; lrow[m][j] = 0.f; }
#pragma unroll
      for (int n = 0; n < 4; ++n) o[m][n] = f32x4{0.f, 0.f, 0.f, 0.f};
    }
    for (int kb = -1; kb <= krhi - krlo; ++kb) {
      const bool meta = kb < 0;
      const int kr = krlo + kb;
      kv_commit(pk, pv, Ks, Vt, tid);
      __syncthreads();
      if (kb < krhi - krlo) {
        const int kr2 = kr + 1;
        const size_t krow2 = (size_t)(Ts0 + 1 + (kr2 >> 1)) * 128 + (kr2 & 1) * 64;
        kv_prefetch(pk, pv, u + krow2 * DIN + C_NK + h * 64, u + krow2 * DIN + C_NV + h * 64, tid);
      }
      const int kc0 = meta ? 0 : kc0w;
      f32x4 s[2][2];
#pragma unroll
      for (int m = 0; m < 2; ++m)
#pragma unroll
        for (int n = 0; n < 2; ++n) s[m][n] = f32x4{0.f, 0.f, 0.f, 0.f};
      wave_mma<2, 2, 2>(s, Qs + (16 * wid) * 72, 72, 64 * 72, Ks + kc0 * 72, 72, 16 * 72, lane);
#pragma unroll
      for (int m = 0; m < 2; ++m) {
        const bool rowok = (kr >= rsm[m]) && (kr <= rsm[m] + 7);
        const int rbase = (kr - qr[m] + 7) * 31 + 15;
#pragma unroll
        for (int j = 0; j < 4; ++j) {
          const int qc = (c == 0) ? 0 : 16 * wid + fq * 4 + j;
          const int qcs = min(max(qc - 8, 0), 48);
          const int kcb = kc0 + fr;
          float mx = mrow[m][j];
#pragma unroll
          for (int n = 0; n < 2; ++n) {
            const int kc = kcb + 16 * n;
            float v = -1e30f;
            if (meta) {
              if (n == 0) v = s[m][n][j] + mb[fr];
            } else if (rowok && (unsigned)(kc - qcs) < 16u) {
              v = s[m][n][j] + rp[rbase + kc - qc];
            }
            s[m][n][j] = v;
            mx = fmaxf(mx, v);
          }
          mx = red16_max(mx);
          const float mxc = mx * C2;
          float alpha = __builtin_amdgcn_exp2f(mrow[m][j] * C2 - mxc);
          float rsum = 0.f;
#pragma unroll
          for (int n = 0; n < 2; ++n) {
            float pv = __builtin_amdgcn_exp2f(s[m][n][j] * C2 - mxc);
            rsum += pv;
            Ps[(wid * 32 + 16 * m + fq * 4 + j) * 40 + 16 * n + fr] = f2bf(pv);
          }
          rsum = red16_sum(rsum);
          lrow[m][j] = lrow[m][j] * alpha + rsum;
          mrow[m][j] = mx;
#pragma unroll
          for (int n = 0; n < 4; ++n) o[m][n][j] *= alpha;
        }
      }
      __syncthreads();
      wave_mma<2, 4, 1>(o, Ps + (wid * 32) * 40, 40, 16 * 40, Vt + kc0, 72, 16 * 72, lane);
      __syncthreads();
    }
#pragma unroll
    for (int m = 0; m < 2; ++m)
#pragma unroll
      for (int j = 0; j < 4; ++j) {
        float inv = 1.f / lrow[m][j];
        size_t R = (size_t)T * 128 + m * 64 + 16 * wid + fq * 4 + j;
#pragma unroll
        for (int n = 0; n < 4; ++n) ymix[R * DMIX + 1536 + h * 64 + 16 * n + fr] = f2bf(o[m][n][j] * inv);
      }
  }
}

__device__ void phase_act(const Params& p, int g, int layer) {
  int nseq, tps, seq0; ginfo(g, nseq, tps, seq0);
  const int ntiles = nseq * tps;
  const int L = (tps - 1) * 128 + 16;
  const u16* gb = (const u16*)(p.ws + OFF_U);
  u16* act = (u16*)(p.ws + OFF_ST);
  const float* cw = p.fconv_w + (size_t)layer * 3 * DUP;
  const float* cb = p.fconv_b + (size_t)layer * DUP;
  const int total = ntiles * 8 * 352;
  for (int id = obid() * 256 + otid(); id < total; id += gridDim.x * 256) {
    const int ch = id % 352, ts = id / 352, seg = ts & 7, T = ts >> 3;
    const int sl = T / tps, c = T - sl * tps;
    const int col = ch * 8;
    const size_t Rseq = (size_t)sl * tps * 128;
    u16* orow = act + ((size_t)T * 128 + seg * 16) * DFF + col;
    const int nvalid = (c > 0) ? 16 : (seg == 0 ? 16 : 0);
    if (nvalid == 0) {
      uint4 z = make_uint4(0, 0, 0, 0);
#pragma unroll 4
      for (int r = 0; r < 16; ++r) *reinterpret_cast<uint4*>(orow + (size_t)r * DFF) = z;
      continue;
    }
    const int pos0 = (c == 0) ? 0 : 16 + (c - 1) * 128 + seg * 16;
    float wg[3][8], wu[3][8], bg[8], bu[8];
#pragma unroll
    for (int j = 0; j < 3; ++j) {
      float4 a0 = *reinterpret_cast<const float4*>(cw + j * DUP + col), a1 = *reinterpret_cast<const float4*>(cw + j * DUP + col + 4);
      float4 c0 = *reinterpret_cast<const float4*>(cw + j * DUP + DFF + col), c1 = *reinterpret_cast<const float4*>(cw + j * DUP + DFF + col + 4);
      wg[j][0] = a0.x; wg[j][1] = a0.y; wg[j][2] = a0.z; wg[j][3] = a0.w; wg[j][4] = a1.x; wg[j][5] = a1.y; wg[j][6] = a1.z; wg[j][7] = a1.w;
      wu[j][0] = c0.x; wu[j][1] = c0.y; wu[j][2] = c0.z; wu[j][3] = c0.w; wu[j][4] = c1.x; wu[j][5] = c1.y; wu[j][6] = c1.z; wu[j][7] = c1.w;
    }
    {
      float4 a0 = *reinterpret_cast<const float4*>(cb + col), a1 = *reinterpret_cast<const float4*>(cb + col + 4);
      float4 c0 = *reinterpret_cast<const float4*>(cb + DFF + col), c1 = *reinterpret_cast<const float4*>(cb + DFF + col + 4);
      bg[0] = a0.x; bg[1] = a0.y; bg[2] = a0.z; bg[3] = a0.w; bg[4] = a1.x; bg[5] = a1.y; bg[6] = a1.z; bg[7] = a1.w;
      bu[0] = c0.x; bu[1] = c0.y; bu[2] = c0.z; bu[3] = c0.w; bu[4] = c1.x; bu[5] = c1.y; bu[6] = c1.z; bu[7] = c1.w;
    }
    float xg[3][8], xu[3][8];
    auto ldrow = [&](int pp, float* dg, float* du) {
      if (pp >= 0 && pp < L) {
        int prow = (pp < 16) ? pp : 112 + pp;
        const u16* sp = gb + (Rseq + prow) * DUP + col;
        uint4 v0 = *reinterpret_cast<const uint4*>(sp), v1 = *reinterpret_cast<const uint4*>(sp + DFF);
        unpack8(v0, dg); unpack8(v1, du);
      } else {
#pragma unroll
        for (int i = 0; i < 8; ++i) { dg[i] = 0.f; du[i] = 0.f; }
      }
    };
    ldrow(pos0 - 1, xg[0], xu[0]); ldrow(pos0, xg[1], xu[1]);
#pragma unroll
    for (int r = 0; r < 16; ++r) {
      ldrow(pos0 + r + 1, xg[(r + 2) % 3], xu[(r + 2) % 3]);
      float res[8];
#pragma unroll
      for (int i = 0; i < 8; ++i) {
        float ga = bg[i], up = bu[i];
#pragma unroll
        for (int j = 0; j < 3; ++j) { ga += xg[(r + j) % 3][i] * wg[j][i]; up += xu[(r + j) % 3][i] * wu[j][i]; }
        float yv = 0.7978845608028654f * (ga + 0.044715f * ga * ga * ga);
        float th = 1.f - 2.f * __builtin_amdgcn_rcpf(__expf(2.f * yv) + 1.f);
        res[i] = 0.5f * ga * (1.f + th) * up;
      }
      *reinterpret_cast<uint4*>(orow + (size_t)r * DFF) = pack8(res);
    }
  }
}

#define XB_TMO      128
#define XB_XCNT(j)  (256  + 64 * (j))
#define XB_XSUB(j)  (1280 + 64 * (j))
#define XB_XGEN(j)  (2304 + 64 * (j))
#define XB_TOP      3328
#define XB_TOPGEN   3392
#define XCD_BAR_WORDS 3456
#define XB_SPIN_CAP (1u << 22)
#define LAS __attribute__((address_space(3)))
DEVI unsigned xb_ld(unsigned* p) { return __hip_atomic_load(p, __ATOMIC_RELAXED, __HIP_MEMORY_SCOPE_AGENT); }
DEVI unsigned xb_add(unsigned* p, unsigned v) { return __hip_atomic_fetch_add(p, v, __ATOMIC_RELAXED, __HIP_MEMORY_SCOPE_AGENT); }
DEVI unsigned xb_xcc_id() { return (unsigned)__builtin_amdgcn_s_getreg((3 << 11) | 20) & 0xFu; }
#define XB_SPIN(cond, bar) do { unsigned _sp = 0; while (cond) { __builtin_amdgcn_s_sleep(1); \
    if ((++_sp & 255u) == 0u) { if (xb_ld(&(bar)[XB_TMO])) break; if (_sp > XB_SPIN_CAP) { atomicAdd(&(bar)[XB_TMO], 1u); break; } } } } while (0)
struct XcdBarrier { unsigned* bar; unsigned x; volatile LAS unsigned* st; };
DEVI XcdBarrier xcd_barrier_post(unsigned* bar, volatile LAS unsigned* st) {
  XcdBarrier b; b.bar = bar; b.x = xb_xcc_id(); b.st = st;
  if (threadIdx.x == 0) (void)xb_add(&bar[XB_XCNT(b.x)], 1u);
  return b;
}
DEVI void xcd_barrier_complete(unsigned* bar, unsigned x, unsigned& nloc, unsigned& nx) {
  const unsigned G = gridDim.x * gridDim.y * gridDim.z;
  unsigned sum, cnt, mine, sp = 0u;
  for (;;) {
    sum = 0u; cnt = 0u; mine = 0u;
#pragma unroll
    for (unsigned j = 0; j < 16; ++j) { const unsigned c = xb_ld(&bar[XB_XCNT(j)]); sum += c; cnt += (c > 0u) ? 1u : 0u; mine = (j == x) ? c : mine; }
    if (sum == G) break;
    __builtin_amdgcn_s_sleep(1);
    if ((++sp & 255u) == 0u) { if (xb_ld(&bar[XB_TMO])) break; if (sp > XB_SPIN_CAP) { atomicAdd(&bar[XB_TMO], 1u); break; } }
  }
  nloc = mine > 0u ? mine : 1u; nx = cnt > 0u ? cnt : 1u;
}
DEVI void xcd_barrier(const XcdBarrier& b) {
  asm volatile("s_waitcnt vmcnt(0)" ::: "memory");
  __syncthreads();
  if (threadIdx.x == 0) {
    unsigned* bar = b.bar;
    __builtin_amdgcn_s_waitcnt(0);
    unsigned nloc = b.st[0], nx = b.st[1];
    if (nloc == 0u) { xcd_barrier_complete(bar, b.x, nloc, nx); b.st[0] = nloc; b.st[1] = nx; }
    const unsigned old = xb_add(&bar[XB_XSUB(b.x)], 1u);
    const unsigned gen = old / nloc;
    if (old + 1u == (gen + 1u) * nloc) {
      __builtin_amdgcn_fence(__ATOMIC_RELEASE, "agent");
      asm volatile("s_waitcnt vmcnt(0)" ::: "memory");
      const unsigned og = xb_add(&bar[XB_TOP], 1u);
      const unsigned tg = og / nx;
      if (og + 1u == (tg + 1u) * nx) xb_add(&bar[XB_TOPGEN], 1u);
      else XB_SPIN(xb_ld(&bar[XB_TOPGEN]) == tg, bar);
      __builtin_amdgcn_fence(__ATOMIC_ACQUIRE, "agent");
      xb_add(&bar[XB_XGEN(b.x)], 1u);
      asm volatile("s_waitcnt vmcnt(0)" ::: "memory");
    } else {
      XB_SPIN(xb_ld(&bar[XB_XGEN(b.x)]) == gen, bar);
      __builtin_amdgcn_fence(__ATOMIC_ACQUIRE, "agent");
      asm volatile("s_waitcnt vmcnt(0)" ::: "memory");
    }
  }
  __syncthreads();
}

#ifndef REP_GEMM
#define REP_GEMM 1
#endif
#ifndef REP_SSD
#define REP_SSD 1
#endif
#ifndef REP_WIN
#define REP_WIN 1
#endif
#ifndef REP_NA
#define REP_NA 1
#endif
#ifndef REP_EW
#define REP_EW 1
#endif
__global__ void __launch_bounds__(256, 2) mega(Params p) {
  extern __shared__ __attribute__((aligned(16))) char smem[];
  cg::grid_group grid = cg::this_grid();
  __shared__ uint4 xb_words;
  if (threadIdx.x == 0) xb_words = make_uint4(0u, 0u, 0u, 0u);
  __syncthreads();
  XcdBarrier xb = xcd_barrier_post((unsigned*)(p.ws + OFF_BAR), (volatile LAS unsigned*)&xb_words);
#pragma unroll 1
  for (int step = 0; step < 93; ++step) {
    int ph = 100, g = 0, layer = 0;
    if (step > 0) {
      int s = step - 1;
      g = s / 23;
      int r = s - g * 23;
      if (r == 0) ph = 101;
      else { layer = (r - 1) / 11; ph = (r - 1) - layer * 11; }
    }
    int nseq, tps, seq0; ginfo(g, nseq, tps, seq0);
    const int ntm = nseq * (tps - 1), tpr = tps - 1;
    if (step == 1) continue;
    if (ph == 100) {
      phase_prep(p, smem);
      phase_rowupd(p, 0, 0, (const u16*)(p.ws + OFF_U), nullptr);
    } else if (ph == 101 || ph == 6 || ph == 10) {
      const float* w = (ph == 6) ? p.n_mix_post + layer * DM : p.n_ffn_post + layer * DM;
      const int mode = (ph == 101) ? 0 : ((ph == 10 && layer == 1) ? 2 : 1);
      phase_rowupd(p, g, mode, (const u16*)(p.ws + OFF_U), w);
    } else if (ph == 0 || ph == 7) {
      const u16* Bt = (ph == 0) ? (const u16*)(p.ws + OFF_WIN) + (size_t)layer * DINP * DM
                                : (const u16*)(p.ws + OFF_WUP) + (size_t)layer * DUP * DM;
      const int nv = (ph == 0) ? DIN : DUP;
      for (int rep = 0; rep < REP_GEMM; ++rep) {
        phase_gemm_w<0>((const u16*)(p.ws + OFF_HB), DM, Bt, DM, ntm, 20, (ph == 0) ? DIN : 5120,
                        (const float*)(p.ws + OFF_RS), (u16*)(p.ws + OFF_U), nv, tpr, nullptr, smem);
        if (ph == 7)
          phase_gemm<0>((const u16*)(p.ws + OFF_HB), DM, Bt + (size_t)5120 * DM, DM, ntm, 4, 512,
                        (const float*)(p.ws + OFF_RS), (u16*)(p.ws + OFF_U) + 5120, nv, tpr, nullptr, smem);
        phase_gemm_meta<0>((const u16*)(p.ws + OFF_HB), DM, Bt, DM, nseq, tps, nv / 16, (const float*)(p.ws + OFF_RS),
                           (u16*)(p.ws + OFF_U), nv, nullptr);
      }
    } else if (ph == 5 || ph == 9) {
      const u16* A = (ph == 5) ? (const u16*)(p.ws + OFF_YMIX) : (const u16*)(p.ws + OFF_ST);
      const u16* Bt = (ph == 5) ? (const u16*)(p.ws + OFF_WOUT) + (size_t)layer * DM * DMIX
                                : (const u16*)(p.ws + OFF_WDN) + (size_t)layer * DM * DFF;
      const int K = (ph == 5) ? DMIX : DFF;
      const float* ssqk = (ph == 5) ? (const float*)(p.ws + OFF_SSQA) : nullptr;
      for (int rep = 0; rep < REP_GEMM; ++rep) {
        phase_gemm_w<1>(A, K, Bt, K, ntm, 4, DM, nullptr, (u16*)(p.ws + OFF_U), DM, tpr, ssqk, smem);
        phase_gemm_meta<1>(A, K, Bt, K, nseq, tps, DM / 16, nullptr, (u16*)(p.ws + OFF_U), DM, ssqk);
      }
    } else if (ph == 1) {
      for (int rep = 0; rep < REP_EW; ++rep) phase_conv(p, g, layer);
      phase_rope(p, g);
    } else if (ph == 2) {
      for (int rep = 0; rep < REP_SSD; ++rep) phase_ssdA(p, g, layer, smem);
    } else if (ph == 3) {
      phase_scan(p, g);
    } else if (ph == 4) {
      for (int rep = 0; rep < REP_SSD; ++rep) phase_ssdC(p, g, layer, smem);
      for (int rep = 0; rep < REP_WIN; ++rep) phase_win(p, g, layer, smem);
      for (int rep = 0; rep < REP_NA; ++rep) phase_na(p, g, layer, smem);
    } else if (ph == 8) {
      for (int rep = 0; rep < REP_EW; ++rep) phase_act(p, g, layer);
    }
    if (step == 0) grid.sync();
    else if (step < 92) xcd_barrier(xb);
  }
}

extern "C" void kernel_launch(void* const* d_in, const int* in_sizes, int n_in, void* d_out, int out_size,
                              void* d_ws, size_t ws_size, hipStream_t stream) {
  static int grid_blocks = 0;
  if (!grid_blocks) {
    int dev = 0, cus = 0, per_cu = 0;
    hipGetDevice(&dev);
    hipDeviceGetAttribute(&cus, hipDeviceAttributeMultiprocessorCount, dev);
    hipFuncSetAttribute((const void*)mega, hipFuncAttributeMaxDynamicSharedMemorySize, LDS_BYTES);
    hipOccupancyMaxActiveBlocksPerMultiprocessor(&per_cu, mega, 256, LDS_BYTES);
    if (per_cu > 2) per_cu = 2;
    if (per_cu < 1) per_cu = 1;
    grid_blocks = cus * per_cu;
  }
  Params p{};
  const float* const* in = (const float* const*)d_in;
  p.xp = in[0]; p.xs = in[1]; p.meta = in[2]; p.n_mix_pre = in[3]; p.n_mix_post = in[4]; p.w_in = in[5];
  p.conv_w = in[6]; p.conv_b = in[7]; p.dt_bias = in[8]; p.a_log = in[9]; p.ssd_d = in[10]; p.ssd_nw = in[11];
  p.sink = in[12]; p.rpb = in[13]; p.mbias = in[14]; p.w_out = in[15]; p.n_ffn_pre = in[16]; p.n_ffn_post = in[17];
  p.w_up = in[18]; p.fconv_w = in[19]; p.fconv_b = in[20]; p.w_down = in[21];
  p.out = (float*)d_out; p.ws = (char*)d_ws;
  if (ws_size < WS_NEED) fprintf(stderr, "workspace too small: %zu < %zu\n", ws_size, (size_t)WS_NEED);
  hipMemsetAsync((char*)d_ws + OFF_BAR, 0, XCD_BAR_WORDS * 4, stream);
  void* args[] = {&p};
  hipError_t e = hipLaunchCooperativeKernel((void*)mega, dim3(grid_blocks), dim3(256), args, LDS_BYTES, stream);
  if (e != hipSuccess) fprintf(stderr, "cooperative launch failed: %s (grid %d)\n", hipGetErrorString(e), grid_blocks);
}
```

```cpp
#include <hip/hip_runtime.h>
#include <hip/hip_cooperative_groups.h>
#include <cstdio>
namespace cg = cooperative_groups;

typedef unsigned short u16;
typedef __attribute__((ext_vector_type(8))) short bf16x8;
typedef __attribute__((ext_vector_type(4))) float f32x4;
typedef __attribute__((ext_vector_type(4))) unsigned int u32x4;
#define DEVI __device__ __forceinline__

constexpr int DM = 1024, DIN = 4896, DINP = 5120, DMIX = 2048, DFF = 2816, DUP = 5632;
constexpr int C_XBC = 1024, C_DT = 2560, C_WQ = 2592, C_WK = 3104, C_WV = 3232, C_NQ = 3360, C_NK = 3872, C_NV = 4384;
constexpr size_t RMAX = 16896;
constexpr int TMAX = 132;
constexpr float EPS = 1e-6f;
constexpr int LDS_BYTES = 77824;

constexpr size_t SZ_WIN = (size_t)2 * DINP * DM * 2;
constexpr size_t SZ_WOUT = (size_t)2 * DM * DMIX * 2;
constexpr size_t SZ_WUP = (size_t)2 * DUP * DM * 2;
constexpr size_t SZ_WDN = (size_t)2 * DM * DFF * 2;
constexpr size_t OFF_WIN = 0;
constexpr size_t OFF_WOUT = OFF_WIN + SZ_WIN;
constexpr size_t OFF_WUP = OFF_WOUT + SZ_WOUT;
constexpr size_t OFF_WDN = OFF_WUP + SZ_WUP;
constexpr size_t OFF_HMETA = OFF_WDN + SZ_WDN;
constexpr size_t OFF_HB = OFF_HMETA + (size_t)10 * 16 * DM * 4;
constexpr size_t OFF_U = OFF_HB + RMAX * DM * 2;
constexpr size_t OFF_XC = OFF_U + RMAX * DIN * 2;
constexpr size_t OFF_DT = OFF_XC + RMAX * 1536 * 2;
constexpr size_t OFF_ST = OFF_DT + RMAX * 32 * 4;
constexpr size_t OFF_YMIX = OFF_ST + (size_t)TMAX * 16 * 2 * 8192 * 2;
constexpr size_t OFF_SSQA = OFF_YMIX + RMAX * DMIX * 2;
constexpr size_t OFF_SSQB = OFF_SSQA + RMAX * 16 * 4;
constexpr size_t OFF_RS = OFF_SSQB + RMAX * 16 * 4;
constexpr size_t OFF_DEC = OFF_RS + RMAX * 4;
constexpr size_t WS_TOTAL = OFF_DEC + (size_t)TMAX * 16 * 2 * 4;
constexpr size_t OFF_BAR = (WS_TOTAL + 255) / 256 * 256;
constexpr size_t WS_NEED = OFF_BAR + 3456 * 4;
static_assert(RMAX * DUP * 2 <= RMAX * DIN * 2 + RMAX * 1536 * 2, "g alias");
static_assert(RMAX * DFF * 2 <= (size_t)TMAX * 16 * 2 * 8192 * 2 + RMAX * DMIX * 2, "act alias");
static_assert(WS_NEED < (size_t)512 * 1024 * 1024, "ws");

__constant__ float c_inv[8] = {1.0f, 0.1939227447486858f, 0.03760603093086394f, 0.007292664737217109f,
                               0.0014142135623730955f, 0.00027424817567620724f, 5.318295896944988e-05f,
                               1.0313385377212461e-05f};

struct Params {
  const float *xp, *xs, *meta, *n_mix_pre, *n_mix_post, *w_in, *conv_w, *conv_b, *dt_bias, *a_log, *ssd_d, *ssd_nw,
      *sink, *rpb, *mbias, *w_out, *n_ffn_pre, *n_ffn_post, *w_up, *fconv_w, *fconv_b, *w_down;
  float* out;
  char* ws;
};

typedef __attribute__((ext_vector_type(2))) __bf16 bf16x2_t;
typedef __attribute__((ext_vector_type(2))) float f32x2_t;
DEVI unsigned cvt_pk_bf16(float a, float b) {
  f32x2_t v = {a, b};
  return __builtin_bit_cast(unsigned, __builtin_convertvector(v, bf16x2_t));
}
DEVI u16 f2bf(float f) { return (u16)(cvt_pk_bf16(f, 0.f) & 0xffffu); }
DEVI float bf2f(u16 h) { return __uint_as_float(((unsigned)h) << 16); }
DEVI float silu_f(float x) { return x * __builtin_amdgcn_rcpf(1.f + __expf(-x)); }
DEVI void unpack8(uint4 v, float* f) {
  f[0] = __uint_as_float(v.x << 16); f[1] = __uint_as_float(v.x & 0xffff0000u);
  f[2] = __uint_as_float(v.y << 16); f[3] = __uint_as_float(v.y & 0xffff0000u);
  f[4] = __uint_as_float(v.z << 16); f[5] = __uint_as_float(v.z & 0xffff0000u);
  f[6] = __uint_as_float(v.w << 16); f[7] = __uint_as_float(v.w & 0xffff0000u);
}
DEVI unsigned pack2(float a, float b) { return cvt_pk_bf16(a, b); }
DEVI uint4 pack8(const float* f) {
  uint4 v; v.x = pack2(f[0], f[1]); v.y = pack2(f[2], f[3]); v.z = pack2(f[4], f[5]); v.w = pack2(f[6], f[7]);
  return v;
}
DEVI void ginfo(int g, int& nseq, int& tps, int& seq0) {
  if (g < 2) { nseq = 4; tps = 33; seq0 = 4 * g; } else { nseq = 1; tps = 129; seq0 = 8 + (g - 2); }
}
DEVI size_t seq_outrow(int seq) { return seq < 8 ? (size_t)seq * 4096 : (size_t)32768 + (size_t)(seq - 8) * 16384; }
template <int N>
DEVI float dpp_ror(float v) {
  return __builtin_bit_cast(float, __builtin_amdgcn_update_dpp(0, __builtin_bit_cast(int, v), 0x120 + N, 0xf, 0xf, false));
}
DEVI float red16_sum(float v) {
  v += dpp_ror<8>(v); v += dpp_ror<4>(v); v += dpp_ror<2>(v); v += dpp_ror<1>(v); return v;
}
DEVI float red16_max(float v) {
  v = fmaxf(v, dpp_ror<8>(v)); v = fmaxf(v, dpp_ror<4>(v)); v = fmaxf(v, dpp_ror<2>(v)); v = fmaxf(v, dpp_ror<1>(v));
  return v;
}
DEVI float red64_sum(float v) {
  v = red16_sum(v);
  v += __shfl_xor(v, 16); v += __shfl_xor(v, 32); return v;
}

DEVI int otid() { int t = threadIdx.x; asm volatile("" : "+v"(t)); return t; }
DEVI int obid() { return blockIdx.x; }

template <int MT, int NT, int KT>
DEVI void wave_mma(f32x4 (&acc)[MT][NT], const u16* A, int lda, int mstep, const u16* B, int ldb, int nstep, int lane) {
  const int fr = lane & 15, fq = lane >> 4;
  const u16* ap = A + fr * lda + fq * 8;
  const u16* bp = B + fr * ldb + fq * 8;
#pragma unroll
  for (int ks = 0; ks < KT; ++ks) {
    bf16x8 a[MT], b[NT];
#pragma unroll
    for (int m = 0; m < MT; ++m) a[m] = *reinterpret_cast<const bf16x8*>(ap + m * mstep + ks * 32);
#pragma unroll
    for (int n = 0; n < NT; ++n) b[n] = *reinterpret_cast<const bf16x8*>(bp + n * nstep + ks * 32);
    __builtin_amdgcn_s_setprio(1);
#pragma unroll
    for (int m = 0; m < MT; ++m)
#pragma unroll
      for (int n = 0; n < NT; ++n) acc[m][n] = __builtin_amdgcn_mfma_f32_16x16x32_bf16(a[m], b[n], acc[m][n], 0, 0, 0);
    __builtin_amdgcn_s_setprio(0);
  }
}

__device__ void prep_one(const float* src, u16* dst, int K, int N, int tk, int tn, const float* kscale, int klim,
                         char* smem) {
  float* tile = (float*)smem;
  const int tid = otid();
  const int k0 = tk * 64, n0 = tn * 64;
#pragma unroll 4
  for (int i = 0; i < 16; ++i) {
    int k = i * 4 + (tid >> 6), n = tid & 63;
    float v = 0.f;
    if (n0 + n < N) {
      v = src[(size_t)(k0 + k) * N + n0 + n];
      if (kscale && (k0 + k) < klim) v *= kscale[k0 + k];
    }
    tile[k * 65 + n] = v;
  }
  __syncthreads();
#pragma unroll 4
  for (int i = 0; i < 16; ++i) {
    int n = i * 4 + (tid >> 6), k = tid & 63;
    dst[(size_t)(n0 + n) * K + k0 + k] = f2bf(tile[k * 65 + n]);
  }
  __syncthreads();
}

__device__ void phase_prep(const Params& p, char* smem) {
  for (int it = obid(); it < 2 * 3904; it += gridDim.x) {
    int layer = it / 3904, r = it % 3904;
    if (r < 1280) {
      prep_one(p.w_in + (size_t)layer * DM * DIN, (u16*)(p.ws + OFF_WIN) + (size_t)layer * DINP * DM, DM, DIN, r / 80,
               r % 80, p.n_mix_pre + layer * DM, DM, smem);
    } else if (r < 1792) {
      r -= 1280;
      prep_one(p.w_out + (size_t)layer * DMIX * DM, (u16*)(p.ws + OFF_WOUT) + (size_t)layer * DM * DMIX, DMIX, DM,
               r / 16, r % 16, p.ssd_nw + layer * 1024, 1024, smem);
    } else if (r < 3200) {
      r -= 1792;
      prep_one(p.w_up + (size_t)layer * DM * DUP, (u16*)(p.ws + OFF_WUP) + (size_t)layer * DUP * DM, DM, DUP, r / 88,
               r % 88, p.n_ffn_pre + layer * DM, DM, smem);
    } else {
      r -= 3200;
      prep_one(p.w_down + (size_t)layer * DFF * DM, (u16*)(p.ws + OFF_WDN) + (size_t)layer * DM * DFF, DFF, DM, r / 16,
               r % 16, nullptr, 0, smem);
    }
  }
}

__device__ void phase_rowupd(const Params& p, int g, int mode, const u16* src, const float* w) {
  int nseq, tps, seq0; ginfo(g, nseq, tps, seq0);
  const int nrows = nseq * tps * 128;
  const int tid_ = otid(); const int lane = tid_ & 63, wid = tid_ >> 6;
  u16* hb = (u16*)(p.ws + OFF_HB);
  float* rs = (float*)(p.ws + OFF_RS);
  for (int Rp = obid() * 8 + wid * 2; Rp < nrows; Rp += gridDim.x * 8) {
    const int T = Rp >> 7, r = Rp & 127, sl = T / tps, c = T - sl * tps, seq = seq0 + sl;
    u16* hbrow = hb + (size_t)Rp * DM;
    const bool valid = (c > 0) || (r < 16);
    if (!valid) {
      if (mode == 0) {
        uint4 z = make_uint4(0, 0, 0, 0);
#pragma unroll
        for (int q = 0; q < 2; ++q) {
          *reinterpret_cast<uint4*>(hbrow + q * DM + lane * 16) = z;
          *reinterpret_cast<uint4*>(hbrow + q * DM + lane * 16 + 8) = z;
        }
        if (lane < 2) rs[Rp + lane] = 0.f;
      }
      continue;
    }
    if (mode == 2 && c == 0) continue;
    float4 v[2][4];
    if (mode == 0) {
      const float* xr;
      if (c == 0) xr = p.meta + (size_t)r * DM;
      else if (seq < 8) xr = p.xp + ((size_t)seq * 4096 + (size_t)(c - 1) * 128 + r) * DM;
      else xr = p.xs + ((size_t)(seq - 8) * 16384 + (size_t)(c - 1) * 128 + r) * DM;
#pragma unroll
      for (int q = 0; q < 2; ++q)
#pragma unroll
        for (int i = 0; i < 4; ++i) v[q][i] = *reinterpret_cast<const float4*>(xr + q * DM + lane * 4 + i * 256);
    } else {
      const u16* sr = src + (size_t)Rp * DM;
      uint2 sv[2][4], hv[2][4];
      float4 wv[4];
#pragma unroll
      for (int q = 0; q < 2; ++q)
#pragma unroll
        for (int i = 0; i < 4; ++i) {
          sv[q][i] = *reinterpret_cast<const uint2*>(sr + q * DM + lane * 4 + i * 256);
          hv[q][i] = *reinterpret_cast<const uint2*>(hbrow + q * DM + lane * 4 + i * 256);
        }
#pragma unroll
      for (int i = 0; i < 4; ++i) wv[i] = *reinterpret_cast<const float4*>(w + lane * 4 + i * 256);
#pragma unroll
      for (int q = 0; q < 2; ++q) {
        float tot = 0.f;
#pragma unroll
        for (int i = 0; i < 4; ++i) {
          float a0 = __uint_as_float(sv[q][i].x << 16), a1 = __uint_as_float(sv[q][i].x & 0xffff0000u);
          float a2 = __uint_as_float(sv[q][i].y << 16), a3 = __uint_as_float(sv[q][i].y & 0xffff0000u);
          tot += a0 * a0 + a1 * a1 + a2 * a2 + a3 * a3;
        }
        tot = red64_sum(tot);
        const float sc = rsqrtf(tot * (1.f / 1024.f) + EPS);
#pragma unroll
        for (int i = 0; i < 4; ++i) {
          float4 o;
          o.x = __uint_as_float(hv[q][i].x << 16) + __uint_as_float(sv[q][i].x << 16) * sc * wv[i].x;
          o.y = __uint_as_float(hv[q][i].x & 0xffff0000u) + __uint_as_float(sv[q][i].x & 0xffff0000u) * sc * wv[i].y;
          o.z = __uint_as_float(hv[q][i].y << 16) + __uint_as_float(sv[q][i].y << 16) * sc * wv[i].z;
          o.w = __uint_as_float(hv[q][i].y & 0xffff0000u) + __uint_as_float(sv[q][i].y & 0xffff0000u) * sc * wv[i].w;
          v[q][i] = o;
        }
      }
    }
    if (mode == 2) {
      float* op = p.out + (seq_outrow(seq) + (size_t)(c - 1) * 128 + r) * DM;
#pragma unroll
      for (int q = 0; q < 2; ++q)
#pragma unroll
        for (int i = 0; i < 4; ++i) *reinterpret_cast<float4*>(op + q * DM + lane * 4 + i * 256) = v[q][i];
      continue;
    }
#pragma unroll
    for (int q = 0; q < 2; ++q) {
      float ss = 0.f;
#pragma unroll
      for (int i = 0; i < 4; ++i) {
        ss += v[q][i].x * v[q][i].x + v[q][i].y * v[q][i].y + v[q][i].z * v[q][i].z + v[q][i].w * v[q][i].w;
        uint2 bb; bb.x = pack2(v[q][i].x, v[q][i].y); bb.y = pack2(v[q][i].z, v[q][i].w);
        *reinterpret_cast<uint2*>(hbrow + q * DM + lane * 4 + i * 256) = bb;
      }
      ss = red64_sum(ss);
      if (lane == 0) rs[Rp + q] = rsqrtf(ss * (1.f / 1024.f) + EPS);
    }
  }
}

struct GemmCursor { int it, kt; const u16* ap; const u16* bp; };
struct GemmMap { int bid, G, ntm, ntn, ntnp, swz, ni; };
DEVI int gemm_T(int tm, int tpr) { return tm + tm / tpr + 1; }
DEVI bool gemm_map(const GemmMap& M, int it, int& tm, int& tn) {
  if (M.swz == 2) {
    const int xcd = M.bid & 7, j = M.bid >> 3;
    const int P = it * 8 + xcd;
    const int ptm = P / M.ntnp, ptn = P - ptm * M.ntnp;
    tm = ptm * 8 + (j & 7);
    tn = ptn * 8 + (j >> 3);
    bool v = tn < M.ntn;
    if (!v) tn = M.ntn - 1;
    return v;
  }
  if (M.swz) {
    const int xcd = M.bid & 7, j = M.bid >> 3, half = j >> 5, q = j & 31;
    const int P = (it * 8 + xcd) * 2 + half;
    const int ptm = P / M.ntnp, ptn = P - ptm * M.ntnp;
    tm = ptm * 8 + (q & 7);
    tn = ptn * 4 + (q >> 3);
    bool v = tn < M.ntn;
    if (!v) tn = M.ntn - 1;
    return v;
  }
  int item = M.bid + it * M.G;
  bool v = item < M.ntm * M.ntn;
  if (!v) item = M.ntm * M.ntn - 1;
  tm = item / M.ntn; tn = item - tm * M.ntn;
  return v;
}
DEVI void gemm_gload(u32x4 (&RA)[4], u32x4 (&RB)[4], GemmCursor& L, const GemmMap& M, const u16* A, int lda, const u16* Bt,
                     int K, int nk, int lrow, int lkc, int tpr) {
#pragma unroll
  for (int i = 0; i < 4; ++i) {
    RA[i] = *reinterpret_cast<const u32x4*>(L.ap + (size_t)(32 * i) * lda);
    RB[i] = *reinterpret_cast<const u32x4*>(L.bp + (size_t)(32 * i) * K);
  }
  L.ap += 64; L.bp += 64;
  if (++L.kt == nk) {
    L.kt = 0;
    if (L.it + 1 < M.ni) L.it += 1;
    int tm_, tn_;
    gemm_map(M, L.it, tm_, tn_);
    L.ap = A + ((size_t)gemm_T(tm_, tpr) * 128 + lrow) * lda + lkc * 8;
    L.bp = Bt + ((size_t)tn_ * 128 + lrow) * K + lkc * 8;
  }
}
DEVI void gemm_sstore(const u32x4 (&RA)[4], const u32x4 (&RB)[4], char* As, char* Bs, const int (&soff)[4]) {
#pragma unroll
  for (int i = 0; i < 4; ++i) {
    *reinterpret_cast<u32x4*>(As + soff[i]) = RA[i];
    *reinterpret_cast<u32x4*>(Bs + soff[i]) = RB[i];
  }
}
DEVI void gemm_frags(bf16x8 (&a_)[2][4], bf16x8 (&b_)[2][4], const char* As, const char* Bs, const int (&aoff)[2],
                     const int (&boff)[2]) {
#pragma unroll
  for (int ks = 0; ks < 2; ++ks) {
#pragma unroll
    for (int m = 0; m < 4; ++m) a_[ks][m] = *reinterpret_cast<const bf16x8*>(As + aoff[ks] + m * 256);
#pragma unroll
    for (int n = 0; n < 4; ++n) b_[ks][n] = *reinterpret_cast<const bf16x8*>(Bs + boff[ks] + n * 256);
  }
}
template <int KS>
DEVI void gemm_mfma(f32x4 (&acc)[4][4], const bf16x8 (&a_)[2][4], const bf16x8 (&b_)[2][4]) {
  __builtin_amdgcn_s_setprio(1);
#pragma unroll
  for (int m = 0; m < 4; ++m)
#pragma unroll
    for (int n = 0; n < 4; ++n)
      acc[m][n] = __builtin_amdgcn_mfma_f32_16x16x32_bf16(a_[KS][m], b_[KS][n], acc[m][n], 0, 0, 0);
  __builtin_amdgcn_s_setprio(0);
}

template <int MODE>
__device__ void phase_gemm(const u16* __restrict__ A, int lda, const u16* __restrict__ Bt, int K, int ntm, int ntn,
                           int nvalid, const float* rowscale, u16* outb, int ldo, int tpr,
                           const float* ssqk, char* smem) {
  char* As = smem;
  char* Bs = smem + 32768;
  float* rsv = (float*)(smem + 65536);
  const int tid = otid(), lane = tid & 63, wid = tid >> 6, wr = wid >> 1, wc = wid & 1;
  const int fr = lane & 15, fq = lane >> 4;
  u16* Cw = (u16*)(smem + 66048) + wid * (16 * 72);
  const int lrow = tid >> 3, lkc = tid & 7;
  const int nk = K / 64;
  GemmMap M;
  M.bid = obid(); M.G = gridDim.x; M.ntm = ntm; M.ntn = ntn; M.ntnp = (ntn + 3) >> 2;
  M.swz = (M.G == 512 && ntm == 128) ? 1 : 0;
  if (M.swz && ((ntn + 7) >> 3) * 2 == M.ntnp) { M.swz = 2; M.ntnp = (ntn + 7) >> 3; }
  M.ni = (M.swz == 2) ? 2 * M.ntnp : (M.swz ? M.ntnp : (ntm * ntn + M.G - 1) / M.G);
  const int S = M.ni * nk;
  int soff[4];
#pragma unroll
  for (int i = 0; i < 4; ++i) soff[i] = lkc * 2048 + (((lrow + 32 * i) ^ lkc) * 16);
  int aoff[2], boff[2];
#pragma unroll
  for (int ks = 0; ks < 2; ++ks) {
    int kc = ks * 4 + fq;
    aoff[ks] = kc * 2048 + ((wr * 64 + (fr ^ kc)) * 16);
    boff[ks] = kc * 2048 + ((wc * 64 + (fr ^ kc)) * 16);
  }
  GemmCursor L;
  L.it = 0; L.kt = 0;
  {
    int tm, tn;
    gemm_map(M, 0, tm, tn);
    L.ap = A + ((size_t)gemm_T(tm, tpr) * 128 + lrow) * lda + lkc * 8;
    L.bp = Bt + ((size_t)tn * 128 + lrow) * K + lkc * 8;
  }
  u32x4 r0a[4], r0b[4], r1a[4], r1b[4];
  f32x4 acc[4][4];
#define GLOAD(RA, RB) gemm_gload(RA, RB, L, M, A, lda, Bt, K, nk, lrow, lkc, tpr)
#define SSTORE(RA, RB, BUF) gemm_sstore(RA, RB, As + (BUF) * 16384, Bs + (BUF) * 16384, soff)
#define FRAGS(BUF) gemm_frags(fa, fb, As + (BUF) * 16384, Bs + (BUF) * 16384, aoff, boff)
#define MFMAS(KS) gemm_mfma<KS>(acc, fa, fb)
  bf16x8 fa[2][4], fb[2][4];
  int cit = 0, ckt = 0;
  float rs_reg = 0.f;
  GLOAD(r0a, r0b);
  GLOAD(r1a, r1b);
  SSTORE(r0a, r0b, 0);
  __syncthreads();
  for (int s = 0; s < S; s += 2) {
    FRAGS(0);
    if (ckt == 0) {
#pragma unroll
      for (int m = 0; m < 4; ++m)
#pragma unroll
        for (int n = 0; n < 4; ++n) acc[m][n] = f32x4{0.f, 0.f, 0.f, 0.f};
      if (MODE == 0 && tid < 128) {
        int tmr_, tn_;
        gemm_map(M, cit, tmr_, tn_);
        rs_reg = rowscale[(size_t)gemm_T(tmr_, tpr) * 128 + tid];
      }
      if (MODE == 1 && ssqk != nullptr && tid < 128) {
        int tmr_, tn_;
        gemm_map(M, cit, tmr_, tn_);
        const int tm = gemm_T(tmr_, tpr);
        const float* q = ssqk + ((size_t)tm * 128 + tid) * 16;
        float t = 0.f;
#pragma unroll
        for (int i = 0; i < 16; ++i) t += q[i];
        rsv[tid] = rsqrtf(t * (1.f / 1024.f) + EPS);
      }
    }
    if (MODE == 0 && ckt == 2 && tid < 128) rsv[tid] = rs_reg;
    if (MODE == 1 && ssqk != nullptr && ckt == 16) {
#pragma unroll
      for (int m = 0; m < 4; ++m)
#pragma unroll
        for (int j = 0; j < 4; ++j) {
          float sc = rsv[wr * 64 + m * 16 + fq * 4 + j];
#pragma unroll
          for (int n = 0; n < 4; ++n) acc[m][n][j] *= sc;
        }
    }
    SSTORE(r1a, r1b, 1);
    MFMAS(0);
    MFMAS(1);
    GLOAD(r0a, r0b);
    __syncthreads();
    FRAGS(1);
    SSTORE(r0a, r0b, 0);
    MFMAS(0);
    MFMAS(1);
    GLOAD(r1a, r1b);
    ckt += 2;
    if (ckt == nk) {
      int tmr, tn;
      const bool valid = gemm_map(M, cit, tmr, tn);
      const int tm = gemm_T(tmr, tpr);
      if (!valid) {
      } else if (MODE == 0) {
#pragma unroll
        for (int m = 0; m < 4; ++m) {
#pragma unroll
          for (int j = 0; j < 4; ++j) {
            float sc = rsv[wr * 64 + m * 16 + fq * 4 + j];
#pragma unroll
            for (int n = 0; n < 4; ++n) Cw[(fq * 4 + j) * 72 + n * 16 + fr] = f2bf(acc[m][n][j] * sc);
          }
#pragma unroll
          for (int i = 0; i < 2; ++i) {
            int c = lane + 64 * i, row = c >> 3, ch = c & 7;
            int col = tn * 128 + wc * 64 + ch * 8;
            uint4 v = *reinterpret_cast<const uint4*>(Cw + row * 72 + ch * 8);
            if (col < nvalid)
              *reinterpret_cast<uint4*>(outb + ((size_t)tm * 128 + wr * 64 + m * 16 + row) * ldo + col) = v;
          }
        }
      } else {
#pragma unroll
        for (int m = 0; m < 4; ++m) {
#pragma unroll
          for (int j = 0; j < 4; ++j) {
#pragma unroll
            for (int n = 0; n < 4; ++n) Cw[(fq * 4 + j) * 72 + n * 16 + fr] = f2bf(acc[m][n][j]);
          }
#pragma unroll
          for (int i = 0; i < 2; ++i) {
            int c = lane + 64 * i, row = c >> 3, ch = c & 7;
            int col = tn * 128 + wc * 64 + ch * 8;
            uint4 v = *reinterpret_cast<const uint4*>(Cw + row * 72 + ch * 8);
            *reinterpret_cast<uint4*>(outb + ((size_t)tm * 128 + wr * 64 + m * 16 + row) * ldo + col) = v;
          }
        }
      }
      cit += 1; ckt = 0;
    }
    __syncthreads();
  }
#undef GLOAD
#undef SSTORE
#undef FRAGS
#undef MFMAS
}

template <int MODE>
__device__ void phase_gemm_w(const u16* __restrict__ A, int lda, const u16* __restrict__ Bt, int K, int ntm, int ntn,
                             int nvalid, const float* rowscale, u16* outb, int ldo, int tpr,
                             const float* ssqk, char* smem) {
  char* As = smem;
  char* Bs = smem + 16384;
  float* rsv = (float*)(smem + 49152);
  const int tid = otid(), lane = tid & 63, wid = tid >> 6, wr = wid >> 1, wc = wid & 1;
  const int fr = lane & 15, fq = lane >> 4;
  u16* Cw = (u16*)(smem + 49664) + wid * (16 * 136);
  const int lrow = tid >> 2, lkc = tid & 3;
  const int nk = K / 32;
  GemmMap M;
  M.bid = obid(); M.G = gridDim.x; M.ntm = ntm; M.ntn = ntn; M.ntnp = (ntn + 3) >> 2;
  M.swz = (M.G == 512 && ntm == 128) ? 1 : 0;
  M.ni = M.swz ? M.ntnp : (ntm * ntn + M.G - 1) / M.G;
  const int S = M.ni * nk;
  const int sa0 = lkc * 2048 + ((lrow ^ (lkc << 1)) * 16);
  const int sb0 = lkc * 4096 + ((lrow ^ (lkc << 1)) * 16);
  const int aoff = fq * 2048 + ((wr * 64 + (fr ^ (fq << 1))) * 16);
  const int boff = fq * 4096 + ((wc * 128 + (fr ^ (fq << 1))) * 16);
  int lit = 0, lkt = 0;
  const u16* ap; const u16* bp;
  {
    int tm, tn;
    gemm_map(M, 0, tm, tn);
    ap = A + ((size_t)gemm_T(tm, tpr) * 128 + lrow) * lda + lkc * 8;
    bp = Bt + ((size_t)tn * 256 + lrow) * K + lkc * 8;
  }
  u32x4 ra[2], rb[4];
  f32x4 acc[4][8];
  bf16x8 fa[4], fb[8];
  auto gload = [&]() __attribute__((always_inline)) {
#pragma unroll
    for (int i = 0; i < 2; ++i) ra[i] = *reinterpret_cast<const u32x4*>(ap + (size_t)(64 * i) * lda);
#pragma unroll
    for (int i = 0; i < 4; ++i) rb[i] = *reinterpret_cast<const u32x4*>(bp + (size_t)(64 * i) * K);
    ap += 32; bp += 32;
    if (++lkt == nk) {
      lkt = 0;
      if (lit + 1 < M.ni) lit += 1;
      int tm_, tn_;
      gemm_map(M, lit, tm_, tn_);
      ap = A + ((size_t)gemm_T(tm_, tpr) * 128 + lrow) * lda + lkc * 8;
      bp = Bt + ((size_t)tn_ * 256 + lrow) * K + lkc * 8;
    }
  };
  auto sstore = [&](int buf) __attribute__((always_inline)) {
#pragma unroll
    for (int i = 0; i < 2; ++i) *reinterpret_cast<u32x4*>(As + buf * 8192 + sa0 + i * 1024) = ra[i];
#pragma unroll
    for (int i = 0; i < 4; ++i) *reinterpret_cast<u32x4*>(Bs + buf * 16384 + sb0 + i * 1024) = rb[i];
  };
  auto frags = [&](int buf) __attribute__((always_inline)) {
#pragma unroll
    for (int m = 0; m < 4; ++m) fa[m] = *reinterpret_cast<const bf16x8*>(As + buf * 8192 + aoff + m * 256);
#pragma unroll
    for (int n = 0; n < 8; ++n) fb[n] = *reinterpret_cast<const bf16x8*>(Bs + buf * 16384 + boff + n * 256);
  };
  auto mfmas = [&]() __attribute__((always_inline)) {
    __builtin_amdgcn_s_setprio(1);
#pragma unroll
    for (int m = 0; m < 4; ++m)
#pragma unroll
      for (int n = 0; n < 8; ++n) acc[m][n] = __builtin_amdgcn_mfma_f32_16x16x32_bf16(fa[m], fb[n], acc[m][n], 0, 0, 0);
    __builtin_amdgcn_s_setprio(0);
  };
  int cit = 0, ckt = 0;
  float rs_reg = 0.f;
  gload();
  sstore(0);
  gload();
  __syncthreads();
  for (int s = 0; s < S; s += 2) {
    frags(0);
    if (ckt == 0) {
#pragma unroll
      for (int m = 0; m < 4; ++m)
#pragma unroll
        for (int n = 0; n < 8; ++n) acc[m][n] = f32x4{0.f, 0.f, 0.f, 0.f};
      if (tid < 128) {
        int tmr_, tn_;
        gemm_map(M, cit, tmr_, tn_);
        const size_t R = (size_t)gemm_T(tmr_, tpr) * 128 + tid;
        if (MODE == 0) rs_reg = rowscale[R];
        if (MODE == 1 && ssqk != nullptr) {
          const float* q = ssqk + R * 16;
          float t = 0.f;
#pragma unroll
          for (int i = 0; i < 16; ++i) t += q[i];
          rsv[tid] = rsqrtf(t * (1.f / 1024.f) + EPS);
        }
      }
    }
    if (MODE == 0 && ckt == 2 && tid < 128) rsv[tid] = rs_reg;
    if (MODE == 1 && ssqk != nullptr && ckt == 32) {
#pragma unroll
      for (int m = 0; m < 4; ++m)
#pragma unroll
        for (int j = 0; j < 4; ++j) {
          float sc = rsv[wr * 64 + m * 16 + fq * 4 + j];
#pragma unroll
          for (int n = 0; n < 8; ++n) acc[m][n][j] *= sc;
        }
    }
    sstore(1);
    mfmas();
    gload();
    __syncthreads();
    frags(1);
    sstore(0);
    mfmas();
    gload();
    ckt += 2;
    if (ckt == nk) {
      int tmr, tn;
      const bool valid = gemm_map(M, cit, tmr, tn);
      const int tm = gemm_T(tmr, tpr);
      if (valid) {
#pragma unroll
        for (int m = 0; m < 4; ++m) {
#pragma unroll
          for (int j = 0; j < 4; ++j) {
            float sc = 1.f;
            if (MODE == 0) sc = rsv[wr * 64 + m * 16 + fq * 4 + j];
#pragma unroll
            for (int n = 0; n < 8; ++n) Cw[(fq * 4 + j) * 136 + n * 16 + fr] = f2bf(acc[m][n][j] * sc);
          }
#pragma unroll
          for (int i = 0; i < 4; ++i) {
            int c = lane + 64 * i, row = c >> 4, ch = c & 15;
            int col = tn * 256 + wc * 128 + ch * 8;
            uint4 v = *reinterpret_cast<const uint4*>(Cw + row * 136 + ch * 8);
            if (col < nvalid)
              *reinterpret_cast<uint4*>(outb + ((size_t)tm * 128 + wr * 64 + m * 16 + row) * ldo + col) = v;
          }
        }
      }
      cit += 1; ckt = 0;
    }
    __syncthreads();
  }
}

template <int MODE, int BATCH>
DEVI void gemm_meta_items(const u16* __restrict__ A, int lda, const u16* __restrict__ Bt, int K, int tps, int nn16,
                          const float* rowscale, u16* outb, int ldo, const float* ssqk, int wid, int fr, int fq) {
  const int G = gridDim.x, bid = obid();
  const size_t R0 = (size_t)wid * tps * 128;
  const u16* ap = A + (R0 + fr) * lda + fq * 8;
  const int nks = K / 32;
  for (int it = G - 1 - bid; it < nn16; it += G) {
    const u16* bp = Bt + ((size_t)it * 16 + fr) * K + fq * 8;
    f32x4 acc = f32x4{0.f, 0.f, 0.f, 0.f};
    for (int ks0 = 0; ks0 < nks; ks0 += BATCH) {
      bf16x8 a[BATCH], b[BATCH];
#pragma unroll
      for (int i = 0; i < BATCH; ++i) {
        a[i] = *reinterpret_cast<const bf16x8*>(ap + (ks0 + i) * 32);
        b[i] = *reinterpret_cast<const bf16x8*>(bp + (ks0 + i) * 32);
      }
      if (MODE == 1 && ssqk != nullptr && ks0 == 32) {
#pragma unroll
        for (int j = 0; j < 4; ++j) {
          const float* q = ssqk + (R0 + fq * 4 + j) * 16;
          float t = 0.f;
#pragma unroll
          for (int i = 0; i < 16; ++i) t += q[i];
          acc[j] *= rsqrtf(t * (1.f / 1024.f) + EPS);
        }
      }
#pragma unroll
      for (int i = 0; i < BATCH; ++i) acc = __builtin_amdgcn_mfma_f32_16x16x32_bf16(a[i], b[i], acc, 0, 0, 0);
    }
#pragma unroll
    for (int j = 0; j < 4; ++j) {
      size_t R = R0 + fq * 4 + j;
      float v = acc[j];
      if (MODE == 0) v *= rowscale[R];
      outb[R * ldo + it * 16 + fr] = f2bf(v);
    }
  }
}
template <int MODE>
__device__ void phase_gemm_meta(const u16* __restrict__ A, int lda, const u16* __restrict__ Bt, int K, int nseq, int tps,
                                int nn16, const float* rowscale, u16* outb, int ldo, const float* ssqk) {
  const int tid = otid(), lane = tid & 63, wid = tid >> 6, fr = lane & 15, fq = lane >> 4;
  if (wid >= nseq) return;
  if (((K / 32) & 15) == 0) gemm_meta_items<MODE, 16>(A, lda, Bt, K, tps, nn16, rowscale, outb, ldo, ssqk, wid, fr, fq);
  else gemm_meta_items<MODE, 11>(A, lda, Bt, K, tps, nn16, rowscale, outb, ldo, ssqk, wid, fr, fq);
}

__device__ void phase_conv(const Params& p, int g, int layer) {
  int nseq, tps, seq0; ginfo(g, nseq, tps, seq0);
  const int ntiles = nseq * tps;
  const int L = (tps - 1) * 128 + 16;
  const u16* u = (const u16*)(p.ws + OFF_U);
  u16* xc = (u16*)(p.ws + OFF_XC);
  float* dtb = (float*)(p.ws + OFF_DT);
  const float* cw = p.conv_w + (size_t)layer * 5 * 1536;
  const float* cb = p.conv_b + (size_t)layer * 1536;
  const int total = ntiles * 8 * 192;
  for (int id = obid() * 256 + otid(); id < total; id += gridDim.x * 256) {
    const int ch = id % 192, ts = id / 192, seg = ts & 7, T = ts >> 3;
    const int sl = T / tps, c = T - sl * tps;
    const int col = ch * 8;
    const size_t Rseq = (size_t)sl * tps * 128;
    u16* orow = xc + ((size_t)T * 128 + seg * 16) * 1536 + col;
    const int nvalid = (c > 0) ? 16 : (seg == 0 ? 16 : 0);
    if (nvalid == 0) {
      uint4 z = make_uint4(0, 0, 0, 0);
#pragma unroll 4
      for (int r = 0; r < 16; ++r) *reinterpret_cast<uint4*>(orow + (size_t)r * 1536) = z;
      continue;
    }
    const int pos0 = (c == 0) ? 0 : 16 + (c - 1) * 128 + seg * 16;
    float w[5][8], bias[8];
#pragma unroll
    for (int j = 0; j < 5; ++j) {
      float4 w0 = *reinterpret_cast<const float4*>(cw + j * 1536 + col), w1 = *reinterpret_cast<const float4*>(cw + j * 1536 + col + 4);
      w[j][0] = w0.x; w[j][1] = w0.y; w[j][2] = w0.z; w[j][3] = w0.w; w[j][4] = w1.x; w[j][5] = w1.y; w[j][6] = w1.z; w[j][7] = w1.w;
    }
    {
      float4 b0 = *reinterpret_cast<const float4*>(cb + col), b1 = *reinterpret_cast<const float4*>(cb + col + 4);
      bias[0] = b0.x; bias[1] = b0.y; bias[2] = b0.z; bias[3] = b0.w; bias[4] = b1.x; bias[5] = b1.y; bias[6] = b1.z; bias[7] = b1.w;
    }
    float win[5][8];
    auto ldrow = [&](int pp, float* dst) {
      if (pp >= 0 && pp < L) {
        int prow = (pp < 16) ? pp : 112 + pp;
        uint4 v = *reinterpret_cast<const uint4*>(u + (Rseq + prow) * DIN + C_XBC + col);
        unpack8(v, dst);
      } else {
#pragma unroll
        for (int i = 0; i < 8; ++i) dst[i] = 0.f;
      }
    };
    ldrow(pos0 - 2, win[0]); ldrow(pos0 - 1, win[1]); ldrow(pos0, win[2]); ldrow(pos0 + 1, win[3]);
#pragma unroll
    for (int r = 0; r < 16; ++r) {
      ldrow(pos0 + r + 2, win[(r + 4) % 5]);
      float acc[8];
#pragma unroll
      for (int i = 0; i < 8; ++i) {
        float a = bias[i];
#pragma unroll
        for (int j = 0; j < 5; ++j) a += win[(r + j) % 5][i] * w[j][i];
        acc[i] = silu_f(a);
      }
      *reinterpret_cast<uint4*>(orow + (size_t)r * 1536) = pack8(acc);
    }
  }
  const int nrows = ntiles * 128;
  for (int id = obid() * 256 + otid(); id < nrows * 4; id += gridDim.x * 256) {
    const int R = id >> 2, h0 = (id & 3) * 8;
    const int T = R >> 7, r = R & 127, sl = T / tps, c = T - sl * tps;
    const bool valid = (c > 0) || (r < 16);
    float o[8];
    uint4 v = *reinterpret_cast<const uint4*>(u + (size_t)R * DIN + C_DT + h0);
    float f[8]; unpack8(v, f);
#pragma unroll
    for (int i = 0; i < 8; ++i) {
      float x = f[i] + p.dt_bias[layer * 32 + h0 + i];
      float sp = (x > 20.f) ? x : log1pf(__expf(x));
      o[i] = valid ? sp : 0.f;
    }
    *reinterpret_cast<float4*>(dtb + (size_t)R * 32 + h0) = make_float4(o[0], o[1], o[2], o[3]);
    *reinterpret_cast<float4*>(dtb + (size_t)R * 32 + h0 + 4) = make_float4(o[4], o[5], o[6], o[7]);
  }
}

DEVI void ssd_cumsums(const float* dt, size_t R0, int hd, float Af, float Ab, float* acsf, float* rcs, float* dtf,
                      float* dtbk, int tid_) {
  const int lane = tid_ & 63, wid = tid_ >> 6;
  if (wid < 2) {
    const int dir = wid;
    float d0 = dt[(R0 + 2 * lane) * 32 + dir * 16 + hd], d1 = dt[(R0 + 2 * lane + 1) * 32 + dir * 16 + hd];
    float A_ = dir ? Ab : Af;
    float a0 = d0 * A_, a1 = d1 * A_;
    float s = a0 + a1, inc = s;
#pragma unroll
    for (int o = 1; o < 64; o <<= 1) {
      float t = __shfl_up(inc, o);
      if (lane >= o) inc += t;
    }
    float excl = inc - s;
    if (dir == 0) {
      acsf[2 * lane] = excl + a0; acsf[2 * lane + 1] = inc;
      dtf[2 * lane] = d0; dtf[2 * lane + 1] = d1;
    } else {
      float tot = __shfl(inc, 63);
      rcs[2 * lane] = tot - excl; rcs[2 * lane + 1] = tot - (excl + a0);
      dtbk[2 * lane] = d0; dtbk[2 * lane + 1] = d1;
    }
  }
}

__device__ void phase_ssdA(const Params& p, int g, int layer, char* smem) {
  int nseq, tps, seq0; ginfo(g, nseq, tps, seq0);
  const int ntiles = nseq * tps;
  u16* Bt = (u16*)smem;
  u16* Xt = Bt + 128 * 136;
  float* arr = (float*)(Xt + 64 * 136);
  float *acsf = arr, *rcs = arr + 128, *dtf = arr + 256, *dtbk = arr + 384;
  const int tid = otid(), lane = tid & 63, wid = tid >> 6, fr = lane & 15, fq = lane >> 4;
  const u16* xc = (const u16*)(p.ws + OFF_XC);
  const float* dt = (const float*)(p.ws + OFF_DT);
  u16* st = (u16*)(p.ws + OFF_ST);
  float* dec = (float*)(p.ws + OFF_DEC);
  for (int item = obid(); item < ntiles * 16; item += gridDim.x) {
    const int T = item >> 4, hd = item & 15, grp = hd >> 3;
    const size_t R0 = (size_t)T * 128;
    const float Af = -1.4426950408889634f * __expf(p.a_log[layer * 32 + hd]), Ab = -1.4426950408889634f * __expf(p.a_log[layer * 32 + 16 + hd]);
    ssd_cumsums(dt, R0, hd, Af, Ab, acsf, rcs, dtf, dtbk, tid);
    for (int id = tid; id < 128 * 16; id += 256) {
      int l = id & 127, ch = id >> 7;
      uint4 v = *reinterpret_cast<const uint4*>(xc + (R0 + l) * 1536 + 1024 + grp * 128 + ch * 8);
      u16* d = Bt + (ch * 8) * 136 + l;
      d[0 * 136] = (u16)(v.x & 0xffff); d[1 * 136] = (u16)(v.x >> 16);
      d[2 * 136] = (u16)(v.y & 0xffff); d[3 * 136] = (u16)(v.y >> 16);
      d[4 * 136] = (u16)(v.z & 0xffff); d[5 * 136] = (u16)(v.z >> 16);
      d[6 * 136] = (u16)(v.w & 0xffff); d[7 * 136] = (u16)(v.w >> 16);
    }
    __syncthreads();
#pragma unroll 1
    for (int dir = 0; dir < 2; ++dir) {
      const float ref = dir ? rcs[0] : acsf[127];
      for (int id = tid; id < 128 * 8; id += 256) {
        int l = id & 127, ch = id >> 7;
        uint4 v = *reinterpret_cast<const uint4*>(xc + (R0 + l) * 1536 + hd * 64 + ch * 8);
        float f[8]; unpack8(v, f);
        float w = dir ? dtbk[l] * __builtin_amdgcn_exp2f(ref - rcs[l]) : dtf[l] * __builtin_amdgcn_exp2f(ref - acsf[l]);
        u16* d = Xt + (ch * 8) * 136 + l;
#pragma unroll
        for (int i = 0; i < 8; ++i) d[i * 136] = f2bf(f[i] * w);
      }
      __syncthreads();
      f32x4 acc[4][2];
#pragma unroll
      for (int m = 0; m < 4; ++m)
#pragma unroll
        for (int n = 0; n < 2; ++n) acc[m][n] = f32x4{0.f, 0.f, 0.f, 0.f};
      wave_mma<4, 2, 4>(acc, Xt, 136, 16 * 136, Bt + (wid * 32) * 136, 136, 16 * 136, lane);
      u16* so = st + ((size_t)(T * 16 + hd) * 2 + dir) * 8192;
#pragma unroll
      for (int m = 0; m < 4; ++m)
#pragma unroll
        for (int n = 0; n < 2; ++n)
#pragma unroll
          for (int j = 0; j < 4; ++j) so[(16 * m + fq * 4 + j) * 128 + wid * 32 + 16 * n + fr] = f2bf(acc[m][n][j]);
      __syncthreads();
    }
    if (tid == 0) {
      dec[(size_t)(T * 16 + hd) * 2] = __builtin_amdgcn_exp2f(acsf[127]);
      dec[(size_t)(T * 16 + hd) * 2 + 1] = __builtin_amdgcn_exp2f(rcs[0]);
    }
    __syncthreads();
  }
}

__device__ void phase_scan(const Params& p, int g) {
  int nseq, tps, seq0; ginfo(g, nseq, tps, seq0);
  u16* st = (u16*)(p.ws + OFF_ST);
  const float* dec = (const float*)(p.ws + OFF_DEC);
  const int total = nseq * 32 * 4096;
  for (int i = obid() * 256 + otid(); i < total; i += gridDim.x * 256) {
    const int e2 = i & 4095, chn = i >> 12, dir = chn & 1, hd = (chn >> 1) & 15, sl = chn >> 5;
    float r0 = 0.f, r1 = 0.f;
    for (int cc = 0; cc < tps; cc += 16) {
      unsigned v[16]; float dc[16];
#pragma unroll
      for (int q = 0; q < 16; ++q) {
        int c = cc + q;
        v[q] = 0; dc[q] = 0.f;
        if (c < tps) {
          int ct = dir ? (tps - 1 - c) : c;
          size_t idx = ((size_t)(sl * tps + ct) * 16 + hd) * 2 + dir;
          v[q] = *reinterpret_cast<const unsigned*>(st + idx * 8192 + e2 * 2);
          dc[q] = dec[idx];
        }
      }
#pragma unroll
      for (int q = 0; q < 16; ++q) {
        int c = cc + q;
        if (c < tps) {
          int ct = dir ? (tps - 1 - c) : c;
          size_t idx = ((size_t)(sl * tps + ct) * 16 + hd) * 2 + dir;
          float s0 = __uint_as_float(v[q] << 16), s1 = __uint_as_float(v[q] & 0xffff0000u);
          *reinterpret_cast<unsigned*>(st + idx * 8192 + e2 * 2) = pack2(r0, r1);
          r0 = dc[q] * r0 + s0; r1 = dc[q] * r1 + s1;
        }
      }
    }
  }
}

__device__ void phase_ssdC(const Params& p, int g, int layer, char* smem) {
  int nseq, tps, seq0; ginfo(g, nseq, tps, seq0);
  const int ntiles = nseq * tps;
  u16* R0b = (u16*)smem;
  u16* R1b = R0b + 128 * 136;
  float* arr = (float*)(R1b + 128 * 136);
  float *acsf = arr, *rcs = arr + 128, *dtf = arr + 256, *dtbk = arr + 384;
  const int tid = otid(), lane = tid & 63, wid = tid >> 6, fr = lane & 15, fq = lane >> 4;
  const u16* xc = (const u16*)(p.ws + OFF_XC);
  const u16* u = (const u16*)(p.ws + OFF_U);
  const float* dt = (const float*)(p.ws + OFF_DT);
  const u16* st = (const u16*)(p.ws + OFF_ST);
  u16* ymix = (u16*)(p.ws + OFF_YMIX);
  float* ssqa = (float*)(p.ws + OFF_SSQA);
  for (int item = obid(); item < ntiles * 16; item += gridDim.x) {
    const int T = item >> 4, hd = item & 15, grp = hd >> 3;
    const size_t Rb = (size_t)T * 128;
    const float Af = -1.4426950408889634f * __expf(p.a_log[layer * 32 + hd]), Ab = -1.4426950408889634f * __expf(p.a_log[layer * 32 + 16 + hd]);
    const float Dh = p.ssd_d[layer * 16 + hd];
    ssd_cumsums(dt, Rb, hd, Af, Ab, acsf, rcs, dtf, dtbk, tid);
    for (int id = tid; id < 128 * 16; id += 256) {
      int l = id >> 4, ch = id & 15;
      const u16* s = xc + (Rb + l) * 1536 + 1024 + grp * 128 + ch * 8;
      *reinterpret_cast<uint4*>(R1b + l * 136 + ch * 8) = *reinterpret_cast<const uint4*>(s);
      *reinterpret_cast<uint4*>(R0b + l * 136 + ch * 8) = *reinterpret_cast<const uint4*>(s + 256);
    }
    __syncthreads();
    f32x4 cb[2][8];
#pragma unroll
    for (int m = 0; m < 2; ++m)
#pragma unroll
      for (int n = 0; n < 8; ++n) cb[m][n] = f32x4{0.f, 0.f, 0.f, 0.f};
    wave_mma<2, 8, 4>(cb, R0b + (wid * 32) * 136, 136, 16 * 136, R1b, 136, 16 * 136, lane);
    __syncthreads();
    for (int id = tid; id < 2 * 64 * 16; id += 256) {
      int d = id >> 10, pp = (id >> 4) & 63, ch = id & 15;
      *reinterpret_cast<uint4*>(R1b + (d * 64 + pp) * 136 + ch * 8) =
          *reinterpret_cast<const uint4*>(st + ((size_t)(T * 16 + hd) * 2 + d) * 8192 + pp * 128 + ch * 8);
    }
    __syncthreads();
    f32x4 y[2][4];
    {
      f32x4 yf[2][4], yb[2][4];
#pragma unroll
      for (int m = 0; m < 2; ++m)
#pragma unroll
        for (int n = 0; n < 4; ++n) { yf[m][n] = f32x4{0.f, 0.f, 0.f, 0.f}; yb[m][n] = f32x4{0.f, 0.f, 0.f, 0.f}; }
      wave_mma<2, 4, 4>(yf, R0b + (wid * 32) * 136, 136, 16 * 136, R1b, 136, 16 * 136, lane);
      wave_mma<2, 4, 4>(yb, R0b + (wid * 32) * 136, 136, 16 * 136, R1b + 64 * 136, 136, 16 * 136, lane);
#pragma unroll
      for (int m = 0; m < 2; ++m)
#pragma unroll
        for (int j = 0; j < 4; ++j) {
          int l = wid * 32 + 16 * m + fq * 4 + j;
          float ef = __builtin_amdgcn_exp2f(acsf[l]), eb = __builtin_amdgcn_exp2f(rcs[l]);
#pragma unroll
          for (int n = 0; n < 4; ++n) y[m][n][j] = ef * yf[m][n][j] + eb * yb[m][n][j];
        }
    }
    __syncthreads();
    int frv = fr, lbase = wid * 32 + fq * 4;
    asm volatile("" : "+v"(frv), "+v"(lbase));
#pragma unroll
    for (int m = 0; m < 2; ++m) {
      float afl[4], rbl[4];
#pragma unroll
      for (int j = 0; j < 4; ++j) { afl[j] = acsf[lbase + 16 * m + j]; rbl[j] = rcs[lbase + 16 * m + j]; }
#pragma unroll
      for (int n = 0; n < 8; ++n) {
        const int s = 16 * n + frv;
        const int rel = 16 * n - (wid * 32 + 16 * m);
        if (rel < 0) {
          const float as_ = acsf[s], dfs = dtf[s];
#pragma unroll
          for (int j = 0; j < 4; ++j)
            R0b[(lbase + 16 * m + j) * 136 + s] = f2bf(cb[m][n][j] * (__builtin_amdgcn_exp2f(afl[j] - as_) * dfs));
        } else if (rel > 0) {
          const float rs_ = rcs[s], dbs = dtbk[s];
#pragma unroll
          for (int j = 0; j < 4; ++j)
            R0b[(lbase + 16 * m + j) * 136 + s] = f2bf(cb[m][n][j] * (__builtin_amdgcn_exp2f(rbl[j] - rs_) * dbs));
        } else {
          const float as_ = acsf[s], rs_ = rcs[s], dfs = dtf[s], dbs = dtbk[s];
#pragma unroll
          for (int j = 0; j < 4; ++j) {
            const int l = lbase + 16 * m + j;
            float gsum = 0.f;
            if (s <= l) gsum += __builtin_amdgcn_exp2f(afl[j] - as_) * dfs;
            if (s >= l) gsum += __builtin_amdgcn_exp2f(rbl[j] - rs_) * dbs;
            float val = cb[m][n][j] * gsum + ((s == l) ? Dh : 0.f);
            R0b[l * 136 + s] = f2bf(val);
          }
        }
      }
    }
    for (int id = tid; id < 128 * 8; id += 256) {
      int l = id & 127, ch = id >> 7;
      uint4 v = *reinterpret_cast<const uint4*>(xc + (Rb + l) * 1536 + hd * 64 + ch * 8);
      u16* d = R1b + (ch * 8) * 136 + l;
      d[0 * 136] = (u16)(v.x & 0xffff); d[1 * 136] = (u16)(v.x >> 16);
      d[2 * 136] = (u16)(v.y & 0xffff); d[3 * 136] = (u16)(v.y >> 16);
      d[4 * 136] = (u16)(v.z & 0xffff); d[5 * 136] = (u16)(v.z >> 16);
      d[6 * 136] = (u16)(v.w & 0xffff); d[7 * 136] = (u16)(v.w >> 16);
    }
    __syncthreads();
    wave_mma<2, 4, 4>(y, R0b + (wid * 32) * 136, 136, 16 * 136, R1b, 136, 16 * 136, lane);
#pragma unroll
    for (int m = 0; m < 2; ++m)
#pragma unroll
      for (int j = 0; j < 4; ++j) {
        size_t R = Rb + wid * 32 + 16 * m + fq * 4 + j;
        float sq = 0.f;
#pragma unroll
        for (int n = 0; n < 4; ++n) {
          int pc = hd * 64 + 16 * n + fr;
          float z = bf2f(u[R * DIN + pc]);
          float val = y[m][n][j] * silu_f(z);
          sq += val * val;
          ymix[R * DMIX + pc] = f2bf(val);
        }
        sq = red16_sum(sq);
        if (fr == 0) ssqa[R * 16 + hd] = sq;
      }
    __syncthreads();
  }
}

__device__ void phase_rope(const Params& p, int g) {
  int nseq, tps, seq0; ginfo(g, nseq, tps, seq0);
  const int nrows = nseq * tps * 128;
  u16* u = (u16*)(p.ws + OFF_U);
  for (int id = obid() * 256 + otid(); id < nrows * 10; id += gridDim.x * 256) {
    const int R = id / 10, hh = id - R * 10;
    const int T = R >> 7, r = R & 127, sl = T / tps, c = T - sl * tps;
    if (c == 0 && r >= 16) continue;
    const int pos = (c == 0) ? r : 16 + (c - 1) * 128 + r;
    u16* s = u + (size_t)R * DIN + (hh < 8 ? C_WQ + hh * 64 : C_WK + (hh - 8) * 64);
    uint4 v0 = *reinterpret_cast<const uint4*>(s), v1 = *reinterpret_cast<const uint4*>(s + 8);
    float x1[8], x2[8], o1[8], o2[8];
    unpack8(v0, x1); unpack8(v1, x2);
    const float posf = (float)pos;
#pragma unroll
    for (int i = 0; i < 8; ++i) {
      float ang = posf * c_inv[i];
      double rev = (double)ang * 0.15915494309189535;
      rev -= rint(rev);
      float rv = (float)rev;
      float sn = __builtin_amdgcn_sinf(rv), cs = __builtin_amdgcn_cosf(rv);
      o1[i] = x1[i] * cs - x2[i] * sn;
      o2[i] = x2[i] * cs + x1[i] * sn;
    }
    *reinterpret_cast<uint4*>(s) = pack8(o1);
    *reinterpret_cast<uint4*>(s + 8) = pack8(o2);
  }
}

DEVI void kv_prefetch(u32x4 (&pk)[2], u32x4 (&pv)[2], const u16* ksrc, const u16* vsrc, int tid) {
#pragma unroll
  for (int i = 0; i < 2; ++i) {
    int id = tid + i * 256;
    pk[i] = *reinterpret_cast<const u32x4*>(ksrc + (size_t)(id >> 3) * DIN + (id & 7) * 8);
    pv[i] = *reinterpret_cast<const u32x4*>(vsrc + (size_t)(id & 63) * DIN + (id >> 6) * 8);
  }
}
DEVI void kv_commit(const u32x4 (&pk)[2], const u32x4 (&pv)[2], u16* Ks, u16* Vt, int tid) {
#pragma unroll
  for (int i = 0; i < 2; ++i) {
    int id = tid + i * 256;
    *reinterpret_cast<u32x4*>(Ks + (id >> 3) * 72 + (id & 7) * 8) = pk[i];
    u16* d = Vt + ((id >> 6) * 8) * 72 + (id & 63);
    d[0 * 72] = (u16)(pv[i][0] & 0xffff); d[1 * 72] = (u16)(pv[i][0] >> 16);
    d[2 * 72] = (u16)(pv[i][1] & 0xffff); d[3 * 72] = (u16)(pv[i][1] >> 16);
    d[4 * 72] = (u16)(pv[i][2] & 0xffff); d[5 * 72] = (u16)(pv[i][2] >> 16);
    d[6 * 72] = (u16)(pv[i][3] & 0xffff); d[7 * 72] = (u16)(pv[i][3] >> 16);
  }
}
DEVI void stage_rope(u16* dst, const u16* src, int nrows, int pos0, int tid) {
  for (int id = tid; id < nrows * 7; id += 256) {
    int r = id / 7, cz = id - r * 7;
    const u16* s = src + (size_t)r * DIN;
    if (cz > 0) {
      *reinterpret_cast<uint4*>(dst + r * 72 + (cz + 1) * 8) = *reinterpret_cast<const uint4*>(s + (cz + 1) * 8);
    } else {
      uint4 v0 = *reinterpret_cast<const uint4*>(s), v1 = *reinterpret_cast<const uint4*>(s + 8);
      float x1[8], x2[8], o1[8], o2[8];
      unpack8(v0, x1); unpack8(v1, x2);
      float pos = (float)(pos0 + r);
#pragma unroll
      for (int i = 0; i < 8; ++i) {
        float ang = pos * c_inv[i];
        double rev = (double)ang * 0.15915494309189535;
        rev -= rint(rev);
        float rv = (float)rev;
        float sn = __builtin_amdgcn_sinf(rv), cs = __builtin_amdgcn_cosf(rv);
        o1[i] = x1[i] * cs - x2[i] * sn;
        o2[i] = x2[i] * cs + x1[i] * sn;
      }
      *reinterpret_cast<uint4*>(dst + r * 72) = pack8(o1);
      *reinterpret_cast<uint4*>(dst + r * 72 + 8) = pack8(o2);
    }
  }
}
DEVI void stage_plain(u16* dst, const u16* src, int nrows, int tid) {
  for (int id = tid; id < nrows * 8; id += 256) {
    int r = id >> 3, ch = id & 7;
    *reinterpret_cast<uint4*>(dst + r * 72 + ch * 8) = *reinterpret_cast<const uint4*>(src + (size_t)r * DIN + ch * 8);
  }
}
DEVI void stage_vt(u16* dst, const u16* src, int tid) {
  for (int id = tid; id < 64 * 8; id += 256) {
    int key = id & 63, ch = id >> 6;
    uint4 v = *reinterpret_cast<const uint4*>(src + (size_t)key * DIN + ch * 8);
    u16* d = dst + (ch * 8) * 72 + key;
    d[0 * 72] = (u16)(v.x & 0xffff); d[1 * 72] = (u16)(v.x >> 16);
    d[2 * 72] = (u16)(v.y & 0xffff); d[3 * 72] = (u16)(v.y >> 16);
    d[4 * 72] = (u16)(v.z & 0xffff); d[5 * 72] = (u16)(v.z >> 16);
    d[6 * 72] = (u16)(v.w & 0xffff); d[7 * 72] = (u16)(v.w >> 16);
  }
}

__device__ void phase_win(const Params& p, int g, int layer, char* smem) {
  int nseq, tps, seq0; ginfo(g, nseq, tps, seq0);
  const int ntiles = nseq * tps;
  u16* Qs = (u16*)smem;
  u16* Ks = Qs + 128 * 72;
  u16* Vt = Ks + 64 * 72;
  u16* Ps = Vt + 64 * 72;
  const int tid = otid(), lane = tid & 63, wid = tid >> 6, fr = lane & 15, fq = lane >> 4;
  const float C2 = 0.125f * 1.4426950408889634f;
  const u16* u = (const u16*)(p.ws + OFF_U);
  u16* ymix = (u16*)(p.ws + OFF_YMIX);
  for (int item = (obid() + gridDim.x - 64) % gridDim.x; item < ntiles * 8; item += gridDim.x) {
    const int T = item >> 3, qh = item & 7, kvh = qh >> 2;
    const int sl = T / tps, c = T - sl * tps, Ts0 = sl * tps;
    const int qpos0 = (c == 0) ? 0 : 16 + (c - 1) * 128;
    u32x4 pk[2], pv[2];
    kv_prefetch(pk, pv, u + (size_t)Ts0 * 128 * DIN + C_WK + kvh * 64, u + (size_t)Ts0 * 128 * DIN + C_WV + kvh * 64, tid);
    stage_plain(Qs, u + (size_t)T * 128 * DIN + C_WQ + qh * 64, 128, tid);
    float mrow[2][4], lrow[2][4];
    f32x4 o[2][4];
#pragma unroll
    for (int m = 0; m < 2; ++m) {
#pragma unroll
      for (int j = 0; j < 4; ++j) { mrow[m][j] = -1e30f; lrow[m][j] = 0.f; }
#pragma unroll
      for (int n = 0; n < 4; ++n) o[m][n] = f32x4{0.f, 0.f, 0.f, 0.f};
    }
    int kb = 0;
    while (kb < 7) {
      int kt = 0, half = 0;
      const bool meta = (kb == 0);
      if (!meta) { kt = c - 1 + ((kb - 1) >> 1); half = (kb - 1) & 1; }
      const int kpos0 = (kt == 0) ? 0 : 16 + (kt - 1) * 128 + half * 64;
      kv_commit(pk, pv, Ks, Vt, tid);
      __syncthreads();
      int nkb = kb + 1;
      while (nkb < 7) {
        int kt2 = c - 1 + ((nkb - 1) >> 1);
        if (kt2 >= 1 && kt2 < tps) break;
        ++nkb;
      }
      if (nkb < 7) {
        const int kt2 = c - 1 + ((nkb - 1) >> 1), half2 = (nkb - 1) & 1;
        const size_t krow2 = (size_t)(Ts0 + kt2) * 128 + half2 * 64;
        kv_prefetch(pk, pv, u + krow2 * DIN + C_WK + kvh * 64, u + krow2 * DIN + C_WV + kvh * 64, tid);
      }
      f32x4 s[2][4];
#pragma unroll
      for (int m = 0; m < 2; ++m)
#pragma unroll
        for (int n = 0; n < 4; ++n) s[m][n] = f32x4{0.f, 0.f, 0.f, 0.f};
      wave_mma<2, 4, 2>(s, Qs + (wid * 32) * 72, 72, 16 * 72, Ks, 72, 16 * 72, lane);
#pragma unroll
      for (int m = 0; m < 2; ++m)
#pragma unroll
        for (int j = 0; j < 4; ++j) {
          const int qrow = wid * 32 + 16 * m + fq * 4 + j;
          const int dbase = qpos0 + qrow - kpos0 - fr + 128;
          float mx = mrow[m][j];
#pragma unroll
          for (int n = 0; n < 4; ++n) {
            bool ok = meta ? (n == 0) : ((unsigned)(dbase - 16 * n) <= 256u);
            float v = ok ? s[m][n][j] : -1e30f;
            s[m][n][j] = v;
            mx = fmaxf(mx, v);
          }
          mx = red16_max(mx);
          const float mxc = mx * C2;
          float alpha = __builtin_amdgcn_exp2f(mrow[m][j] * C2 - mxc);
          float rsum = 0.f;
#pragma unroll
          for (int n = 0; n < 4; ++n) {
            float pv = __builtin_amdgcn_exp2f(s[m][n][j] * C2 - mxc);
            rsum += pv;
            Ps[(wid * 32 + 16 * m + fq * 4 + j) * 72 + 16 * n + fr] = f2bf(pv);
          }
          rsum = red16_sum(rsum);
          lrow[m][j] = lrow[m][j] * alpha + rsum;
          mrow[m][j] = mx;
#pragma unroll
          for (int n = 0; n < 4; ++n) o[m][n][j] *= alpha;
        }
      __syncthreads();
      wave_mma<2, 4, 2>(o, Ps + (wid * 32) * 72, 72, 16 * 72, Vt, 72, 16 * 72, lane);
      __syncthreads();
      kb = nkb;
    }
    const float sk = p.sink[layer * 8 + qh];
#pragma unroll
    for (int m = 0; m < 2; ++m)
#pragma unroll
      for (int j = 0; j < 4; ++j) {
        const float ms = mrow[m][j] * 0.125f;
        float mx = fmaxf(ms, sk);
        float a = __expf(ms - mx);
        float l = lrow[m][j] * a + __expf(sk - mx);
        float inv = a / l;
        size_t R = (size_t)T * 128 + wid * 32 + 16 * m + fq * 4 + j;
#pragma unroll
        for (int n = 0; n < 4; ++n) ymix[R * DMIX + 1024 + qh * 64 + 16 * n + fr] = f2bf(o[m][n][j] * inv);
      }
  }
}

__device__ void phase_na(const Params& p, int g, int layer, char* smem) {
  int nseq, tps, seq0; ginfo(g, nseq, tps, seq0);
  const int ntiles = nseq * tps;
  const int rows_total = (tps - 1) * 2;
  u16* Qs = (u16*)smem;
  u16* Ks = Qs + 128 * 72;
  u16* Vt = Ks + 64 * 72;
  u16* Ps = Vt + 64 * 72;
  float* rp = (float*)(Ps + 4 * 32 * 40);
  float* mb = rp + 480;
  const int tid = otid(), lane = tid & 63, wid = tid >> 6, fr = lane & 15, fq = lane >> 4;
  const float C2 = 0.125f * 1.4426950408889634f;
  const u16* u = (const u16*)(p.ws + OFF_U);
  u16* ymix = (u16*)(p.ws + OFF_YMIX);
  for (int item = (obid() + gridDim.x - 96) % gridDim.x; item < ntiles * 8; item += gridDim.x) {
    const int T = item >> 3, h = item & 7;
    const int sl = T / tps, c = T - sl * tps, Ts0 = sl * tps;
    u32x4 pk[2], pv[2];
    kv_prefetch(pk, pv, u + (size_t)Ts0 * 128 * DIN + C_NK + h * 64, u + (size_t)Ts0 * 128 * DIN + C_NV + h * 64, tid);
    stage_plain(Qs, u + (size_t)T * 128 * DIN + C_NQ + h * 64, 128, tid);
    for (int i = tid; i < 465; i += 256) rp[i] = 8.f * p.rpb[(size_t)(layer * 8 + h) * 465 + i];
    if (tid < 16) mb[tid] = 8.f * p.mbias[(layer * 8 + h) * 16 + tid];
    const int r0 = (c == 0) ? 0 : 2 * (c - 1);
    int qr[2], rsm[2];
#pragma unroll
    for (int m = 0; m < 2; ++m) {
      qr[m] = (c == 0) ? 0 : r0 + m;
      rsm[m] = min(max(qr[m] - 4, 0), rows_total - 8);
    }
    const int krlo = rsm[0], krhi = rsm[1] + 7;
    const int kc0w = min(max(16 * wid - 8, 0), 32);
    float mrow[2][4], lrow[2][4];
    f32x4 o[2][4];
#pragma unroll
    for (int m = 0; m < 2; ++m) {
#pragma unroll
      for (int j = 0; j < 4; ++j) { mrow[m][j] = -1e30f; lrow[m][j] = 0.f; }
#pragma unroll
      for (int n = 0; n < 4; ++n) o[m][n] = f32x4{0.f, 0.f, 0.f, 0.f};
    }
    for (int kb = -1; kb <= krhi - krlo; ++kb) {
      const bool meta = kb < 0;
      const int kr = krlo + kb;
      kv_commit(pk, pv, Ks, Vt, tid);
      __syncthreads();
      if (kb < krhi - krlo) {
        const int kr2 = kr + 1;
        const size_t krow2 = (size_t)(Ts0 + 1 + (kr2 >> 1)) * 128 + (kr2 & 1) * 64;
        kv_prefetch(pk, pv, u + krow2 * DIN + C_NK + h * 64, u + krow2 * DIN + C_NV + h * 64, tid);
      }
      const int kc0 = meta ? 0 : kc0w;
      f32x4 s[2][2];
#pragma unroll
      for (int m = 0; m < 2; ++m)
#pragma unroll
        for (int n = 0; n < 2; ++n) s[m][n] = f32x4{0.f, 0.f, 0.f, 0.f};
      wave_mma<2, 2, 2>(s, Qs + (16 * wid) * 72, 72, 64 * 72, Ks + kc0 * 72, 72, 16 * 72, lane);
#pragma unroll
      for (int m = 0; m < 2; ++m) {
        const bool rowok = (kr >= rsm[m]) && (kr <= rsm[m] + 7);
        const int rbase = (kr - qr[m] + 7) * 31 + 15;
#pragma unroll
        for (int j = 0; j < 4; ++j) {
          const int qc = (c == 0) ? 0 : 16 * wid + fq * 4 + j;
          const int qcs = min(max(qc - 8, 0), 48);
          const int kcb = kc0 + fr;
          float mx = mrow[m][j];
#pragma unroll
          for (int n = 0; n < 2; ++n) {
            const int kc = kcb + 16 * n;
            float v = -1e30f;
            if (meta) {
              if (n == 0) v = s[m][n][j] + mb[fr];
            } else if (rowok && (unsigned)(kc - qcs) < 16u) {
              v = s[m][n][j] + rp[rbase + kc - qc];
            }
            s[m][n][j] = v;
            mx = fmaxf(mx, v);
          }
          mx = red16_max(mx);
          const float mxc = mx * C2;
          float alpha = __builtin_amdgcn_exp2f(mrow[m][j] * C2 - mxc);
          float rsum = 0.f;
#pragma unroll
          for (int n = 0; n < 2; ++n) {
            float pv = __builtin_amdgcn_exp2f(s[m][n][j] * C2 - mxc);
            rsum += pv;
            Ps[(wid * 32 + 16 * m + fq * 4 + j) * 40 + 16 * n + fr] = f2bf(pv);
          }
          rsum = red16_sum(rsum);
          lrow[m][j] = lrow[m][j] * alpha + rsum;
          mrow[m][j] = mx;
#pragma unroll
          for (int n = 0; n < 4; ++n) o[m][n][j] *= alpha;
        }
      }
      __syncthreads();
      wave_mma<2, 4, 1>(o, Ps + (wid * 32) * 40, 40, 16 * 40, Vt + kc0, 72, 16 * 72, lane);
      __syncthreads();
    }
#pragma unroll
    for (int m = 0; m < 2; ++m)
#pragma unroll
      for (int j = 0; j < 4; ++j) {
        float inv = 1.f / lrow[m][j];
        size_t R = (size_t)T * 128 + m * 64 + 16 * wid + fq * 4 + j;
#pragma unroll
        for (int n = 0; n < 4; ++n) ymix[R * DMIX + 1536 + h * 64 + 16 * n + fr] = f2bf(o[m][n][j] * inv);
      }
  }
}

__device__ void phase_act(const Params& p, int g, int layer) {
  int nseq, tps, seq0; ginfo(g, nseq, tps, seq0);
  const int ntiles = nseq * tps;
  const int L = (tps - 1) * 128 + 16;
  const u16* gb = (const u16*)(p.ws + OFF_U);
  u16* act = (u16*)(p.ws + OFF_ST);
  const float* cw = p.fconv_w + (size_t)layer * 3 * DUP;
  const float* cb = p.fconv_b + (size_t)layer * DUP;
  const int total = ntiles * 8 * 352;
  for (int id = obid() * 256 + otid(); id < total; id += gridDim.x * 256) {
    const int ch = id % 352, ts = id / 352, seg = ts & 7, T = ts >> 3;
    const int sl = T / tps, c = T - sl * tps;
    const int col = ch * 8;
    const size_t Rseq = (size_t)sl * tps * 128;
    u16* orow = act + ((size_t)T * 128 + seg * 16) * DFF + col;
    const int nvalid = (c > 0) ? 16 : (seg == 0 ? 16 : 0);
    if (nvalid == 0) {
      uint4 z = make_uint4(0, 0, 0, 0);
#pragma unroll 4
      for (int r = 0; r < 16; ++r) *reinterpret_cast<uint4*>(orow + (size_t)r * DFF) = z;
      continue;
    }
    const int pos0 = (c == 0) ? 0 : 16 + (c - 1) * 128 + seg * 16;
    float wg[3][8], wu[3][8], bg[8], bu[8];
#pragma unroll
    for (int j = 0; j < 3; ++j) {
      float4 a0 = *reinterpret_cast<const float4*>(cw + j * DUP + col), a1 = *reinterpret_cast<const float4*>(cw + j * DUP + col + 4);
      float4 c0 = *reinterpret_cast<const float4*>(cw + j * DUP + DFF + col), c1 = *reinterpret_cast<const float4*>(cw + j * DUP + DFF + col + 4);
      wg[j][0] = a0.x; wg[j][1] = a0.y; wg[j][2] = a0.z; wg[j][3] = a0.w; wg[j][4] = a1.x; wg[j][5] = a1.y; wg[j][6] = a1.z; wg[j][7] = a1.w;
      wu[j][0] = c0.x; wu[j][1] = c0.y; wu[j][2] = c0.z; wu[j][3] = c0.w; wu[j][4] = c1.x; wu[j][5] = c1.y; wu[j][6] = c1.z; wu[j][7] = c1.w;
    }
    {
      float4 a0 = *reinterpret_cast<const float4*>(cb + col), a1 = *reinterpret_cast<const float4*>(cb + col + 4);
      float4 c0 = *reinterpret_cast<const float4*>(cb + DFF + col), c1 = *reinterpret_cast<const float4*>(cb + DFF + col + 4);
      bg[0] = a0.x; bg[1] = a0.y; bg[2] = a0.z; bg[3] = a0.w; bg[4] = a1.x; bg[5] = a1.y; bg[6] = a1.z; bg[7] = a1.w;
      bu[0] = c0.x; bu[1] = c0.y; bu[2] = c0.z; bu[3] = c0.w; bu[4] = c1.x; bu[5] = c1.y; bu[6] = c1.z; bu[7] = c1.w;
    }
    float xg[3][8], xu[3][8];
    auto ldrow = [&](int pp, float* dg, float* du) {
      if (pp >= 0 && pp < L) {
        int prow = (pp < 16) ? pp : 112 + pp;
        const u16* sp = gb + (Rseq + prow) * DUP + col;
        uint4 v0 = *reinterpret_cast<const uint4*>(sp), v1 = *reinterpret_cast<const uint4*>(sp + DFF);
        unpack8(v0, dg); unpack8(v1, du);
      } else {
#pragma unroll
        for (int i = 0; i < 8; ++i) { dg[i] = 0.f; du[i] = 0.f; }
      }
    };
    ldrow(pos0 - 1, xg[0], xu[0]); ldrow(pos0, xg[1], xu[1]);
#pragma unroll
    for (int r = 0; r < 16; ++r) {
      ldrow(pos0 + r + 1, xg[(r + 2) % 3], xu[(r + 2) % 3]);
      float res[8];
#pragma unroll
      for (int i = 0; i < 8; ++i) {
        float ga = bg[i], up = bu[i];
#pragma unroll
        for (int j = 0; j < 3; ++j) { ga += xg[(r + j) % 3][i] * wg[j][i]; up += xu[(r + j) % 3][i] * wu[j][i]; }
        float yv = 0.7978845608028654f * (ga + 0.044715f * ga * ga * ga);
        float th = 1.f - 2.f * __builtin_amdgcn_rcpf(__expf(2.f * yv) + 1.f);
        res[i] = 0.5f * ga * (1.f + th) * up;
      }
      *reinterpret_cast<uint4*>(orow + (size_t)r * DFF) = pack8(res);
    }
  }
}

#define XB_TMO      128
#define XB_XCNT(j)  (256  + 64 * (j))
#define XB_XSUB(j)  (1280 + 64 * (j))
#define XB_XGEN(j)  (2304 + 64 * (j))
#define XB_TOP      3328
#define XB_TOPGEN   3392
#define XCD_BAR_WORDS 3456
#define XB_SPIN_CAP (1u << 22)
#define LAS __attribute__((address_space(3)))
DEVI unsigned xb_ld(unsigned* p) { return __hip_atomic_load(p, __ATOMIC_RELAXED, __HIP_MEMORY_SCOPE_AGENT); }
DEVI unsigned xb_add(unsigned* p, unsigned v) { return __hip_atomic_fetch_add(p, v, __ATOMIC_RELAXED, __HIP_MEMORY_SCOPE_AGENT); }
DEVI unsigned xb_xcc_id() { return (unsigned)__builtin_amdgcn_s_getreg((3 << 11) | 20) & 0xFu; }
#define XB_SPIN(cond, bar) do { unsigned _sp = 0; while (cond) { __builtin_amdgcn_s_sleep(1); \
    if ((++_sp & 255u) == 0u) { if (xb_ld(&(bar)[XB_TMO])) break; if (_sp > XB_SPIN_CAP) { atomicAdd(&(bar)[XB_TMO], 1u); break; } } } } while (0)
struct XcdBarrier { unsigned* bar; unsigned x; volatile LAS unsigned* st; };
DEVI XcdBarrier xcd_barrier_post(unsigned* bar, volatile LAS unsigned* st) {
  XcdBarrier b; b.bar = bar; b.x = xb_xcc_id(); b.st = st;
  if (threadIdx.x == 0) (void)xb_add(&bar[XB_XCNT(b.x)], 1u);
  return b;
}
DEVI void xcd_barrier_complete(unsigned* bar, unsigned x, unsigned& nloc, unsigned& nx) {
  const unsigned G = gridDim.x * gridDim.y * gridDim.z;
  unsigned sum, cnt, mine, sp = 0u;
  for (;;) {
    sum = 0u; cnt = 0u; mine = 0u;
#pragma unroll
    for (unsigned j = 0; j < 16; ++j) { const unsigned c = xb_ld(&bar[XB_XCNT(j)]); sum += c; cnt += (c > 0u) ? 1u : 0u; mine = (j == x) ? c : mine; }
    if (sum == G) break;
    __builtin_amdgcn_s_sleep(1);
    if ((++sp & 255u) == 0u) { if (xb_ld(&bar[XB_TMO])) break; if (sp > XB_SPIN_CAP) { atomicAdd(&bar[XB_TMO], 1u); break; } }
  }
  nloc = mine > 0u ? mine : 1u; nx = cnt > 0u ? cnt : 1u;
}
DEVI void xcd_barrier(const XcdBarrier& b) {
  asm volatile("s_waitcnt vmcnt(0)" ::: "memory");
  __syncthreads();
  if (threadIdx.x == 0) {
    unsigned* bar = b.bar;
    __builtin_amdgcn_s_waitcnt(0);
    unsigned nloc = b.st[0], nx = b.st[1];
    if (nloc == 0u) { xcd_barrier_complete(bar, b.x, nloc, nx); b.st[0] = nloc; b.st[1] = nx; }
    const unsigned old = xb_add(&bar[XB_XSUB(b.x)], 1u);
    const unsigned gen = old / nloc;
    if (old + 1u == (gen + 1u) * nloc) {
      __builtin_amdgcn_fence(__ATOMIC_RELEASE, "agent");
      asm volatile("s_waitcnt vmcnt(0)" ::: "memory");
      const unsigned og = xb_add(&bar[XB_TOP], 1u);
      const unsigned tg = og / nx;
      if (og + 1u == (tg + 1u) * nx) xb_add(&bar[XB_TOPGEN], 1u);
      else XB_SPIN(xb_ld(&bar[XB_TOPGEN]) == tg, bar);
      __builtin_amdgcn_fence(__ATOMIC_ACQUIRE, "agent");
      xb_add(&bar[XB_XGEN(b.x)], 1u);
      asm volatile("s_waitcnt vmcnt(0)" ::: "memory");
    } else {
      XB_SPIN(xb_ld(&bar[XB_XGEN(b.x)]) == gen, bar);
      __builtin_amdgcn_fence(__ATOMIC_ACQUIRE, "agent");
      asm volatile("s_waitcnt vmcnt(0)" ::: "memory");
    }
  }
  __syncthreads();
}

#ifndef REP_GEMM
#define REP_GEMM 1
#endif
#ifndef REP_SSD
#define REP_SSD 1
#endif
#ifndef REP_WIN
#define REP_WIN 1
#endif
#ifndef REP_NA
#define REP_NA 1
#endif
#ifndef REP_EW
#define REP_EW 1
#endif
__global__ void __launch_bounds__(256, 2) mega(Params p) {
  extern __shared__ __attribute__((aligned(16))) char smem[];
  cg::grid_group grid = cg::this_grid();
  __shared__ uint4 xb_words;
  if (threadIdx.x == 0) xb_words = make_uint4(0u, 0u, 0u, 0u);
  __syncthreads();
  XcdBarrier xb = xcd_barrier_post((unsigned*)(p.ws + OFF_BAR), (volatile LAS unsigned*)&xb_words);
#pragma unroll 1
  for (int step = 0; step < 93; ++step) {
    int ph = 100, g = 0, layer = 0;
    if (step > 0) {
      int s = step - 1;
      g = s / 23;
      int r = s - g * 23;
      if (r == 0) ph = 101;
      else { layer = (r - 1) / 11; ph = (r - 1) - layer * 11; }
    }
    int nseq, tps, seq0; ginfo(g, nseq, tps, seq0);
    const int ntm = nseq * (tps - 1), tpr = tps - 1;
    if (ph == 100) {
      phase_prep(p, smem);
    } else if (ph == 101 || ph == 6 || ph == 10) {
      const float* w = (ph == 6) ? p.n_mix_post + layer * DM : p.n_ffn_post + layer * DM;
      const int mode = (ph == 101) ? 0 : ((ph == 10 && layer == 1) ? 2 : 1);
      phase_rowupd(p, g, mode, (const u16*)(p.ws + OFF_U), w);
    } else if (ph == 0 || ph == 7) {
      const u16* Bt = (ph == 0) ? (const u16*)(p.ws + OFF_WIN) + (size_t)layer * DINP * DM
                                : (const u16*)(p.ws + OFF_WUP) + (size_t)layer * DUP * DM;
      const int nv = (ph == 0) ? DIN : DUP;
      for (int rep = 0; rep < REP_GEMM; ++rep) {
        phase_gemm_w<0>((const u16*)(p.ws + OFF_HB), DM, Bt, DM, ntm, 20, (ph == 0) ? DIN : 5120,
                        (const float*)(p.ws + OFF_RS), (u16*)(p.ws + OFF_U), nv, tpr, nullptr, smem);
        if (ph == 7)
          phase_gemm<0>((const u16*)(p.ws + OFF_HB), DM, Bt + (size_t)5120 * DM, DM, ntm, 4, 512,
                        (const float*)(p.ws + OFF_RS), (u16*)(p.ws + OFF_U) + 5120, nv, tpr, nullptr, smem);
        phase_gemm_meta<0>((const u16*)(p.ws + OFF_HB), DM, Bt, DM, nseq, tps, nv / 16, (const float*)(p.ws + OFF_RS),
                           (u16*)(p.ws + OFF_U), nv, nullptr);
      }
    } else if (ph == 5 || ph == 9) {
      const u16* A = (ph == 5) ? (const u16*)(p.ws + OFF_YMIX) : (const u16*)(p.ws + OFF_ST);
      const u16* Bt = (ph == 5) ? (const u16*)(p.ws + OFF_WOUT) + (size_t)layer * DM * DMIX
                                : (const u16*)(p.ws + OFF_WDN) + (size_t)layer * DM * DFF;
      const int K = (ph == 5) ? DMIX : DFF;
      const float* ssqk = (ph == 5) ? (const float*)(p.ws + OFF_SSQA) : nullptr;
      for (int rep = 0; rep < REP_GEMM; ++rep) {
        phase_gemm_w<1>(A, K, Bt, K, ntm, 4, DM, nullptr, (u16*)(p.ws + OFF_U), DM, tpr, ssqk, smem);
        phase_gemm_meta<1>(A, K, Bt, K, nseq, tps, DM / 16, nullptr, (u16*)(p.ws + OFF_U), DM, ssqk);
      }
    } else if (ph == 1) {
      for (int rep = 0; rep < REP_EW; ++rep) phase_conv(p, g, layer);
      phase_rope(p, g);
    } else if (ph == 2) {
      for (int rep = 0; rep < REP_SSD; ++rep) phase_ssdA(p, g, layer, smem);
    } else if (ph == 3) {
      phase_scan(p, g);
    } else if (ph == 4) {
      for (int rep = 0; rep < REP_SSD; ++rep) phase_ssdC(p, g, layer, smem);
      for (int rep = 0; rep < REP_WIN; ++rep) phase_win(p, g, layer, smem);
      for (int rep = 0; rep < REP_NA; ++rep) phase_na(p, g, layer, smem);
    } else if (ph == 8) {
      for (int rep = 0; rep < REP_EW; ++rep) phase_act(p, g, layer);
    }
    if (step == 0) grid.sync();
    else xcd_barrier(xb);
  }
}

extern "C" void kernel_launch(void* const* d_in, const int* in_sizes, int n_in, void* d_out, int out_size,
                              void* d_ws, size_t ws_size, hipStream_t stream) {
  static int grid_blocks = 0;
  if (!grid_blocks) {
    int dev = 0, cus = 0, per_cu = 0;
    hipGetDevice(&dev);
    hipDeviceGetAttribute(&cus, hipDeviceAttributeMultiprocessorCount, dev);
    hipFuncSetAttribute((const void*)mega, hipFuncAttributeMaxDynamicSharedMemorySize, LDS_BYTES);
    hipOccupancyMaxActiveBlocksPerMultiprocessor(&per_cu, mega, 256, LDS_BYTES);
    if (per_cu > 2) per_cu = 2;
    if (per_cu < 1) per_cu = 1;
    grid_blocks = cus * per_cu;
  }
  Params p{};
  const float* const* in = (const float* const*)d_in;
  p.xp = in[0]; p.xs = in[1]; p.meta = in[2]; p.n_mix_pre = in[3]; p.n_mix_post = in[4]; p.w_in = in[5];
  p.conv_w = in[6]; p.conv_b = in[7]; p.dt_bias = in[8]; p.a_log = in[9]; p.ssd_d = in[10]; p.ssd_nw = in[11];
  p.sink = in[12]; p.rpb = in[13]; p.mbias = in[14]; p.w_out = in[15]; p.n_ffn_pre = in[16]; p.n_ffn_post = in[17];
  p.w_up = in[18]; p.fconv_w = in[19]; p.fconv_b = in[20]; p.w_down = in[21];
  p.out = (float*)d_out; p.ws = (char*)d_ws;
  if (ws_size < WS_NEED) fprintf(stderr, "workspace too small: %zu < %zu\n", ws_size, (size_t)WS_NEED);
  hipMemsetAsync((char*)d_ws + OFF_BAR, 0, XCD_BAR_WORDS * 4, stream);
  void* args[] = {&p};
  hipError_t e = hipLaunchCooperativeKernel((void*)mega, dim3(grid_blocks), dim3(256), args, LDS_BYTES, stream);
  if (e != hipSuccess) fprintf(stderr, "cooperative launch failed: %s (grid %d)\n", hipGetErrorString(e), grid_blocks);
}
```

```cpp
#include <hip/hip_runtime.h>
#include <hip/hip_cooperative_groups.h>
#include <cstdio>
namespace cg = cooperative_groups;

typedef unsigned short u16;
typedef __attribute__((ext_vector_type(8))) short bf16x8;
typedef __attribute__((ext_vector_type(4))) float f32x4;
typedef __attribute__((ext_vector_type(4))) unsigned int u32x4;
#define DEVI __device__ __forceinline__

constexpr int DM = 1024, DIN = 4896, DINP = 5120, DMIX = 2048, DFF = 2816, DUP = 5632;
constexpr int C_XBC = 1024, C_DT = 2560, C_WQ = 2592, C_WK = 3104, C_WV = 3232, C_NQ = 3360, C_NK = 3872, C_NV = 4384;
constexpr size_t RMAX = 16896;
constexpr int TMAX = 132;
constexpr float EPS = 1e-6f;
constexpr int LDS_BYTES = 77824;

constexpr size_t SZ_WIN = (size_t)2 * DINP * DM * 2;
constexpr size_t SZ_WOUT = (size_t)2 * DM * DMIX * 2;
constexpr size_t SZ_WUP = (size_t)2 * DUP * DM * 2;
constexpr size_t SZ_WDN = (size_t)2 * DM * DFF * 2;
constexpr size_t OFF_WIN = 0;
constexpr size_t OFF_WOUT = OFF_WIN + SZ_WIN;
constexpr size_t OFF_WUP = OFF_WOUT + SZ_WOUT;
constexpr size_t OFF_WDN = OFF_WUP + SZ_WUP;
constexpr size_t OFF_HMETA = OFF_WDN + SZ_WDN;
constexpr size_t OFF_HB = OFF_HMETA + (size_t)10 * 16 * DM * 4;
constexpr size_t OFF_U = OFF_HB + RMAX * DM * 2;
constexpr size_t OFF_XC = OFF_U + RMAX * DIN * 2;
constexpr size_t OFF_DT = OFF_XC + RMAX * 1536 * 2;
constexpr size_t OFF_ST = OFF_DT + RMAX * 32 * 4;
constexpr size_t OFF_YMIX = OFF_ST + (size_t)TMAX * 16 * 2 * 8192 * 2;
constexpr size_t OFF_SSQA = OFF_YMIX + RMAX * DMIX * 2;
constexpr size_t OFF_SSQB = OFF_SSQA + RMAX * 16 * 4;
constexpr size_t OFF_RS = OFF_SSQB + RMAX * 16 * 4;
constexpr size_t OFF_DEC = OFF_RS + RMAX * 4;
constexpr size_t WS_TOTAL = OFF_DEC + (size_t)TMAX * 16 * 2 * 4;
constexpr size_t OFF_BAR = (WS_TOTAL + 255) / 256 * 256;
constexpr size_t WS_NEED = OFF_BAR + 3456 * 4;
static_assert(RMAX * DUP * 2 <= RMAX * DIN * 2 + RMAX * 1536 * 2, "g alias");
static_assert(RMAX * DFF * 2 <= (size_t)TMAX * 16 * 2 * 8192 * 2 + RMAX * DMIX * 2, "act alias");
static_assert(WS_NEED < (size_t)512 * 1024 * 1024, "ws");

__constant__ float c_inv[8] = {1.0f, 0.1939227447486858f, 0.03760603093086394f, 0.007292664737217109f,
                               0.0014142135623730955f, 0.00027424817567620724f, 5.318295896944988e-05f,
                               1.0313385377212461e-05f};

struct Params {
  const float *xp, *xs, *meta, *n_mix_pre, *n_mix_post, *w_in, *conv_w, *conv_b, *dt_bias, *a_log, *ssd_d, *ssd_nw,
      *sink, *rpb, *mbias, *w_out, *n_ffn_pre, *n_ffn_post, *w_up, *fconv_w, *fconv_b, *w_down;
  float* out;
  char* ws;
};

typedef __attribute__((ext_vector_type(2))) __bf16 bf16x2_t;
typedef __attribute__((ext_vector_type(2))) float f32x2_t;
DEVI unsigned cvt_pk_bf16(float a, float b) {
  f32x2_t v = {a, b};
  return __builtin_bit_cast(unsigned, __builtin_convertvector(v, bf16x2_t));
}
DEVI u16 f2bf(float f) { return (u16)(cvt_pk_bf16(f, 0.f) & 0xffffu); }
DEVI float bf2f(u16 h) { return __uint_as_float(((unsigned)h) << 16); }
DEVI float silu_f(float x) { return x * __builtin_amdgcn_rcpf(1.f + __expf(-x)); }
DEVI void unpack8(uint4 v, float* f) {
  f[0] = __uint_as_float(v.x << 16); f[1] = __uint_as_float(v.x & 0xffff0000u);
  f[2] = __uint_as_float(v.y << 16); f[3] = __uint_as_float(v.y & 0xffff0000u);
  f[4] = __uint_as_float(v.z << 16); f[5] = __uint_as_float(v.z & 0xffff0000u);
  f[6] = __uint_as_float(v.w << 16); f[7] = __uint_as_float(v.w & 0xffff0000u);
}
DEVI unsigned pack2(float a, float b) { return cvt_pk_bf16(a, b); }
DEVI uint4 pack8(const float* f) {
  uint4 v; v.x = pack2(f[0], f[1]); v.y = pack2(f[2], f[3]); v.z = pack2(f[4], f[5]); v.w = pack2(f[6], f[7]);
  return v;
}
DEVI void ginfo(int g, int& nseq, int& tps, int& seq0) {
  if (g < 2) { nseq = 4; tps = 33; seq0 = 4 * g; } else { nseq = 1; tps = 129; seq0 = 8 + (g - 2); }
}
DEVI size_t seq_outrow(int seq) { return seq < 8 ? (size_t)seq * 4096 : (size_t)32768 + (size_t)(seq - 8) * 16384; }
template <int N>
DEVI float dpp_ror(float v) {
  return __builtin_bit_cast(float, __builtin_amdgcn_update_dpp(0, __builtin_bit_cast(int, v), 0x120 + N, 0xf, 0xf, false));
}
DEVI float red16_sum(float v) {
  v += dpp_ror<8>(v); v += dpp_ror<4>(v); v += dpp_ror<2>(v); v += dpp_ror<1>(v); return v;
}
DEVI float red16_max(float v) {
  v = fmaxf(v, dpp_ror<8>(v)); v = fmaxf(v, dpp_ror<4>(v)); v = fmaxf(v, dpp_ror<2>(v)); v = fmaxf(v, dpp_ror<1>(v));
  return v;
}
DEVI float red64_sum(float v) {
  v = red16_sum(v);
  v += __shfl_xor(v, 16); v += __shfl_xor(v, 32); return v;
}

DEVI int otid() { int t = threadIdx.x; asm volatile("" : "+v"(t)); return t; }
DEVI int obid() { return blockIdx.x; }

template <int MT, int NT, int KT>
DEVI void wave_mma(f32x4 (&acc)[MT][NT], const u16* A, int lda, int mstep, const u16* B, int ldb, int nstep, int lane) {
  const int fr = lane & 15, fq = lane >> 4;
  const u16* ap = A + fr * lda + fq * 8;
  const u16* bp = B + fr * ldb + fq * 8;
#pragma unroll
  for (int ks = 0; ks < KT; ++ks) {
    bf16x8 a[MT], b[NT];
#pragma unroll
    for (int m = 0; m < MT; ++m) a[m] = *reinterpret_cast<const bf16x8*>(ap + m * mstep + ks * 32);
#pragma unroll
    for (int n = 0; n < NT; ++n) b[n] = *reinterpret_cast<const bf16x8*>(bp + n * nstep + ks * 32);
    __builtin_amdgcn_s_setprio(1);
#pragma unroll
    for (int m = 0; m < MT; ++m)
#pragma unroll
      for (int n = 0; n < NT; ++n) acc[m][n] = __builtin_amdgcn_mfma_f32_16x16x32_bf16(a[m], b[n], acc[m][n], 0, 0, 0);
    __builtin_amdgcn_s_setprio(0);
  }
}

__device__ void prep_one(const float* src, u16* dst, int K, int N, int tk, int tn, const float* kscale, int klim,
                         char* smem) {
  float* tile = (float*)smem;
  const int tid = otid();
  const int k0 = tk * 64, n0 = tn * 64;
#pragma unroll 4
  for (int i = 0; i < 16; ++i) {
    int k = i * 4 + (tid >> 6), n = tid & 63;
    float v = 0.f;
    if (n0 + n < N) {
      v = src[(size_t)(k0 + k) * N + n0 + n];
      if (kscale && (k0 + k) < klim) v *= kscale[k0 + k];
    }
    tile[k * 65 + n] = v;
  }
  __syncthreads();
#pragma unroll 4
  for (int i = 0; i < 16; ++i) {
    int n = i * 4 + (tid >> 6), k = tid & 63;
    dst[(size_t)(n0 + n) * K + k0 + k] = f2bf(tile[k * 65 + n]);
  }
  __syncthreads();
}

__device__ void phase_prep(const Params& p, char* smem) {
  for (int it = obid(); it < 2 * 3904; it += gridDim.x) {
    int layer = it / 3904, r = it % 3904;
    if (r < 1280) {
      prep_one(p.w_in + (size_t)layer * DM * DIN, (u16*)(p.ws + OFF_WIN) + (size_t)layer * DINP * DM, DM, DIN, r / 80,
               r % 80, p.n_mix_pre + layer * DM, DM, smem);
    } else if (r < 1792) {
      r -= 1280;
      prep_one(p.w_out + (size_t)layer * DMIX * DM, (u16*)(p.ws + OFF_WOUT) + (size_t)layer * DM * DMIX, DMIX, DM,
               r / 16, r % 16, p.ssd_nw + layer * 1024, 1024, smem);
    } else if (r < 3200) {
      r -= 1792;
      prep_one(p.w_up + (size_t)layer * DM * DUP, (u16*)(p.ws + OFF_WUP) + (size_t)layer * DUP * DM, DM, DUP, r / 88,
               r % 88, p.n_ffn_pre + layer * DM, DM, smem);
    } else {
      r -= 3200;
      prep_one(p.w_down + (size_t)layer * DFF * DM, (u16*)(p.ws + OFF_WDN) + (size_t)layer * DM * DFF, DFF, DM, r / 16,
               r % 16, nullptr, 0, smem);
    }
  }
}

__device__ void phase_rowupd(const Params& p, int g, int mode, const u16* src, const float* w) {
  int nseq, tps, seq0; ginfo(g, nseq, tps, seq0);
  const int nrows = nseq * tps * 128;
  const int tid_ = otid(); const int lane = tid_ & 63, wid = tid_ >> 6;
  u16* hb = (u16*)(p.ws + OFF_HB);
  float* rs = (float*)(p.ws + OFF_RS);
  for (int Rp = obid() * 8 + wid * 2; Rp < nrows; Rp += gridDim.x * 8) {
    const int T = Rp >> 7, r = Rp & 127, sl = T / tps, c = T - sl * tps, seq = seq0 + sl;
    u16* hbrow = hb + (size_t)Rp * DM;
    const bool valid = (c > 0) || (r < 16);
    if (!valid) {
      if (mode == 0) {
        uint4 z = make_uint4(0, 0, 0, 0);
#pragma unroll
        for (int q = 0; q < 2; ++q) {
          *reinterpret_cast<uint4*>(hbrow + q * DM + lane * 16) = z;
          *reinterpret_cast<uint4*>(hbrow + q * DM + lane * 16 + 8) = z;
        }
        if (lane < 2) rs[Rp + lane] = 0.f;
      }
      continue;
    }
    if (mode == 2 && c == 0) continue;
    float4 v[2][4];
    if (mode == 0) {
      const float* xr;
      if (c == 0) xr = p.meta + (size_t)r * DM;
      else if (seq < 8) xr = p.xp + ((size_t)seq * 4096 + (size_t)(c - 1) * 128 + r) * DM;
      else xr = p.xs + ((size_t)(seq - 8) * 16384 + (size_t)(c - 1) * 128 + r) * DM;
#pragma unroll
      for (int q = 0; q < 2; ++q)
#pragma unroll
        for (int i = 0; i < 4; ++i) v[q][i] = *reinterpret_cast<const float4*>(xr + q * DM + lane * 4 + i * 256);
    } else {
      const u16* sr = src + (size_t)Rp * DM;
      uint2 sv[2][4], hv[2][4];
      float4 wv[4];
#pragma unroll
      for (int q = 0; q < 2; ++q)
#pragma unroll
        for (int i = 0; i < 4; ++i) {
          sv[q][i] = *reinterpret_cast<const uint2*>(sr + q * DM + lane * 4 + i * 256);
          hv[q][i] = *reinterpret_cast<const uint2*>(hbrow + q * DM + lane * 4 + i * 256);
        }
#pragma unroll
      for (int i = 0; i < 4; ++i) wv[i] = *reinterpret_cast<const float4*>(w + lane * 4 + i * 256);
#pragma unroll
      for (int q = 0; q < 2; ++q) {
        float tot = 0.f;
#pragma unroll
        for (int i = 0; i < 4; ++i) {
          float a0 = __uint_as_float(sv[q][i].x << 16), a1 = __uint_as_float(sv[q][i].x & 0xffff0000u);
          float a2 = __uint_as_float(sv[q][i].y << 16), a3 = __uint_as_float(sv[q][i].y & 0xffff0000u);
          tot += a0 * a0 + a1 * a1 + a2 * a2 + a3 * a3;
        }
        tot = red64_sum(tot);
        const float sc = rsqrtf(tot * (1.f / 1024.f) + EPS);
#pragma unroll
        for (int i = 0; i < 4; ++i) {
          float4 o;
          o.x = __uint_as_float(hv[q][i].x << 16) + __uint_as_float(sv[q][i].x << 16) * sc * wv[i].x;
          o.y = __uint_as_float(hv[q][i].x & 0xffff0000u) + __uint_as_float(sv[q][i].x & 0xffff0000u) * sc * wv[i].y;
          o.z = __uint_as_float(hv[q][i].y << 16) + __uint_as_float(sv[q][i].y << 16) * sc * wv[i].z;
          o.w = __uint_as_float(hv[q][i].y & 0xffff0000u) + __uint_as_float(sv[q][i].y & 0xffff0000u) * sc * wv[i].w;
          v[q][i] = o;
        }
      }
    }
    if (mode == 2) {
      float* op = p.out + (seq_outrow(seq) + (size_t)(c - 1) * 128 + r) * DM;
#pragma unroll
      for (int q = 0; q < 2; ++q)
#pragma unroll
        for (int i = 0; i < 4; ++i) *reinterpret_cast<float4*>(op + q * DM + lane * 4 + i * 256) = v[q][i];
      continue;
    }
#pragma unroll
    for (int q = 0; q < 2; ++q) {
      float ss = 0.f;
#pragma unroll
      for (int i = 0; i < 4; ++i) {
        ss += v[q][i].x * v[q][i].x + v[q][i].y * v[q][i].y + v[q][i].z * v[q][i].z + v[q][i].w * v[q][i].w;
        uint2 bb; bb.x = pack2(v[q][i].x, v[q][i].y); bb.y = pack2(v[q][i].z, v[q][i].w);
        *reinterpret_cast<uint2*>(hbrow + q * DM + lane * 4 + i * 256) = bb;
      }
      ss = red64_sum(ss);
      if (lane == 0) rs[Rp + q] = rsqrtf(ss * (1.f / 1024.f) + EPS);
    }
  }
}

struct GemmCursor { int it, kt; const u16* ap; const u16* bp; };
struct GemmMap { int bid, G, ntm, ntn, ntnp, swz, ni; };
DEVI int gemm_T(int tm, int tpr) { return tm + tm / tpr + 1; }
DEVI bool gemm_map(const GemmMap& M, int it, int& tm, int& tn) {
  if (M.swz == 2) {
    const int xcd = M.bid & 7, j = M.bid >> 3;
    const int P = it * 8 + xcd;
    const int ptm = P / M.ntnp, ptn = P - ptm * M.ntnp;
    tm = ptm * 8 + (j & 7);
    tn = ptn * 8 + (j >> 3);
    bool v = tn < M.ntn;
    if (!v) tn = M.ntn - 1;
    return v;
  }
  if (M.swz) {
    const int xcd = M.bid & 7, j = M.bid >> 3, half = j >> 5, q = j & 31;
    const int P = (it * 8 + xcd) * 2 + half;
    const int ptm = P / M.ntnp, ptn = P - ptm * M.ntnp;
    tm = ptm * 8 + (q & 7);
    tn = ptn * 4 + (q >> 3);
    bool v = tn < M.ntn;
    if (!v) tn = M.ntn - 1;
    return v;
  }
  int item = M.bid + it * M.G;
  bool v = item < M.ntm * M.ntn;
  if (!v) item = M.ntm * M.ntn - 1;
  tm = item / M.ntn; tn = item - tm * M.ntn;
  return v;
}
DEVI void gemm_gload(u32x4 (&RA)[4], u32x4 (&RB)[4], GemmCursor& L, const GemmMap& M, const u16* A, int lda, const u16* Bt,
                     int K, int nk, int lrow, int lkc, int tpr) {
#pragma unroll
  for (int i = 0; i < 4; ++i) {
    RA[i] = *reinterpret_cast<const u32x4*>(L.ap + (size_t)(32 * i) * lda);
    RB[i] = *reinterpret_cast<const u32x4*>(L.bp + (size_t)(32 * i) * K);
  }
  L.ap += 64; L.bp += 64;
  if (++L.kt == nk) {
    L.kt = 0;
    if (L.it + 1 < M.ni) L.it += 1;
    int tm_, tn_;
    gemm_map(M, L.it, tm_, tn_);
    L.ap = A + ((size_t)gemm_T(tm_, tpr) * 128 + lrow) * lda + lkc * 8;
    L.bp = Bt + ((size_t)tn_ * 128 + lrow) * K + lkc * 8;
  }
}
DEVI void gemm_sstore(const u32x4 (&RA)[4], const u32x4 (&RB)[4], char* As, char* Bs, const int (&soff)[4]) {
#pragma unroll
  for (int i = 0; i < 4; ++i) {
    *reinterpret_cast<u32x4*>(As + soff[i]) = RA[i];
    *reinterpret_cast<u32x4*>(Bs + soff[i]) = RB[i];
  }
}
DEVI void gemm_frags(bf16x8 (&a_)[2][4], bf16x8 (&b_)[2][4], const char* As, const char* Bs, const int (&aoff)[2],
                     const int (&boff)[2]) {
#pragma unroll
  for (int ks = 0; ks < 2; ++ks) {
#pragma unroll
    for (int m = 0; m < 4; ++m) a_[ks][m] = *reinterpret_cast<const bf16x8*>(As + aoff[ks] + m * 256);
#pragma unroll
    for (int n = 0; n < 4; ++n) b_[ks][n] = *reinterpret_cast<const bf16x8*>(Bs + boff[ks] + n * 256);
  }
}
template <int KS>
DEVI void gemm_mfma(f32x4 (&acc)[4][4], const bf16x8 (&a_)[2][4], const bf16x8 (&b_)[2][4]) {
  __builtin_amdgcn_s_setprio(1);
#pragma unroll
  for (int m = 0; m < 4; ++m)
#pragma unroll
    for (int n = 0; n < 4; ++n)
      acc[m][n] = __builtin_amdgcn_mfma_f32_16x16x32_bf16(a_[KS][m], b_[KS][n], acc[m][n], 0, 0, 0);
  __builtin_amdgcn_s_setprio(0);
}

template <int MODE>
__device__ void phase_gemm(const u16* __restrict__ A, int lda, const u16* __restrict__ Bt, int K, int ntm, int ntn,
                           int nvalid, const float* rowscale, u16* outb, int ldo, int tpr,
                           const float* ssqk, char* smem) {
  char* As = smem;
  char* Bs = smem + 32768;
  float* rsv = (float*)(smem + 65536);
  const int tid = otid(), lane = tid & 63, wid = tid >> 6, wr = wid >> 1, wc = wid & 1;
  const int fr = lane & 15, fq = lane >> 4;
  u16* Cw = (u16*)(smem + 66048) + wid * (16 * 72);
  const int lrow = tid >> 3, lkc = tid & 7;
  const int nk = K / 64;
  GemmMap M;
  M.bid = obid(); M.G = gridDim.x; M.ntm = ntm; M.ntn = ntn; M.ntnp = (ntn + 3) >> 2;
  M.swz = (M.G == 512 && ntm == 128) ? 1 : 0;
  if (M.swz && ((ntn + 7) >> 3) * 2 == M.ntnp) { M.swz = 2; M.ntnp = (ntn + 7) >> 3; }
  M.ni = (M.swz == 2) ? 2 * M.ntnp : (M.swz ? M.ntnp : (ntm * ntn + M.G - 1) / M.G);
  const int S = M.ni * nk;
  int soff[4];
#pragma unroll
  for (int i = 0; i < 4; ++i) soff[i] = lkc * 2048 + (((lrow + 32 * i) ^ lkc) * 16);
  int aoff[2], boff[2];
#pragma unroll
  for (int ks = 0; ks < 2; ++ks) {
    int kc = ks * 4 + fq;
    aoff[ks] = kc * 2048 + ((wr * 64 + (fr ^ kc)) * 16);
    boff[ks] = kc * 2048 + ((wc * 64 + (fr ^ kc)) * 16);
  }
  GemmCursor L;
  L.it = 0; L.kt = 0;
  {
    int tm, tn;
    gemm_map(M, 0, tm, tn);
    L.ap = A + ((size_t)gemm_T(tm, tpr) * 128 + lrow) * lda + lkc * 8;
    L.bp = Bt + ((size_t)tn * 128 + lrow) * K + lkc * 8;
  }
  u32x4 r0a[4], r0b[4], r1a[4], r1b[4];
  f32x4 acc[4][4];
#define GLOAD(RA, RB) gemm_gload(RA, RB, L, M, A, lda, Bt, K, nk, lrow, lkc, tpr)
#define SSTORE(RA, RB, BUF) gemm_sstore(RA, RB, As + (BUF) * 16384, Bs + (BUF) * 16384, soff)
#define FRAGS(BUF) gemm_frags(fa, fb, As + (BUF) * 16384, Bs + (BUF) * 16384, aoff, boff)
#define MFMAS(KS) gemm_mfma<KS>(acc, fa, fb)
  bf16x8 fa[2][4], fb[2][4];
  int cit = 0, ckt = 0;
  float rs_reg = 0.f;
  GLOAD(r0a, r0b);
  GLOAD(r1a, r1b);
  SSTORE(r0a, r0b, 0);
  __syncthreads();
  for (int s = 0; s < S; s += 2) {
    FRAGS(0);
    if (ckt == 0) {
#pragma unroll
      for (int m = 0; m < 4; ++m)
#pragma unroll
        for (int n = 0; n < 4; ++n) acc[m][n] = f32x4{0.f, 0.f, 0.f, 0.f};
      if (MODE == 0 && tid < 128) {
        int tmr_, tn_;
        gemm_map(M, cit, tmr_, tn_);
        rs_reg = rowscale[(size_t)gemm_T(tmr_, tpr) * 128 + tid];
      }
      if (MODE == 1 && ssqk != nullptr && tid < 128) {
        int tmr_, tn_;
        gemm_map(M, cit, tmr_, tn_);
        const int tm = gemm_T(tmr_, tpr);
        const float* q = ssqk + ((size_t)tm * 128 + tid) * 16;
        float t = 0.f;
#pragma unroll
        for (int i = 0; i < 16; ++i) t += q[i];
        rsv[tid] = rsqrtf(t * (1.f / 1024.f) + EPS);
      }
    }
    if (MODE == 0 && ckt == 2 && tid < 128) rsv[tid] = rs_reg;
    if (MODE == 1 && ssqk != nullptr && ckt == 16) {
#pragma unroll
      for (int m = 0; m < 4; ++m)
#pragma unroll
        for (int j = 0; j < 4; ++j) {
          float sc = rsv[wr * 64 + m * 16 + fq * 4 + j];
#pragma unroll
          for (int n = 0; n < 4; ++n) acc[m][n][j] *= sc;
        }
    }
    SSTORE(r1a, r1b, 1);
    MFMAS(0);
    MFMAS(1);
    GLOAD(r0a, r0b);
    __syncthreads();
    FRAGS(1);
    SSTORE(r0a, r0b, 0);
    MFMAS(0);
    MFMAS(1);
    GLOAD(r1a, r1b);
    ckt += 2;
    if (ckt == nk) {
      int tmr, tn;
      const bool valid = gemm_map(M, cit, tmr, tn);
      const int tm = gemm_T(tmr, tpr);
      if (!valid) {
      } else if (MODE == 0) {
#pragma unroll
        for (int m = 0; m < 4; ++m) {
#pragma unroll
          for (int j = 0; j < 4; ++j) {
            float sc = rsv[wr * 64 + m * 16 + fq * 4 + j];
#pragma unroll
            for (int n = 0; n < 4; ++n) Cw[(fq * 4 + j) * 72 + n * 16 + fr] = f2bf(acc[m][n][j] * sc);
          }
#pragma unroll
          for (int i = 0; i < 2; ++i) {
            int c = lane + 64 * i, row = c >> 3, ch = c & 7;
            int col = tn * 128 + wc * 64 + ch * 8;
            uint4 v = *reinterpret_cast<const uint4*>(Cw + row * 72 + ch * 8);
            if (col < nvalid)
              *reinterpret_cast<uint4*>(outb + ((size_t)tm * 128 + wr * 64 + m * 16 + row) * ldo + col) = v;
          }
        }
      } else {
#pragma unroll
        for (int m = 0; m < 4; ++m) {
#pragma unroll
          for (int j = 0; j < 4; ++j) {
#pragma unroll
            for (int n = 0; n < 4; ++n) Cw[(fq * 4 + j) * 72 + n * 16 + fr] = f2bf(acc[m][n][j]);
          }
#pragma unroll
          for (int i = 0; i < 2; ++i) {
            int c = lane + 64 * i, row = c >> 3, ch = c & 7;
            int col = tn * 128 + wc * 64 + ch * 8;
            uint4 v = *reinterpret_cast<const uint4*>(Cw + row * 72 + ch * 8);
            *reinterpret_cast<uint4*>(outb + ((size_t)tm * 128 + wr * 64 + m * 16 + row) * ldo + col) = v;
          }
        }
      }
      cit += 1; ckt = 0;
    }
    __syncthreads();
  }
#undef GLOAD
#undef SSTORE
#undef FRAGS
#undef MFMAS
}

template <int MODE>
__device__ void phase_gemm_w(const u16* __restrict__ A, int lda, const u16* __restrict__ Bt, int K, int ntm, int ntn,
                             int nvalid, const float* rowscale, u16* outb, int ldo, int tpr,
                             const float* ssqk, char* smem) {
  char* As = smem;
  char* Bs = smem + 16384;
  float* rsv = (float*)(smem + 49152);
  const int tid = otid(), lane = tid & 63, wid = tid >> 6, wr = wid >> 1, wc = wid & 1;
  const int fr = lane & 15, fq = lane >> 4;
  u16* Cw = (u16*)(smem + 49664) + wid * (16 * 136);
  const int lrow = tid >> 2, lkc = tid & 3;
  const int nk = K / 32;
  GemmMap M;
  M.bid = obid(); M.G = gridDim.x; M.ntm = ntm; M.ntn = ntn; M.ntnp = (ntn + 3) >> 2;
  M.swz = (M.G == 512 && ntm == 128) ? 1 : 0;
  M.ni = M.swz ? M.ntnp : (ntm * ntn + M.G - 1) / M.G;
  const int S = M.ni * nk;
  const int sa0 = lkc * 2048 + ((lrow ^ (lkc << 1)) * 16);
  const int sb0 = lkc * 4096 + ((lrow ^ (lkc << 1)) * 16);
  const int aoff = fq * 2048 + ((wr * 64 + (fr ^ (fq << 1))) * 16);
  const int boff = fq * 4096 + ((wc * 128 + (fr ^ (fq << 1))) * 16);
  int lit = 0, lkt = 0;
  const u16* ap; const u16* bp;
  {
    int tm, tn;
    gemm_map(M, 0, tm, tn);
    ap = A + ((size_t)gemm_T(tm, tpr) * 128 + lrow) * lda + lkc * 8;
    bp = Bt + ((size_t)tn * 256 + lrow) * K + lkc * 8;
  }
  u32x4 ra[2], rb[4];
  f32x4 acc[4][8];
  bf16x8 fa[4], fb[8];
  auto gload = [&]() __attribute__((always_inline)) {
#pragma unroll
    for (int i = 0; i < 2; ++i) ra[i] = *reinterpret_cast<const u32x4*>(ap + (size_t)(64 * i) * lda);
#pragma unroll
    for (int i = 0; i < 4; ++i) rb[i] = *reinterpret_cast<const u32x4*>(bp + (size_t)(64 * i) * K);
    ap += 32; bp += 32;
    if (++lkt == nk) {
      lkt = 0;
      if (lit + 1 < M.ni) lit += 1;
      int tm_, tn_;
      gemm_map(M, lit, tm_, tn_);
      ap = A + ((size_t)gemm_T(tm_, tpr) * 128 + lrow) * lda + lkc * 8;
      bp = Bt + ((size_t)tn_ * 256 + lrow) * K + lkc * 8;
    }
  };
  auto sstore = [&](int buf) __attribute__((always_inline)) {
#pragma unroll
    for (int i = 0; i < 2; ++i) *reinterpret_cast<u32x4*>(As + buf * 8192 + sa0 + i * 1024) = ra[i];
#pragma unroll
    for (int i = 0; i < 4; ++i) *reinterpret_cast<u32x4*>(Bs + buf * 16384 + sb0 + i * 1024) = rb[i];
  };
  auto frags = [&](int buf) __attribute__((always_inline)) {
#pragma unroll
    for (int m = 0; m < 4; ++m) fa[m] = *reinterpret_cast<const bf16x8*>(As + buf * 8192 + aoff + m * 256);
#pragma unroll
    for (int n = 0; n < 8; ++n) fb[n] = *reinterpret_cast<const bf16x8*>(Bs + buf * 16384 + boff + n * 256);
  };
  auto mfmas = [&]() __attribute__((always_inline)) {
    __builtin_amdgcn_s_setprio(1);
#pragma unroll
    for (int m = 0; m < 4; ++m)
#pragma unroll
      for (int n = 0; n < 8; ++n) acc[m][n] = __builtin_amdgcn_mfma_f32_16x16x32_bf16(fa[m], fb[n], acc[m][n], 0, 0, 0);
    __builtin_amdgcn_s_setprio(0);
  };
  int cit = 0, ckt = 0;
  float rs_reg = 0.f;
  gload();
  sstore(0);
  gload();
  __syncthreads();
  for (int s = 0; s < S; s += 2) {
    frags(0);
    if (ckt == 0) {
#pragma unroll
      for (int m = 0; m < 4; ++m)
#pragma unroll
        for (int n = 0; n < 8; ++n) acc[m][n] = f32x4{0.f, 0.f, 0.f, 0.f};
      if (tid < 128) {
        int tmr_, tn_;
        gemm_map(M, cit, tmr_, tn_);
        const size_t R = (size_t)gemm_T(tmr_, tpr) * 128 + tid;
        if (MODE == 0) rs_reg = rowscale[R];
        if (MODE == 1 && ssqk != nullptr) {
          const float* q = ssqk + R * 16;
          float t = 0.f;
#pragma unroll
          for (int i = 0; i < 16; ++i) t += q[i];
          rsv[tid] = rsqrtf(t * (1.f / 1024.f) + EPS);
        }
      }
    }
    if (MODE == 0 && ckt == 2 && tid < 128) rsv[tid] = rs_reg;
    if (MODE == 1 && ssqk != nullptr && ckt == 32) {
#pragma unroll
      for (int m = 0; m < 4; ++m)
#pragma unroll
        for (int j = 0; j < 4; ++j) {
          float sc = rsv[wr * 64 + m * 16 + fq * 4 + j];
#pragma unroll
          for (int n = 0; n < 8; ++n) acc[m][n][j] *= sc;
        }
    }
    sstore(1);
    mfmas();
    gload();
    __syncthreads();
    frags(1);
    sstore(0);
    mfmas();
    gload();
    ckt += 2;
    if (ckt == nk) {
      int tmr, tn;
      const bool valid = gemm_map(M, cit, tmr, tn);
      const int tm = gemm_T(tmr, tpr);
      if (valid) {
#pragma unroll
        for (int m = 0; m < 4; ++m) {
#pragma unroll
          for (int j = 0; j < 4; ++j) {
            float sc = 1.f;
            if (MODE == 0) sc = rsv[wr * 64 + m * 16 + fq * 4 + j];
#pragma unroll
            for (int n = 0; n < 8; ++n) Cw[(fq * 4 + j) * 136 + n * 16 + fr] = f2bf(acc[m][n][j] * sc);
          }
#pragma unroll
          for (int i = 0; i < 4; ++i) {
            int c = lane + 64 * i, row = c >> 4, ch = c & 15;
            int col = tn * 256 + wc * 128 + ch * 8;
            uint4 v = *reinterpret_cast<const uint4*>(Cw + row * 136 + ch * 8);
            if (col < nvalid)
              *reinterpret_cast<uint4*>(outb + ((size_t)tm * 128 + wr * 64 + m * 16 + row) * ldo + col) = v;
          }
        }
      }
      cit += 1; ckt = 0;
    }
    __syncthreads();
  }
}

template <int MODE, int BATCH>
DEVI void gemm_meta_items(const u16* __restrict__ A, int lda, const u16* __restrict__ Bt, int K, int tps, int nn16,
                          const float* rowscale, u16* outb, int ldo, const float* ssqk, int wid, int fr, int fq) {
  const int G = gridDim.x, bid = obid();
  const size_t R0 = (size_t)wid * tps * 128;
  const u16* ap = A + (R0 + fr) * lda + fq * 8;
  const int nks = K / 32;
  for (int it = G - 1 - bid; it < nn16; it += G) {
    const u16* bp = Bt + ((size_t)it * 16 + fr) * K + fq * 8;
    f32x4 acc = f32x4{0.f, 0.f, 0.f, 0.f};
    for (int ks0 = 0; ks0 < nks; ks0 += BATCH) {
      bf16x8 a[BATCH], b[BATCH];
#pragma unroll
      for (int i = 0; i < BATCH; ++i) {
        a[i] = *reinterpret_cast<const bf16x8*>(ap + (ks0 + i) * 32);
        b[i] = *reinterpret_cast<const bf16x8*>(bp + (ks0 + i) * 32);
      }
      if (MODE == 1 && ssqk != nullptr && ks0 == 32) {
#pragma unroll
        for (int j = 0; j < 4; ++j) {
          const float* q = ssqk + (R0 + fq * 4 + j) * 16;
          float t = 0.f;
#pragma unroll
          for (int i = 0; i < 16; ++i) t += q[i];
          acc[j] *= rsqrtf(t * (1.f / 1024.f) + EPS);
        }
      }
#pragma unroll
      for (int i = 0; i < BATCH; ++i) acc = __builtin_amdgcn_mfma_f32_16x16x32_bf16(a[i], b[i], acc, 0, 0, 0);
    }
#pragma unroll
    for (int j = 0; j < 4; ++j) {
      size_t R = R0 + fq * 4 + j;
      float v = acc[j];
      if (MODE == 0) v *= rowscale[R];
      outb[R * ldo + it * 16 + fr] = f2bf(v);
    }
  }
}
template <int MODE>
__device__ void phase_gemm_meta(const u16* __restrict__ A, int lda, const u16* __restrict__ Bt, int K, int nseq, int tps,
                                int nn16, const float* rowscale, u16* outb, int ldo, const float* ssqk) {
  const int tid = otid(), lane = tid & 63, wid = tid >> 6, fr = lane & 15, fq = lane >> 4;
  if (wid >= nseq) return;
  if (((K / 32) & 15) == 0) gemm_meta_items<MODE, 16>(A, lda, Bt, K, tps, nn16, rowscale, outb, ldo, ssqk, wid, fr, fq);
  else gemm_meta_items<MODE, 11>(A, lda, Bt, K, tps, nn16, rowscale, outb, ldo, ssqk, wid, fr, fq);
}

__device__ void phase_conv(const Params& p, int g, int layer) {
  int nseq, tps, seq0; ginfo(g, nseq, tps, seq0);
  const int ntiles = nseq * tps;
  const int L = (tps - 1) * 128 + 16;
  const u16* u = (const u16*)(p.ws + OFF_U);
  u16* xc = (u16*)(p.ws + OFF_XC);
  float* dtb = (float*)(p.ws + OFF_DT);
  const float* cw = p.conv_w + (size_t)layer * 5 * 1536;
  const float* cb = p.conv_b + (size_t)layer * 1536;
  const int total = ntiles * 8 * 192;
  for (int id = obid() * 256 + otid(); id < total; id += gridDim.x * 256) {
    const int ch = id % 192, ts = id / 192, seg = ts & 7, T = ts >> 3;
    const int sl = T / tps, c = T - sl * tps;
    const int col = ch * 8;
    const size_t Rseq = (size_t)sl * tps * 128;
    u16* orow = xc + ((size_t)T * 128 + seg * 16) * 1536 + col;
    const int nvalid = (c > 0) ? 16 : (seg == 0 ? 16 : 0);
    if (nvalid == 0) {
      uint4 z = make_uint4(0, 0, 0, 0);
#pragma unroll 4
      for (int r = 0; r < 16; ++r) *reinterpret_cast<uint4*>(orow + (size_t)r * 1536) = z;
      continue;
    }
    const int pos0 = (c == 0) ? 0 : 16 + (c - 1) * 128 + seg * 16;
    float w[5][8], bias[8];
#pragma unroll
    for (int j = 0; j < 5; ++j) {
      float4 w0 = *reinterpret_cast<const float4*>(cw + j * 1536 + col), w1 = *reinterpret_cast<const float4*>(cw + j * 1536 + col + 4);
      w[j][0] = w0.x; w[j][1] = w0.y; w[j][2] = w0.z; w[j][3] = w0.w; w[j][4] = w1.x; w[j][5] = w1.y; w[j][6] = w1.z; w[j][7] = w1.w;
    }
    {
      float4 b0 = *reinterpret_cast<const float4*>(cb + col), b1 = *reinterpret_cast<const float4*>(cb + col + 4);
      bias[0] = b0.x; bias[1] = b0.y; bias[2] = b0.z; bias[3] = b0.w; bias[4] = b1.x; bias[5] = b1.y; bias[6] = b1.z; bias[7] = b1.w;
    }
    float win[5][8];
    auto ldrow = [&](int pp, float* dst) {
      if (pp >= 0 && pp < L) {
        int prow = (pp < 16) ? pp : 112 + pp;
        uint4 v = *reinterpret_cast<const uint4*>(u + (Rseq + prow) * DIN + C_XBC + col);
        unpack8(v, dst);
      } else {
#pragma unroll
        for (int i = 0; i < 8; ++i) dst[i] = 0.f;
      }
    };
    ldrow(pos0 - 2, win[0]); ldrow(pos0 - 1, win[1]); ldrow(pos0, win[2]); ldrow(pos0 + 1, win[3]);
#pragma unroll
    for (int r = 0; r < 16; ++r) {
      ldrow(pos0 + r + 2, win[(r + 4) % 5]);
      float acc[8];
#pragma unroll
      for (int i = 0; i < 8; ++i) {
        float a = bias[i];
#pragma unroll
        for (int j = 0; j < 5; ++j) a += win[(r + j) % 5][i] * w[j][i];
        acc[i] = silu_f(a);
      }
      *reinterpret_cast<uint4*>(orow + (size_t)r * 1536) = pack8(acc);
    }
  }
  const int nrows = ntiles * 128;
  for (int id = obid() * 256 + otid(); id < nrows * 4; id += gridDim.x * 256) {
    const int R = id >> 2, h0 = (id & 3) * 8;
    const int T = R >> 7, r = R & 127, sl = T / tps, c = T - sl * tps;
    const bool valid = (c > 0) || (r < 16);
    float o[8];
    uint4 v = *reinterpret_cast<const uint4*>(u + (size_t)R * DIN + C_DT + h0);
    float f[8]; unpack8(v, f);
#pragma unroll
    for (int i = 0; i < 8; ++i) {
      float x = f[i] + p.dt_bias[layer * 32 + h0 + i];
      float sp = (x > 20.f) ? x : log1pf(__expf(x));
      o[i] = valid ? sp : 0.f;
    }
    *reinterpret_cast<float4*>(dtb + (size_t)R * 32 + h0) = make_float4(o[0], o[1], o[2], o[3]);
    *reinterpret_cast<float4*>(dtb + (size_t)R * 32 + h0 + 4) = make_float4(o[4], o[5], o[6], o[7]);
  }
}

DEVI void ssd_cumsums(const float* dt, size_t R0, int hd, float Af, float Ab, float* acsf, float* rcs, float* dtf,
                      float* dtbk, int tid_) {
  const int lane = tid_ & 63, wid = tid_ >> 6;
  if (wid < 2) {
    const int dir = wid;
    float d0 = dt[(R0 + 2 * lane) * 32 + dir * 16 + hd], d1 = dt[(R0 + 2 * lane + 1) * 32 + dir * 16 + hd];
    float A_ = dir ? Ab : Af;
    float a0 = d0 * A_, a1 = d1 * A_;
    float s = a0 + a1, inc = s;
#pragma unroll
    for (int o = 1; o < 64; o <<= 1) {
      float t = __shfl_up(inc, o);
      if (lane >= o) inc += t;
    }
    float excl = inc - s;
    if (dir == 0) {
      acsf[2 * lane] = excl + a0; acsf[2 * lane + 1] = inc;
      dtf[2 * lane] = d0; dtf[2 * lane + 1] = d1;
    } else {
      float tot = __shfl(inc, 63);
      rcs[2 * lane] = tot - excl; rcs[2 * lane + 1] = tot - (excl + a0);
      dtbk[2 * lane] = d0; dtbk[2 * lane + 1] = d1;
    }
  }
}

__device__ void phase_ssdA(const Params& p, int g, int layer, char* smem) {
  int nseq, tps, seq0; ginfo(g, nseq, tps, seq0);
  const int ntiles = nseq * tps;
  u16* Bt = (u16*)smem;
  u16* Xt = Bt + 128 * 136;
  float* arr = (float*)(Xt + 64 * 136);
  float *acsf = arr, *rcs = arr + 128, *dtf = arr + 256, *dtbk = arr + 384;
  const int tid = otid(), lane = tid & 63, wid = tid >> 6, fr = lane & 15, fq = lane >> 4;
  const u16* xc = (const u16*)(p.ws + OFF_XC);
  const float* dt = (const float*)(p.ws + OFF_DT);
  u16* st = (u16*)(p.ws + OFF_ST);
  float* dec = (float*)(p.ws + OFF_DEC);
  for (int item = obid(); item < ntiles * 16; item += gridDim.x) {
    const int T = item >> 4, hd = item & 15, grp = hd >> 3;
    const size_t R0 = (size_t)T * 128;
    const float Af = -1.4426950408889634f * __expf(p.a_log[layer * 32 + hd]), Ab = -1.4426950408889634f * __expf(p.a_log[layer * 32 + 16 + hd]);
    ssd_cumsums(dt, R0, hd, Af, Ab, acsf, rcs, dtf, dtbk, tid);
    for (int id = tid; id < 128 * 16; id += 256) {
      int l = id & 127, ch = id >> 7;
      uint4 v = *reinterpret_cast<const uint4*>(xc + (R0 + l) * 1536 + 1024 + grp * 128 + ch * 8);
      u16* d = Bt + (ch * 8) * 136 + l;
      d[0 * 136] = (u16)(v.x & 0xffff); d[1 * 136] = (u16)(v.x >> 16);
      d[2 * 136] = (u16)(v.y & 0xffff); d[3 * 136] = (u16)(v.y >> 16);
      d[4 * 136] = (u16)(v.z & 0xffff); d[5 * 136] = (u16)(v.z >> 16);
      d[6 * 136] = (u16)(v.w & 0xffff); d[7 * 136] = (u16)(v.w >> 16);
    }
    __syncthreads();
#pragma unroll 1
    for (int dir = 0; dir < 2; ++dir) {
      const float ref = dir ? rcs[0] : acsf[127];
      for (int id = tid; id < 128 * 8; id += 256) {
        int l = id & 127, ch = id >> 7;
        uint4 v = *reinterpret_cast<const uint4*>(xc + (R0 + l) * 1536 + hd * 64 + ch * 8);
        float f[8]; unpack8(v, f);
        float w = dir ? dtbk[l] * __builtin_amdgcn_exp2f(ref - rcs[l]) : dtf[l] * __builtin_amdgcn_exp2f(ref - acsf[l]);
        u16* d = Xt + (ch * 8) * 136 + l;
#pragma unroll
        for (int i = 0; i < 8; ++i) d[i * 136] = f2bf(f[i] * w);
      }
      __syncthreads();
      f32x4 acc[4][2];
#pragma unroll
      for (int m = 0; m < 4; ++m)
#pragma unroll
        for (int n = 0; n < 2; ++n) acc[m][n] = f32x4{0.f, 0.f, 0.f, 0.f};
      wave_mma<4, 2, 4>(acc, Xt, 136, 16 * 136, Bt + (wid * 32) * 136, 136, 16 * 136, lane);
      u16* so = st + ((size_t)(T * 16 + hd) * 2 + dir) * 8192;
#pragma unroll
      for (int m = 0; m < 4; ++m)
#pragma unroll
        for (int n = 0; n < 2; ++n)
#pragma unroll
          for (int j = 0; j < 4; ++j) so[(16 * m + fq * 4 + j) * 128 + wid * 32 + 16 * n + fr] = f2bf(acc[m][n][j]);
      __syncthreads();
    }
    if (tid == 0) {
      dec[(size_t)(T * 16 + hd) * 2] = __builtin_amdgcn_exp2f(acsf[127]);
      dec[(size_t)(T * 16 + hd) * 2 + 1] = __builtin_amdgcn_exp2f(rcs[0]);
    }
    __syncthreads();
  }
}

__device__ void phase_scan(const Params& p, int g) {
  int nseq, tps, seq0; ginfo(g, nseq, tps, seq0);
  u16* st = (u16*)(p.ws + OFF_ST);
  const float* dec = (const float*)(p.ws + OFF_DEC);
  const int total = nseq * 32 * 4096;
  for (int i = obid() * 256 + otid(); i < total; i += gridDim.x * 256) {
    const int e2 = i & 4095, chn = i >> 12, dir = chn & 1, hd = (chn >> 1) & 15, sl = chn >> 5;
    float r0 = 0.f, r1 = 0.f;
    for (int cc = 0; cc < tps; cc += 16) {
      unsigned v[16]; float dc[16];
#pragma unroll
      for (int q = 0; q < 16; ++q) {
        int c = cc + q;
        v[q] = 0; dc[q] = 0.f;
        if (c < tps) {
          int ct = dir ? (tps - 1 - c) : c;
          size_t idx = ((size_t)(sl * tps + ct) * 16 + hd) * 2 + dir;
          v[q] = *reinterpret_cast<const unsigned*>(st + idx * 8192 + e2 * 2);
          dc[q] = dec[idx];
        }
      }
#pragma unroll
      for (int q = 0; q < 16; ++q) {
        int c = cc + q;
        if (c < tps) {
          int ct = dir ? (tps - 1 - c) : c;
          size_t idx = ((size_t)(sl * tps + ct) * 16 + hd) * 2 + dir;
          float s0 = __uint_as_float(v[q] << 16), s1 = __uint_as_float(v[q] & 0xffff0000u);
          *reinterpret_cast<unsigned*>(st + idx * 8192 + e2 * 2) = pack2(r0, r1);
          r0 = dc[q] * r0 + s0; r1 = dc[q] * r1 + s1;
        }
      }
    }
  }
}

__device__ void phase_ssdC(const Params& p, int g, int layer, char* smem) {
  int nseq, tps, seq0; ginfo(g, nseq, tps, seq0);
  const int ntiles = nseq * tps;
  u16* R0b = (u16*)smem;
  u16* R1b = R0b + 128 * 136;
  float* arr = (float*)(R1b + 128 * 136);
  float *acsf = arr, *rcs = arr + 128, *dtf = arr + 256, *dtbk = arr + 384;
  const int tid = otid(), lane = tid & 63, wid = tid >> 6, fr = lane & 15, fq = lane >> 4;
  const u16* xc = (const u16*)(p.ws + OFF_XC);
  const u16* u = (const u16*)(p.ws + OFF_U);
  const float* dt = (const float*)(p.ws + OFF_DT);
  const u16* st = (const u16*)(p.ws + OFF_ST);
  u16* ymix = (u16*)(p.ws + OFF_YMIX);
  float* ssqa = (float*)(p.ws + OFF_SSQA);
  for (int item = obid(); item < ntiles * 16; item += gridDim.x) {
    const int T = item >> 4, hd = item & 15, grp = hd >> 3;
    const size_t Rb = (size_t)T * 128;
    const float Af = -1.4426950408889634f * __expf(p.a_log[layer * 32 + hd]), Ab = -1.4426950408889634f * __expf(p.a_log[layer * 32 + 16 + hd]);
    const float Dh = p.ssd_d[layer * 16 + hd];
    ssd_cumsums(dt, Rb, hd, Af, Ab, acsf, rcs, dtf, dtbk, tid);
    for (int id = tid; id < 128 * 16; id += 256) {
      int l = id >> 4, ch = id & 15;
      const u16* s = xc + (Rb + l) * 1536 + 1024 + grp * 128 + ch * 8;
      *reinterpret_cast<uint4*>(R1b + l * 136 + ch * 8) = *reinterpret_cast<const uint4*>(s);
      *reinterpret_cast<uint4*>(R0b + l * 136 + ch * 8) = *reinterpret_cast<const uint4*>(s + 256);
    }
    __syncthreads();
    f32x4 cb[2][8];
#pragma unroll
    for (int m = 0; m < 2; ++m)
#pragma unroll
      for (int n = 0; n < 8; ++n) cb[m][n] = f32x4{0.f, 0.f, 0.f, 0.f};
    wave_mma<2, 8, 4>(cb, R0b + (wid * 32) * 136, 136, 16 * 136, R1b, 136, 16 * 136, lane);
    __syncthreads();
    for (int id = tid; id < 2 * 64 * 16; id += 256) {
      int d = id >> 10, pp = (id >> 4) & 63, ch = id & 15;
      *reinterpret_cast<uint4*>(R1b + (d * 64 + pp) * 136 + ch * 8) =
          *reinterpret_cast<const uint4*>(st + ((size_t)(T * 16 + hd) * 2 + d) * 8192 + pp * 128 + ch * 8);
    }
    __syncthreads();
    f32x4 y[2][4];
    {
      f32x4 yf[2][4], yb[2][4];
#pragma unroll
      for (int m = 0; m < 2; ++m)
#pragma unroll
        for (int n = 0; n < 4; ++n) { yf[m][n] = f32x4{0.f, 0.f, 0.f, 0.f}; yb[m][n] = f32x4{0.f, 0.f, 0.f, 0.f}; }
      {
        const u16* ap_ = R0b + (wid * 32 + fr) * 136 + fq * 8;
        const u16* bp_ = R1b + fr * 136 + fq * 8;
#pragma unroll
        for (int ks = 0; ks < 4; ++ks) {
          bf16x8 a_[2], f_[4], b_[4];
#pragma unroll
          for (int m = 0; m < 2; ++m) a_[m] = *reinterpret_cast<const bf16x8*>(ap_ + m * 16 * 136 + ks * 32);
#pragma unroll
          for (int n = 0; n < 4; ++n) {
            f_[n] = *reinterpret_cast<const bf16x8*>(bp_ + n * 16 * 136 + ks * 32);
            b_[n] = *reinterpret_cast<const bf16x8*>(bp_ + (64 + n * 16) * 136 + ks * 32);
          }
          __builtin_amdgcn_s_setprio(1);
#pragma unroll
          for (int m = 0; m < 2; ++m)
#pragma unroll
            for (int n = 0; n < 4; ++n) {
              yf[m][n] = __builtin_amdgcn_mfma_f32_16x16x32_bf16(a_[m], f_[n], yf[m][n], 0, 0, 0);
              yb[m][n] = __builtin_amdgcn_mfma_f32_16x16x32_bf16(a_[m], b_[n], yb[m][n], 0, 0, 0);
            }
          __builtin_amdgcn_s_setprio(0);
        }
      }
#pragma unroll
      for (int m = 0; m < 2; ++m)
#pragma unroll
        for (int j = 0; j < 4; ++j) {
          int l = wid * 32 + 16 * m + fq * 4 + j;
          float ef = __builtin_amdgcn_exp2f(acsf[l]), eb = __builtin_amdgcn_exp2f(rcs[l]);
#pragma unroll
          for (int n = 0; n < 4; ++n) y[m][n][j] = ef * yf[m][n][j] + eb * yb[m][n][j];
        }
    }
    __syncthreads();
    int frv = fr, lbase = wid * 32 + fq * 4;
    asm volatile("" : "+v"(frv), "+v"(lbase));
#pragma unroll
    for (int m = 0; m < 2; ++m) {
      float afl[4], rbl[4];
#pragma unroll
      for (int j = 0; j < 4; ++j) { afl[j] = acsf[lbase + 16 * m + j]; rbl[j] = rcs[lbase + 16 * m + j]; }
#pragma unroll
      for (int n = 0; n < 8; ++n) {
        const int s = 16 * n + frv;
        const int rel = 16 * n - (wid * 32 + 16 * m);
        if (rel < 0) {
          const float as_ = acsf[s], dfs = dtf[s];
#pragma unroll
          for (int j = 0; j < 4; ++j)
            R0b[(lbase + 16 * m + j) * 136 + s] = f2bf(cb[m][n][j] * (__builtin_amdgcn_exp2f(afl[j] - as_) * dfs));
        } else if (rel > 0) {
          const float rs_ = rcs[s], dbs = dtbk[s];
#pragma unroll
          for (int j = 0; j < 4; ++j)
            R0b[(lbase + 16 * m + j) * 136 + s] = f2bf(cb[m][n][j] * (__builtin_amdgcn_exp2f(rbl[j] - rs_) * dbs));
        } else {
          const float as_ = acsf[s], rs_ = rcs[s], dfs = dtf[s], dbs = dtbk[s];
#pragma unroll
          for (int j = 0; j < 4; ++j) {
            const int l = lbase + 16 * m + j;
            float gsum = 0.f;
            if (s <= l) gsum += __builtin_amdgcn_exp2f(afl[j] - as_) * dfs;
            if (s >= l) gsum += __builtin_amdgcn_exp2f(rbl[j] - rs_) * dbs;
            float val = cb[m][n][j] * gsum + ((s == l) ? Dh : 0.f);
            R0b[l * 136 + s] = f2bf(val);
          }
        }
      }
    }
    for (int id = tid; id < 128 * 8; id += 256) {
      int l = id & 127, ch = id >> 7;
      uint4 v = *reinterpret_cast<const uint4*>(xc + (Rb + l) * 1536 + hd * 64 + ch * 8);
      u16* d = R1b + (ch * 8) * 136 + l;
      d[0 * 136] = (u16)(v.x & 0xffff); d[1 * 136] = (u16)(v.x >> 16);
      d[2 * 136] = (u16)(v.y & 0xffff); d[3 * 136] = (u16)(v.y >> 16);
      d[4 * 136] = (u16)(v.z & 0xffff); d[5 * 136] = (u16)(v.z >> 16);
      d[6 * 136] = (u16)(v.w & 0xffff); d[7 * 136] = (u16)(v.w >> 16);
    }
    __syncthreads();
    wave_mma<2, 4, 4>(y, R0b + (wid * 32) * 136, 136, 16 * 136, R1b, 136, 16 * 136, lane);
#pragma unroll
    for (int m = 0; m < 2; ++m)
#pragma unroll
      for (int j = 0; j < 4; ++j) {
        size_t R = Rb + wid * 32 + 16 * m + fq * 4 + j;
        float sq = 0.f;
#pragma unroll
        for (int n = 0; n < 4; ++n) {
          int pc = hd * 64 + 16 * n + fr;
          float z = bf2f(u[R * DIN + pc]);
          float val = y[m][n][j] * silu_f(z);
          sq += val * val;
          ymix[R * DMIX + pc] = f2bf(val);
        }
        sq = red16_sum(sq);
        if (fr == 0) ssqa[R * 16 + hd] = sq;
      }
    __syncthreads();
  }
}

__device__ void phase_rope(const Params& p, int g) {
  int nseq, tps, seq0; ginfo(g, nseq, tps, seq0);
  const int nrows = nseq * tps * 128;
  u16* u = (u16*)(p.ws + OFF_U);
  for (int id = obid() * 256 + otid(); id < nrows * 10; id += gridDim.x * 256) {
    const int R = id / 10, hh = id - R * 10;
    const int T = R >> 7, r = R & 127, sl = T / tps, c = T - sl * tps;
    if (c == 0 && r >= 16) continue;
    const int pos = (c == 0) ? r : 16 + (c - 1) * 128 + r;
    u16* s = u + (size_t)R * DIN + (hh < 8 ? C_WQ + hh * 64 : C_WK + (hh - 8) * 64);
    uint4 v0 = *reinterpret_cast<const uint4*>(s), v1 = *reinterpret_cast<const uint4*>(s + 8);
    float x1[8], x2[8], o1[8], o2[8];
    unpack8(v0, x1); unpack8(v1, x2);
    const float posf = (float)pos;
#pragma unroll
    for (int i = 0; i < 8; ++i) {
      float ang = posf * c_inv[i];
      double rev = (double)ang * 0.15915494309189535;
      rev -= rint(rev);
      float rv = (float)rev;
      float sn = __builtin_amdgcn_sinf(rv), cs = __builtin_amdgcn_cosf(rv);
      o1[i] = x1[i] * cs - x2[i] * sn;
      o2[i] = x2[i] * cs + x1[i] * sn;
    }
    *reinterpret_cast<uint4*>(s) = pack8(o1);
    *reinterpret_cast<uint4*>(s + 8) = pack8(o2);
  }
}

DEVI void kv_prefetch(u32x4 (&pk)[2], u32x4 (&pv)[2], const u16* ksrc, const u16* vsrc, int tid) {
#pragma unroll
  for (int i = 0; i < 2; ++i) {
    int id = tid + i * 256;
    pk[i] = *reinterpret_cast<const u32x4*>(ksrc + (size_t)(id >> 3) * DIN + (id & 7) * 8);
    pv[i] = *reinterpret_cast<const u32x4*>(vsrc + (size_t)(id & 63) * DIN + (id >> 6) * 8);
  }
}
DEVI void kv_commit(const u32x4 (&pk)[2], const u32x4 (&pv)[2], u16* Ks, u16* Vt, int tid) {
#pragma unroll
  for (int i = 0; i < 2; ++i) {
    int id = tid + i * 256;
    *reinterpret_cast<u32x4*>(Ks + (id >> 3) * 72 + (id & 7) * 8) = pk[i];
    u16* d = Vt + ((id >> 6) * 8) * 72 + (id & 63);
    d[0 * 72] = (u16)(pv[i][0] & 0xffff); d[1 * 72] = (u16)(pv[i][0] >> 16);
    d[2 * 72] = (u16)(pv[i][1] & 0xffff); d[3 * 72] = (u16)(pv[i][1] >> 16);
    d[4 * 72] = (u16)(pv[i][2] & 0xffff); d[5 * 72] = (u16)(pv[i][2] >> 16);
    d[6 * 72] = (u16)(pv[i][3] & 0xffff); d[7 * 72] = (u16)(pv[i][3] >> 16);
  }
}
DEVI void stage_rope(u16* dst, const u16* src, int nrows, int pos0, int tid) {
  for (int id = tid; id < nrows * 7; id += 256) {
    int r = id / 7, cz = id - r * 7;
    const u16* s = src + (size_t)r * DIN;
    if (cz > 0) {
      *reinterpret_cast<uint4*>(dst + r * 72 + (cz + 1) * 8) = *reinterpret_cast<const uint4*>(s + (cz + 1) * 8);
    } else {
      uint4 v0 = *reinterpret_cast<const uint4*>(s), v1 = *reinterpret_cast<const uint4*>(s + 8);
      float x1[8], x2[8], o1[8], o2[8];
      unpack8(v0, x1); unpack8(v1, x2);
      float pos = (float)(pos0 + r);
#pragma unroll
      for (int i = 0; i < 8; ++i) {
        float ang = pos * c_inv[i];
        double rev = (double)ang * 0.15915494309189535;
        rev -= rint(rev);
        float rv = (float)rev;
        float sn = __builtin_amdgcn_sinf(rv), cs = __builtin_amdgcn_cosf(rv);
        o1[i] = x1[i] * cs - x2[i] * sn;
        o2[i] = x2[i] * cs + x1[i] * sn;
      }
      *reinterpret_cast<uint4*>(dst + r * 72) = pack8(o1);
      *reinterpret_cast<uint4*>(dst + r * 72 + 8) = pack8(o2);
    }
  }
}
DEVI void stage_plain(u16* dst, const u16* src, int nrows, int tid) {
  for (int id = tid; id < nrows * 8; id += 256) {
    int r = id >> 3, ch = id & 7;
    *reinterpret_cast<uint4*>(dst + r * 72 + ch * 8) = *reinterpret_cast<const uint4*>(src + (size_t)r * DIN + ch * 8);
  }
}
DEVI void stage_vt(u16* dst, const u16* src, int tid) {
  for (int id = tid; id < 64 * 8; id += 256) {
    int key = id & 63, ch = id >> 6;
    uint4 v = *reinterpret_cast<const uint4*>(src + (size_t)key * DIN + ch * 8);
    u16* d = dst + (ch * 8) * 72 + key;
    d[0 * 72] = (u16)(v.x & 0xffff); d[1 * 72] = (u16)(v.x >> 16);
    d[2 * 72] = (u16)(v.y & 0xffff); d[3 * 72] = (u16)(v.y >> 16);
    d[4 * 72] = (u16)(v.z & 0xffff); d[5 * 72] = (u16)(v.z >> 16);
    d[6 * 72] = (u16)(v.w & 0xffff); d[7 * 72] = (u16)(v.w >> 16);
  }
}

__device__ void phase_win(const Params& p, int g, int layer, char* smem) {
  int nseq, tps, seq0; ginfo(g, nseq, tps, seq0);
  const int ntiles = nseq * tps;
  u16* Qs = (u16*)smem;
  u16* Ks = Qs + 128 * 72;
  u16* Vt = Ks + 64 * 72;
  u16* Ps = Vt + 64 * 72;
  const int tid = otid(), lane = tid & 63, wid = tid >> 6, fr = lane & 15, fq = lane >> 4;
  const float C2 = 0.125f * 1.4426950408889634f;
  const u16* u = (const u16*)(p.ws + OFF_U);
  u16* ymix = (u16*)(p.ws + OFF_YMIX);
  for (int item = (obid() + gridDim.x - 64) % gridDim.x; item < ntiles * 8; item += gridDim.x) {
    const int T = item >> 3, qh = item & 7, kvh = qh >> 2;
    const int sl = T / tps, c = T - sl * tps, Ts0 = sl * tps;
    const int qpos0 = (c == 0) ? 0 : 16 + (c - 1) * 128;
    u32x4 pk[2], pv[2];
    kv_prefetch(pk, pv, u + (size_t)Ts0 * 128 * DIN + C_WK + kvh * 64, u + (size_t)Ts0 * 128 * DIN + C_WV + kvh * 64, tid);
    stage_plain(Qs, u + (size_t)T * 128 * DIN + C_WQ + qh * 64, 128, tid);
    float mrow[2][4], lrow[2][4];
    f32x4 o[2][4];
#pragma unroll
    for (int m = 0; m < 2; ++m) {
#pragma unroll
      for (int j = 0; j < 4; ++j) { mrow[m][j] = -1e30f; lrow[m][j] = 0.f; }
#pragma unroll
      for (int n = 0; n < 4; ++n) o[m][n] = f32x4{0.f, 0.f, 0.f, 0.f};
    }
    int kb = 0;
    while (kb < 7) {
      int kt = 0, half = 0;
      const bool meta = (kb == 0);
      if (!meta) { kt = c - 1 + ((kb - 1) >> 1); half = (kb - 1) & 1; }
      const int kpos0 = (kt == 0) ? 0 : 16 + (kt - 1) * 128 + half * 64;
      kv_commit(pk, pv, Ks, Vt, tid);
      __syncthreads();
      int nkb = kb + 1;
      while (nkb < 7) {
        int kt2 = c - 1 + ((nkb - 1) >> 1);
        if (kt2 >= 1 && kt2 < tps) break;
        ++nkb;
      }
      if (nkb < 7) {
        const int kt2 = c - 1 + ((nkb - 1) >> 1), half2 = (nkb - 1) & 1;
        const size_t krow2 = (size_t)(Ts0 + kt2) * 128 + half2 * 64;
        kv_prefetch(pk, pv, u + krow2 * DIN + C_WK + kvh * 64, u + krow2 * DIN + C_WV + kvh * 64, tid);
      }
      f32x4 s[2][4];
#pragma unroll
      for (int m = 0; m < 2; ++m)
#pragma unroll
        for (int n = 0; n < 4; ++n) s[m][n] = f32x4{0.f, 0.f, 0.f, 0.f};
      wave_mma<2, 4, 2>(s, Qs + (wid * 32) * 72, 72, 16 * 72, Ks, 72, 16 * 72, lane);
#pragma unroll
      for (int m = 0; m < 2; ++m)
#pragma unroll
        for (int j = 0; j < 4; ++j) {
          const int qrow = wid * 32 + 16 * m + fq * 4 + j;
          const int dbase = qpos0 + qrow - kpos0 - fr + 128;
          float mx = mrow[m][j];
#pragma unroll
          for (int n = 0; n < 4; ++n) {
            bool ok = meta ? (n == 0) : ((unsigned)(dbase - 16 * n) <= 256u);
            float v = ok ? s[m][n][j] : -1e30f;
            s[m][n][j] = v;
            mx = fmaxf(mx, v);
          }
          mx = red16_max(mx);
          const float mxc = mx * C2;
          float alpha = __builtin_amdgcn_exp2f(mrow[m][j] * C2 - mxc);
          float rsum = 0.f;
#pragma unroll
          for (int n = 0; n < 4; ++n) {
            float pv = __builtin_amdgcn_exp2f(s[m][n][j] * C2 - mxc);
            rsum += pv;
            Ps[(wid * 32 + 16 * m + fq * 4 + j) * 72 + 16 * n + fr] = f2bf(pv);
          }
          rsum = red16_sum(rsum);
          lrow[m][j] = lrow[m][j] * alpha + rsum;
          mrow[m][j] = mx;
#pragma unroll
          for (int n = 0; n < 4; ++n) o[m][n][j] *= alpha;
        }
      __syncthreads();
      wave_mma<2, 4, 2>(o, Ps + (wid * 32) * 72, 72, 16 * 72, Vt, 72, 16 * 72, lane);
      __syncthreads();
      kb = nkb;
    }
    const float sk = p.sink[layer * 8 + qh];
#pragma unroll
    for (int m = 0; m < 2; ++m)
#pragma unroll
      for (int j = 0; j < 4; ++j) {
        const float ms = mrow[m][j] * 0.125f;
        float mx = fmaxf(ms, sk);
        float a = __expf(ms - mx);
        float l = lrow[m][j] * a + __expf(sk - mx);
        float inv = a / l;
        size_t R = (size_t)T * 128 + wid * 32 + 16 * m + fq * 4 + j;
#pragma unroll
        for (int n = 0; n < 4; ++n) ymix[R * DMIX + 1024 + qh * 64 + 16 * n + fr] = f2bf(o[m][n][j] * inv);
      }
  }
}

__device__ void phase_na(const Params& p, int g, int layer, char* smem) {
  int nseq, tps, seq0; ginfo(g, nseq, tps, seq0);
  const int ntiles = nseq * tps;
  const int rows_total = (tps - 1) * 2;
  u16* Qs = (u16*)smem;
  u16* Ks = Qs + 128 * 72;
  u16* Vt = Ks + 64 * 72;
  u16* Ps = Vt + 64 * 72;
  float* rp = (float*)(Ps + 4 * 32 * 40);
  float* mb = rp + 480;
  const int tid = otid(), lane = tid & 63, wid = tid >> 6, fr = lane & 15, fq = lane >> 4;
  const float C2 = 0.125f * 1.4426950408889634f;
  const u16* u = (const u16*)(p.ws + OFF_U);
  u16* ymix = (u16*)(p.ws + OFF_YMIX);
  for (int item = (obid() + gridDim.x - 96) % gridDim.x; item < ntiles * 8; item += gridDim.x) {
    const int T = item >> 3, h = item & 7;
    const int sl = T / tps, c = T - sl * tps, Ts0 = sl * tps;
    u32x4 pk[2], pv[2];
    kv_prefetch(pk, pv, u + (size_t)Ts0 * 128 * DIN + C_NK + h * 64, u + (size_t)Ts0 * 128 * DIN + C_NV + h * 64, tid);
    stage_plain(Qs, u + (size_t)T * 128 * DIN + C_NQ + h * 64, 128, tid);
    for (int i = tid; i < 465; i += 256) rp[i] = 8.f * p.rpb[(size_t)(layer * 8 + h) * 465 + i];
    if (tid < 16) mb[tid] = 8.f * p.mbias[(layer * 8 + h) * 16 + tid];
    const int r0 = (c == 0) ? 0 : 2 * (c - 1);
    int qr[2], rsm[2];
#pragma unroll
    for (int m = 0; m < 2; ++m) {
      qr[m] = (c == 0) ? 0 : r0 + m;
      rsm[m] = min(max(qr[m] - 4, 0), rows_total - 8);
    }
    const int krlo = rsm[0], krhi = rsm[1] + 7;
    const int kc0w = min(max(16 * wid - 8, 0), 32);
    float mrow[2][4], lrow[2][4];
    f32x4 o[2][4];
#pragma unroll
    for (int m = 0; m < 2; ++m) {
#pragma unroll
      for (int j = 0; j < 4; ++j) { mrow[m][j] = -1e30f; lrow[m][j] = 0.f; }
#pragma unroll
      for (int n = 0; n < 4; ++n) o[m][n] = f32x4{0.f, 0.f, 0.f, 0.f};
    }
    for (int kb = -1; kb <= krhi - krlo; ++kb) {
      const bool meta = kb < 0;
      const int kr = krlo + kb;
      kv_commit(pk, pv, Ks, Vt, tid);
      __syncthreads();
      if (kb < krhi - krlo) {
        const int kr2 = kr + 1;
        const size_t krow2 = (size_t)(Ts0 + 1 + (kr2 >> 1)) * 128 + (kr2 & 1) * 64;
        kv_prefetch(pk, pv, u + krow2 * DIN + C_NK + h * 64, u + krow2 * DIN + C_NV + h * 64, tid);
      }
      const int kc0 = meta ? 0 : kc0w;
      f32x4 s[2][2];
#pragma unroll
      for (int m = 0; m < 2; ++m)
#pragma unroll
        for (int n = 0; n < 2; ++n) s[m][n] = f32x4{0.f, 0.f, 0.f, 0.f};
      wave_mma<2, 2, 2>(s, Qs + (16 * wid) * 72, 72, 64 * 72, Ks + kc0 * 72, 72, 16 * 72, lane);
#pragma unroll
      for (int m = 0; m < 2; ++m) {
        const bool rowok = (kr >= rsm[m]) && (kr <= rsm[m] + 7);
        const int rbase = (kr - qr[m] + 7) * 31 + 15;
#pragma unroll
        for (int j = 0; j < 4; ++j) {
          const int qc = (c == 0) ? 0 : 16 * wid + fq * 4 + j;
          const int qcs = min(max(qc - 8, 0), 48);
          const int kcb = kc0 + fr;
          float mx = mrow[m][j];
#pragma unroll
          for (int n = 0; n < 2; ++n) {
            const int kc = kcb + 16 * n;
            float v = -1e30f;
            if (meta) {
              if (n == 0) v = s[m][n][j] + mb[fr];
            } else if (rowok && (unsigned)(kc - qcs) < 16u) {
              v = s[m][n][j] + rp[rbase + kc - qc];
            }
            s[m][n][j] = v;
            mx = fmaxf(mx, v);
          }
          mx = red16_max(mx);
          const float mxc = mx * C2;
          float alpha = __builtin_amdgcn_exp2f(mrow[m][j] * C2 - mxc);
          float rsum = 0.f;
#pragma unroll
          for (int n = 0; n < 2; ++n) {
            float pv = __builtin_amdgcn_exp2f(s[m][n][j] * C2 - mxc);
            rsum += pv;
            Ps[(wid * 32 + 16 * m + fq * 4 + j) * 40 + 16 * n + fr] = f2bf(pv);
          }
          rsum = red16_sum(rsum);
          lrow[m][j] = lrow[m][j] * alpha + rsum;
          mrow[m][j] = mx;
#pragma unroll
          for (int n = 0; n < 4; ++n) o[m][n][j] *= alpha;
        }
      }
      __syncthreads();
      wave_mma<2, 4, 1>(o, Ps + (wid * 32) * 40, 40, 16 * 40, Vt + kc0, 72, 16 * 72, lane);
      __syncthreads();
    }
#pragma unroll
    for (int m = 0; m < 2; ++m)
#pragma unroll
      for (int j = 0; j < 4; ++j) {
        float inv = 1.f / lrow[m][j];
        size_t R = (size_t)T * 128 + m * 64 + 16 * wid + fq * 4 + j;
#pragma unroll
        for (int n = 0; n < 4; ++n) ymix[R * DMIX + 1536 + h * 64 + 16 * n + fr] = f2bf(o[m][n][j] * inv);
      }
  }
}

__device__ void phase_act(const Params& p, int g, int layer) {
  int nseq, tps, seq0; ginfo(g, nseq, tps, seq0);
  const int ntiles = nseq * tps;
  const int L = (tps - 1) * 128 + 16;
  const u16* gb = (const u16*)(p.ws + OFF_U);
  u16* act = (u16*)(p.ws + OFF_ST);
  const float* cw = p.fconv_w + (size_t)layer * 3 * DUP;
  const float* cb = p.fconv_b + (size_t)layer * DUP;
  const int total = ntiles * 8 * 352;
  for (int id = obid() * 256 + otid(); id < total; id += gridDim.x * 256) {
    const int ch = id % 352, ts = id / 352, seg = ts & 7, T = ts >> 3;
    const int sl = T / tps, c = T - sl * tps;
    const int col = ch * 8;
    const size_t Rseq = (size_t)sl * tps * 128;
    u16* orow = act + ((size_t)T * 128 + seg * 16) * DFF + col;
    const int nvalid = (c > 0) ? 16 : (seg == 0 ? 16 : 0);
    if (nvalid == 0) {
      uint4 z = make_uint4(0, 0, 0, 0);
#pragma unroll 4
      for (int r = 0; r < 16; ++r) *reinterpret_cast<uint4*>(orow + (size_t)r * DFF) = z;
      continue;
    }
    const int pos0 = (c == 0) ? 0 : 16 + (c - 1) * 128 + seg * 16;
    float wg[3][8], wu[3][8], bg[8], bu[8];
#pragma unroll
    for (int j = 0; j < 3; ++j) {
      float4 a0 = *reinterpret_cast<const float4*>(cw + j * DUP + col), a1 = *reinterpret_cast<const float4*>(cw + j * DUP + col + 4);
      float4 c0 = *reinterpret_cast<const float4*>(cw + j * DUP + DFF + col), c1 = *reinterpret_cast<const float4*>(cw + j * DUP + DFF + col + 4);
      wg[j][0] = a0.x; wg[j][1] = a0.y; wg[j][2] = a0.z; wg[j][3] = a0.w; wg[j][4] = a1.x; wg[j][5] = a1.y; wg[j][6] = a1.z; wg[j][7] = a1.w;
      wu[j][0] = c0.x; wu[j][1] = c0.y; wu[j][2] = c0.z; wu[j][3] = c0.w; wu[j][4] = c1.x; wu[j][5] = c1.y; wu[j][6] = c1.z; wu[j][7] = c1.w;
    }
    {
      float4 a0 = *reinterpret_cast<const float4*>(cb + col), a1 = *reinterpret_cast<const float4*>(cb + col + 4);
      float4 c0 = *reinterpret_cast<const float4*>(cb + DFF + col), c1 = *reinterpret_cast<const float4*>(cb + DFF + col + 4);
      bg[0] = a0.x; bg[1] = a0.y; bg[2] = a0.z; bg[3] = a0.w; bg[4] = a1.x; bg[5] = a1.y; bg[6] = a1.z; bg[7] = a1.w;
      bu[0] = c0.x; bu[1] = c0.y; bu[2] = c0.z; bu[3] = c0.w; bu[4] = c1.x; bu[5] = c1.y; bu[6] = c1.z; bu[7] = c1.w;
    }
    float xg[3][8], xu[3][8];
    auto ldrow = [&](int pp, float* dg, float* du) {
      if (pp >= 0 && pp < L) {
        int prow = (pp < 16) ? pp : 112 + pp;
        const u16* sp = gb + (Rseq + prow) * DUP + col;
        uint4 v0 = *reinterpret_cast<const uint4*>(sp), v1 = *reinterpret_cast<const uint4*>(sp + DFF);
        unpack8(v0, dg); unpack8(v1, du);
      } else {
#pragma unroll
        for (int i = 0; i < 8; ++i) { dg[i] = 0.f; du[i] = 0.f; }
      }
    };
    ldrow(pos0 - 1, xg[0], xu[0]); ldrow(pos0, xg[1], xu[1]);
#pragma unroll
    for (int r = 0; r < 16; ++r) {
      ldrow(pos0 + r + 1, xg[(r + 2) % 3], xu[(r + 2) % 3]);
      float res[8];
#pragma unroll
      for (int i = 0; i < 8; ++i) {
        float ga = bg[i], up = bu[i];
#pragma unroll
        for (int j = 0; j < 3; ++j) { ga += xg[(r + j) % 3][i] * wg[j][i]; up += xu[(r + j) % 3][i] * wu[j][i]; }
        float yv = 0.7978845608028654f * (ga + 0.044715f * ga * ga * ga);
        float th = 1.f - 2.f * __builtin_amdgcn_rcpf(__expf(2.f * yv) + 1.f);
        res[i] = 0.5f * ga * (1.f + th) * up;
      }
      *reinterpret_cast<uint4*>(orow + (size_t)r * DFF) = pack8(res);
    }
  }
}

#define XB_TMO      128
#define XB_XCNT(j)  (256  + 64 * (j))
#define XB_XSUB(j)  (1280 + 64 * (j))
#define XB_XGEN(j)  (2304 + 64 * (j))
#define XB_TOP      3328
#define XB_TOPGEN   3392
#define XCD_BAR_WORDS 3456
#define XB_SPIN_CAP (1u << 22)
#define LAS __attribute__((address_space(3)))
DEVI unsigned xb_ld(unsigned* p) { return __hip_atomic_load(p, __ATOMIC_RELAXED, __HIP_MEMORY_SCOPE_AGENT); }
DEVI unsigned xb_add(unsigned* p, unsigned v) { return __hip_atomic_fetch_add(p, v, __ATOMIC_RELAXED, __HIP_MEMORY_SCOPE_AGENT); }
DEVI unsigned xb_xcc_id() { return (unsigned)__builtin_amdgcn_s_getreg((3 << 11) | 20) & 0xFu; }
#define XB_SPIN(cond, bar) do { unsigned _sp = 0; while (cond) { __builtin_amdgcn_s_sleep(1); \
    if ((++_sp & 255u) == 0u) { if (xb_ld(&(bar)[XB_TMO])) break; if (_sp > XB_SPIN_CAP) { atomicAdd(&(bar)[XB_TMO], 1u); break; } } } } while (0)
struct XcdBarrier { unsigned* bar; unsigned x; volatile LAS unsigned* st; };
DEVI XcdBarrier xcd_barrier_post(unsigned* bar, volatile LAS unsigned* st) {
  XcdBarrier b; b.bar = bar; b.x = xb_xcc_id(); b.st = st;
  if (threadIdx.x == 0) (void)xb_add(&bar[XB_XCNT(b.x)], 1u);
  return b;
}
DEVI void xcd_barrier_complete(unsigned* bar, unsigned x, unsigned& nloc, unsigned& nx) {
  const unsigned G = gridDim.x * gridDim.y * gridDim.z;
  unsigned sum, cnt, mine, sp = 0u;
  for (;;) {
    sum = 0u; cnt = 0u; mine = 0u;
#pragma unroll
    for (unsigned j = 0; j < 16; ++j) { const unsigned c = xb_ld(&bar[XB_XCNT(j)]); sum += c; cnt += (c > 0u) ? 1u : 0u; mine = (j == x) ? c : mine; }
    if (sum == G) break;
    __builtin_amdgcn_s_sleep(1);
    if ((++sp & 255u) == 0u) { if (xb_ld(&bar[XB_TMO])) break; if (sp > XB_SPIN_CAP) { atomicAdd(&bar[XB_TMO], 1u); break; } }
  }
  nloc = mine > 0u ? mine : 1u; nx = cnt > 0u ? cnt : 1u;
}
DEVI void xcd_barrier(const XcdBarrier& b) {
  asm volatile("s_waitcnt vmcnt(0)" ::: "memory");
  __syncthreads();
  if (threadIdx.x == 0) {
    unsigned* bar = b.bar;
    __builtin_amdgcn_s_waitcnt(0);
    unsigned nloc = b.st[0], nx = b.st[1];
    if (nloc == 0u) { xcd_barrier_complete(bar, b.x, nloc, nx); b.st[0] = nloc; b.st[1] = nx; }
    const unsigned old = xb_add(&bar[XB_XSUB(b.x)], 1u);
    const unsigned gen = old / nloc;
    if (old + 1u == (gen + 1u) * nloc) {
      __builtin_amdgcn_fence(__ATOMIC_RELEASE, "agent");
      asm volatile("s_waitcnt vmcnt(0)" ::: "memory");
      const unsigned og = xb_add(&bar[XB_TOP], 1u);
      const unsigned tg = og / nx;
      if (og + 1u == (tg + 1u) * nx) xb_add(&bar[XB_TOPGEN], 1u);
      else XB_SPIN(xb_ld(&bar[XB_TOPGEN]) == tg, bar);
      __builtin_amdgcn_fence(__ATOMIC_ACQUIRE, "agent");
      xb_add(&bar[XB_XGEN(b.x)], 1u);
      asm volatile("s_waitcnt vmcnt(0)" ::: "memory");
    } else {
      XB_SPIN(xb_ld(&bar[XB_XGEN(b.x)]) == gen, bar);
      __builtin_amdgcn_fence(__ATOMIC_ACQUIRE, "agent");
      asm volatile("s_waitcnt vmcnt(0)" ::: "memory");
    }
  }
  __syncthreads();
}

#ifndef REP_GEMM
#define REP_GEMM 1
#endif
#ifndef REP_SSD
#define REP_SSD 1
#endif
#ifndef REP_WIN
#define REP_WIN 1
#endif
#ifndef REP_NA
#define REP_NA 1
#endif
#ifndef REP_EW
#define REP_EW 1
#endif
__global__ void __launch_bounds__(256, 2) mega(Params p) {
  extern __shared__ __attribute__((aligned(16))) char smem[];
  cg::grid_group grid = cg::this_grid();
  __shared__ uint4 xb_words;
  if (threadIdx.x == 0) xb_words = make_uint4(0u, 0u, 0u, 0u);
  __syncthreads();
  XcdBarrier xb = xcd_barrier_post((unsigned*)(p.ws + OFF_BAR), (volatile LAS unsigned*)&xb_words);
#pragma unroll 1
  for (int step = 0; step < 93; ++step) {
    int ph = 100, g = 0, layer = 0;
    if (step > 0) {
      int s = step - 1;
      g = s / 23;
      int r = s - g * 23;
      if (r == 0) ph = 101;
      else { layer = (r - 1) / 11; ph = (r - 1) - layer * 11; }
    }
    int nseq, tps, seq0; ginfo(g, nseq, tps, seq0);
    const int ntm = nseq * (tps - 1), tpr = tps - 1;
    if (step == 1) continue;
    if (ph == 100) {
      phase_prep(p, smem);
      phase_rowupd(p, 0, 0, (const u16*)(p.ws + OFF_U), nullptr);
    } else if (ph == 101 || ph == 6 || ph == 10) {
      const float* w = (ph == 6) ? p.n_mix_post + layer * DM : p.n_ffn_post + layer * DM;
      const int mode = (ph == 101) ? 0 : ((ph == 10 && layer == 1) ? 2 : 1);
      phase_rowupd(p, g, mode, (const u16*)(p.ws + OFF_U), w);
    } else if (ph == 0 || ph == 7) {
      const u16* Bt = (ph == 0) ? (const u16*)(p.ws + OFF_WIN) + (size_t)layer * DINP * DM
                                : (const u16*)(p.ws + OFF_WUP) + (size_t)layer * DUP * DM;
      const int nv = (ph == 0) ? DIN : DUP;
      for (int rep = 0; rep < REP_GEMM; ++rep) {
        phase_gemm_w<0>((const u16*)(p.ws + OFF_HB), DM, Bt, DM, ntm, 20, (ph == 0) ? DIN : 5120,
                        (const float*)(p.ws + OFF_RS), (u16*)(p.ws + OFF_U), nv, tpr, nullptr, smem);
        if (ph == 7)
          phase_gemm<0>((const u16*)(p.ws + OFF_HB), DM, Bt + (size_t)5120 * DM, DM, ntm, 4, 512,
                        (const float*)(p.ws + OFF_RS), (u16*)(p.ws + OFF_U) + 5120, nv, tpr, nullptr, smem);
        phase_gemm_meta<0>((const u16*)(p.ws + OFF_HB), DM, Bt, DM, nseq, tps, nv / 16, (const float*)(p.ws + OFF_RS),
                           (u16*)(p.ws + OFF_U), nv, nullptr);
      }
    } else if (ph == 5 || ph == 9) {
      const u16* A = (ph == 5) ? (const u16*)(p.ws + OFF_YMIX) : (const u16*)(p.ws + OFF_ST);
      const u16* Bt = (ph == 5) ? (const u16*)(p.ws + OFF_WOUT) + (size_t)layer * DM * DMIX
                                : (const u16*)(p.ws + OFF_WDN) + (size_t)layer * DM * DFF;
      const int K = (ph == 5) ? DMIX : DFF;
      const float* ssqk = (ph == 5) ? (const float*)(p.ws + OFF_SSQA) : nullptr;
      for (int rep = 0; rep < REP_GEMM; ++rep) {
        phase_gemm_w<1>(A, K, Bt, K, ntm, 4, DM, nullptr, (u16*)(p.ws + OFF_U), DM, tpr, ssqk, smem);
        phase_gemm_meta<1>(A, K, Bt, K, nseq, tps, DM / 16, nullptr, (u16*)(p.ws + OFF_U), DM, ssqk);
      }
    } else if (ph == 1) {
      for (int rep = 0; rep < REP_EW; ++rep) phase_conv(p, g, layer);
      phase_rope(p, g);
    } else if (ph == 2) {
      for (int rep = 0; rep < REP_SSD; ++rep) phase_ssdA(p, g, layer, smem);
    } else if (ph == 3) {
      phase_scan(p, g);
    } else if (ph == 4) {
      for (int rep = 0; rep < REP_SSD; ++rep) phase_ssdC(p, g, layer, smem);
      for (int rep = 0; rep < REP_WIN; ++rep) phase_win(p, g, layer, smem);
      for (int rep = 0; rep < REP_NA; ++rep) phase_na(p, g, layer, smem);
    } else if (ph == 8) {
      for (int rep = 0; rep < REP_EW; ++rep) phase_act(p, g, layer);
    }
    if (step == 0) grid.sync();
    else if (step < 92) xcd_barrier(xb);
  }
}

extern "C" void kernel_launch(void* const* d_in, const int* in_sizes, int n_in, void* d_out, int out_size,
                              void* d_ws, size_t ws_size, hipStream_t stream) {
  static int grid_blocks = 0;
  if (!grid_blocks) {
    int dev = 0, cus = 0, per_cu = 0;
    hipGetDevice(&dev);
    hipDeviceGetAttribute(&cus, hipDeviceAttributeMultiprocessorCount, dev);
    hipFuncSetAttribute((const void*)mega, hipFuncAttributeMaxDynamicSharedMemorySize, LDS_BYTES);
    hipOccupancyMaxActiveBlocksPerMultiprocessor(&per_cu, mega, 256, LDS_BYTES);
    if (per_cu > 2) per_cu = 2;
    if (per_cu < 1) per_cu = 1;
    grid_blocks = cus * per_cu;
  }
  Params p{};
  const float* const* in = (const float* const*)d_in;
  p.xp = in[0]; p.xs = in[1]; p.meta = in[2]; p.n_mix_pre = in[3]; p.n_mix_post = in[4]; p.w_in = in[5];
  p.conv_w = in[6]; p.conv_b = in[7]; p.dt_bias = in[8]; p.a_log = in[9]; p.ssd_d = in[10]; p.ssd_nw = in[11];
  p.sink = in[12]; p.rpb = in[13]; p.mbias = in[14]; p.w_out = in[15]; p.n_ffn_pre = in[16]; p.n_ffn_post = in[17];
  p.w_up = in[18]; p.fconv_w = in[19]; p.fconv_b = in[20]; p.w_down = in[21];
  p.out = (float*)d_out; p.ws = (char*)d_ws;
  if (ws_size < WS_NEED) fprintf(stderr, "workspace too small: %zu < %zu\n", ws_size, (size_t)WS_NEED);
  hipMemsetAsync((char*)d_ws + OFF_BAR, 0, XCD_BAR_WORDS * 4, stream);
  void* args[] = {&p};
  hipError_t e = hipLaunchCooperativeKernel((void*)mega, dim3(grid_blocks), dim3(256), args, LDS_BYTES, stream);
  if (e != hipSuccess) fprintf(stderr, "cooperative launch failed: %s (grid %d)\n", hipGetErrorString(e), grid_blocks);
}
```

```cpp
#include <hip/hip_runtime.h>
#include <hip/hip_cooperative_groups.h>
#include <cstdio>
namespace cg = cooperative_groups;

typedef unsigned short u16;
typedef __attribute__((ext_vector_type(8))) short bf16x8;
typedef __attribute__((ext_vector_type(4))) float f32x4;
typedef __attribute__((ext_vector_type(4))) unsigned int u32x4;
#define DEVI __device__ __forceinline__

constexpr int DM = 1024, DIN = 4896, DINP = 5120, DMIX = 2048, DFF = 2816, DUP = 5632;
constexpr int C_XBC = 1024, C_DT = 2560, C_WQ = 2592, C_WK = 3104, C_WV = 3232, C_NQ = 3360, C_NK = 3872, C_NV = 4384;
constexpr size_t RMAX = 16896;
constexpr int TMAX = 132;
constexpr float EPS = 1e-6f;
constexpr int LDS_BYTES = 77824;

constexpr size_t SZ_WIN = (size_t)2 * DINP * DM * 2;
constexpr size_t SZ_WOUT = (size_t)2 * DM * DMIX * 2;
constexpr size_t SZ_WUP = (size_t)2 * DUP * DM * 2;
constexpr size_t SZ_WDN = (size_t)2 * DM * DFF * 2;
constexpr size_t OFF_WIN = 0;
constexpr size_t OFF_WOUT = OFF_WIN + SZ_WIN;
constexpr size_t OFF_WUP = OFF_WOUT + SZ_WOUT;
constexpr size_t OFF_WDN = OFF_WUP + SZ_WUP;
constexpr size_t OFF_HMETA = OFF_WDN + SZ_WDN;
constexpr size_t OFF_HB = OFF_HMETA + (size_t)10 * 16 * DM * 4;
constexpr size_t OFF_U = OFF_HB + RMAX * DM * 2;
constexpr size_t OFF_XC = OFF_U + RMAX * DIN * 2;
constexpr size_t OFF_DT = OFF_XC + RMAX * 1536 * 2;
constexpr size_t OFF_ST = OFF_DT + RMAX * 32 * 4;
constexpr size_t OFF_YMIX = OFF_ST + (size_t)TMAX * 16 * 2 * 8192 * 2;
constexpr size_t OFF_SSQA = OFF_YMIX + RMAX * DMIX * 2;
constexpr size_t OFF_SSQB = OFF_SSQA + RMAX * 16 * 4;
constexpr size_t OFF_RS = OFF_SSQB + RMAX * 16 * 4;
constexpr size_t OFF_DEC = OFF_RS + RMAX * 4;
constexpr size_t WS_TOTAL = OFF_DEC + (size_t)TMAX * 16 * 2 * 4;
constexpr size_t OFF_BAR = (WS_TOTAL + 255) / 256 * 256;
constexpr size_t WS_NEED = OFF_BAR + 3456 * 4;
static_assert(RMAX * DUP * 2 <= RMAX * DIN * 2 + RMAX * 1536 * 2, "g alias");
static_assert(RMAX * DFF * 2 <= (size_t)TMAX * 16 * 2 * 8192 * 2 + RMAX * DMIX * 2, "act alias");
static_assert(WS_NEED < (size_t)512 * 1024 * 1024, "ws");

__constant__ float c_inv[8] = {1.0f, 0.1939227447486858f, 0.03760603093086394f, 0.007292664737217109f,
                               0.0014142135623730955f, 0.00027424817567620724f, 5.318295896944988e-05f,
                               1.0313385377212461e-05f};

struct Params {
  const float *xp, *xs, *meta, *n_mix_pre, *n_mix_post, *w_in, *conv_w, *conv_b, *dt_bias, *a_log, *ssd_d, *ssd_nw,
      *sink, *rpb, *mbias, *w_out, *n_ffn_pre, *n_ffn_post, *w_up, *fconv_w, *fconv_b, *w_down;
  float* out;
  char* ws;
};

typedef __attribute__((ext_vector_type(2))) __bf16 bf16x2_t;
typedef __attribute__((ext_vector_type(2))) float f32x2_t;
DEVI unsigned cvt_pk_bf16(float a, float b) {
  f32x2_t v = {a, b};
  return __builtin_bit_cast(unsigned, __builtin_convertvector(v, bf16x2_t));
}
DEVI u16 f2bf(float f) { return (u16)(cvt_pk_bf16(f, 0.f) & 0xffffu); }
DEVI float bf2f(u16 h) { return __uint_as_float(((unsigned)h) << 16); }
DEVI float silu_f(float x) { return x * __builtin_amdgcn_rcpf(1.f + __expf(-x)); }
DEVI void unpack8(uint4 v, float* f) {
  f[0] = __uint_as_float(v.x << 16); f[1] = __uint_as_float(v.x & 0xffff0000u);
  f[2] = __uint_as_float(v.y << 16); f[3] = __uint_as_float(v.y & 0xffff0000u);
  f[4] = __uint_as_float(v.z << 16); f[5] = __uint_as_float(v.z & 0xffff0000u);
  f[6] = __uint_as_float(v.w << 16); f[7] = __uint_as_float(v.w & 0xffff0000u);
}
DEVI unsigned pack2(float a, float b) { return cvt_pk_bf16(a, b); }
DEVI uint4 pack8(const float* f) {
  uint4 v; v.x = pack2(f[0], f[1]); v.y = pack2(f[2], f[3]); v.z = pack2(f[4], f[5]); v.w = pack2(f[6], f[7]);
  return v;
}
DEVI void ginfo(int g, int& nseq, int& tps, int& seq0) {
  if (g < 2) { nseq = 4; tps = 33; seq0 = 4 * g; } else { nseq = 1; tps = 129; seq0 = 8 + (g - 2); }
}
DEVI size_t seq_outrow(int seq) { return seq < 8 ? (size_t)seq * 4096 : (size_t)32768 + (size_t)(seq - 8) * 16384; }
template <int N>
DEVI float dpp_ror(float v) {
  return __builtin_bit_cast(float, __builtin_amdgcn_update_dpp(0, __builtin_bit_cast(int, v), 0x120 + N, 0xf, 0xf, false));
}
DEVI float red16_sum(float v) {
  v += dpp_ror<8>(v); v += dpp_ror<4>(v); v += dpp_ror<2>(v); v += dpp_ror<1>(v); return v;
}
DEVI float red16_max(float v) {
  v = fmaxf(v, dpp_ror<8>(v)); v = fmaxf(v, dpp_ror<4>(v)); v = fmaxf(v, dpp_ror<2>(v)); v = fmaxf(v, dpp_ror<1>(v));
  return v;
}
DEVI float red64_sum(float v) {
  v = red16_sum(v);
  v += __shfl_xor(v, 16); v += __shfl_xor(v, 32); return v;
}

DEVI int otid() { int t = threadIdx.x; asm volatile("" : "+v"(t)); return t; }
DEVI int obid() { return blockIdx.x; }

template <int MT, int NT, int KT>
DEVI void wave_mma(f32x4 (&acc)[MT][NT], const u16* A, int lda, int mstep, const u16* B, int ldb, int nstep, int lane) {
  const int fr = lane & 15, fq = lane >> 4;
  const u16* ap = A + fr * lda + fq * 8;
  const u16* bp = B + fr * ldb + fq * 8;
#pragma unroll
  for (int ks = 0; ks < KT; ++ks) {
    bf16x8 a[MT], b[NT];
#pragma unroll
    for (int m = 0; m < MT; ++m) a[m] = *reinterpret_cast<const bf16x8*>(ap + m * mstep + ks * 32);
#pragma unroll
    for (int n = 0; n < NT; ++n) b[n] = *reinterpret_cast<const bf16x8*>(bp + n * nstep + ks * 32);
    __builtin_amdgcn_s_setprio(1);
#pragma unroll
    for (int m = 0; m < MT; ++m)
#pragma unroll
      for (int n = 0; n < NT; ++n) acc[m][n] = __builtin_amdgcn_mfma_f32_16x16x32_bf16(a[m], b[n], acc[m][n], 0, 0, 0);
    __builtin_amdgcn_s_setprio(0);
  }
}

__device__ void prep_one(const float* src, u16* dst, int K, int N, int tk, int tn, const float* kscale, int klim,
                         char* smem) {
  float* tile = (float*)smem;
  const int tid = otid();
  const int k0 = tk * 64, n0 = tn * 64;
#pragma unroll 4
  for (int i = 0; i < 16; ++i) {
    int k = i * 4 + (tid >> 6), n = tid & 63;
    float v = 0.f;
    if (n0 + n < N) {
      v = src[(size_t)(k0 + k) * N + n0 + n];
      if (kscale && (k0 + k) < klim) v *= kscale[k0 + k];
    }
    tile[k * 65 + n] = v;
  }
  __syncthreads();
#pragma unroll 4
  for (int i = 0; i < 16; ++i) {
    int n = i * 4 + (tid >> 6), k = tid & 63;
    dst[(size_t)(n0 + n) * K + k0 + k] = f2bf(tile[k * 65 + n]);
  }
  __syncthreads();
}

__device__ void phase_prep(const Params& p, char* smem) {
  for (int it = obid(); it < 2 * 3904; it += gridDim.x) {
    int layer = it / 3904, r = it % 3904;
    if (r < 1280) {
      prep_one(p.w_in + (size_t)layer * DM * DIN, (u16*)(p.ws + OFF_WIN) + (size_t)layer * DINP * DM, DM, DIN, r / 80,
               r % 80, p.n_mix_pre + layer * DM, DM, smem);
    } else if (r < 1792) {
      r -= 1280;
      prep_one(p.w_out + (size_t)layer * DMIX * DM, (u16*)(p.ws + OFF_WOUT) + (size_t)layer * DM * DMIX, DMIX, DM,
               r / 16, r % 16, p.ssd_nw + layer * 1024, 1024, smem);
    } else if (r < 3200) {
      r -= 1792;
      prep_one(p.w_up + (size_t)layer * DM * DUP, (u16*)(p.ws + OFF_WUP) + (size_t)layer * DUP * DM, DM, DUP, r / 88,
               r % 88, p.n_ffn_pre + layer * DM, DM, smem);
    } else {
      r -= 3200;
      prep_one(p.w_down + (size_t)layer * DFF * DM, (u16*)(p.ws + OFF_WDN) + (size_t)layer * DM * DFF, DFF, DM, r / 16,
               r % 16, nullptr, 0, smem);
    }
  }
}

__device__ void phase_rowupd(const Params& p, int g, int mode, const u16* src, const float* w) {
  int nseq, tps, seq0; ginfo(g, nseq, tps, seq0);
  const int nrows = nseq * tps * 128;
  const int tid_ = otid(); const int lane = tid_ & 63, wid = tid_ >> 6;
  u16* hb = (u16*)(p.ws + OFF_HB);
  float* rs = (float*)(p.ws + OFF_RS);
  for (int Rp = obid() * 8 + wid * 2; Rp < nrows; Rp += gridDim.x * 8) {
    const int T = Rp >> 7, r = Rp & 127, sl = T / tps, c = T - sl * tps, seq = seq0 + sl;
    u16* hbrow = hb + (size_t)Rp * DM;
    const bool valid = (c > 0) || (r < 16);
    if (!valid) {
      if (mode == 0) {
        uint4 z = make_uint4(0, 0, 0, 0);
#pragma unroll
        for (int q = 0; q < 2; ++q) {
          *reinterpret_cast<uint4*>(hbrow + q * DM + lane * 16) = z;
          *reinterpret_cast<uint4*>(hbrow + q * DM + lane * 16 + 8) = z;
        }
        if (lane < 2) rs[Rp + lane] = 0.f;
      }
      continue;
    }
    if (mode == 2 && c == 0) continue;
    float4 v[2][4];
    if (mode == 0) {
      const float* xr;
      if (c == 0) xr = p.meta + (size_t)r * DM;
      else if (seq < 8) xr = p.xp + ((size_t)seq * 4096 + (size_t)(c - 1) * 128 + r) * DM;
      else xr = p.xs + ((size_t)(seq - 8) * 16384 + (size_t)(c - 1) * 128 + r) * DM;
#pragma unroll
      for (int q = 0; q < 2; ++q)
#pragma unroll
        for (int i = 0; i < 4; ++i) v[q][i] = *reinterpret_cast<const float4*>(xr + q * DM + lane * 4 + i * 256);
    } else {
      const u16* sr = src + (size_t)Rp * DM;
      uint2 sv[2][4], hv[2][4];
      float4 wv[4];
#pragma unroll
      for (int q = 0; q < 2; ++q)
#pragma unroll
        for (int i = 0; i < 4; ++i) {
          sv[q][i] = *reinterpret_cast<const uint2*>(sr + q * DM + lane * 4 + i * 256);
          hv[q][i] = *reinterpret_cast<const uint2*>(hbrow + q * DM + lane * 4 + i * 256);
        }
#pragma unroll
      for (int i = 0; i < 4; ++i) wv[i] = *reinterpret_cast<const float4*>(w + lane * 4 + i * 256);
#pragma unroll
      for (int q = 0; q < 2; ++q) {
        float tot = 0.f;
#pragma unroll
        for (int i = 0; i < 4; ++i) {
          float a0 = __uint_as_float(sv[q][i].x << 16), a1 = __uint_as_float(sv[q][i].x & 0xffff0000u);
          float a2 = __uint_as_float(sv[q][i].y << 16), a3 = __uint_as_float(sv[q][i].y & 0xffff0000u);
          tot += a0 * a0 + a1 * a1 + a2 * a2 + a3 * a3;
        }
        tot = red64_sum(tot);
        const float sc = rsqrtf(tot * (1.f / 1024.f) + EPS);
#pragma unroll
        for (int i = 0; i < 4; ++i) {
          float4 o;
          o.x = __uint_as_float(hv[q][i].x << 16) + __uint_as_float(sv[q][i].x << 16) * sc * wv[i].x;
          o.y = __uint_as_float(hv[q][i].x & 0xffff0000u) + __uint_as_float(sv[q][i].x & 0xffff0000u) * sc * wv[i].y;
          o.z = __uint_as_float(hv[q][i].y << 16) + __uint_as_float(sv[q][i].y << 16) * sc * wv[i].z;
          o.w = __uint_as_float(hv[q][i].y & 0xffff0000u) + __uint_as_float(sv[q][i].y & 0xffff0000u) * sc * wv[i].w;
          v[q][i] = o;
        }
      }
    }
    if (mode == 2) {
      float* op = p.out + (seq_outrow(seq) + (size_t)(c - 1) * 128 + r) * DM;
#pragma unroll
      for (int q = 0; q < 2; ++q)
#pragma unroll
        for (int i = 0; i < 4; ++i) *reinterpret_cast<float4*>(op + q * DM + lane * 4 + i * 256) = v[q][i];
      continue;
    }
#pragma unroll
    for (int q = 0; q < 2; ++q) {
      float ss = 0.f;
#pragma unroll
      for (int i = 0; i < 4; ++i) {
        ss += v[q][i].x * v[q][i].x + v[q][i].y * v[q][i].y + v[q][i].z * v[q][i].z + v[q][i].w * v[q][i].w;
        uint2 bb; bb.x = pack2(v[q][i].x, v[q][i].y); bb.y = pack2(v[q][i].z, v[q][i].w);
        *reinterpret_cast<uint2*>(hbrow + q * DM + lane * 4 + i * 256) = bb;
      }
      ss = red64_sum(ss);
      if (lane == 0) rs[Rp + q] = rsqrtf(ss * (1.f / 1024.f) + EPS);
    }
  }
}

struct GemmCursor { int it, kt; const u16* ap; const u16* bp; };
struct GemmMap { int bid, G, ntm, ntn, ntnp, swz, ni; };
DEVI int gemm_T(int tm, int tpr) { return tm + tm / tpr + 1; }
DEVI bool gemm_map(const GemmMap& M, int it, int& tm, int& tn) {
  if (M.swz == 2) {
    const int xcd = M.bid & 7, j = M.bid >> 3;
    const int P = it * 8 + xcd;
    const int ptm = P / M.ntnp, ptn = P - ptm * M.ntnp;
    tm = ptm * 8 + (j & 7);
    tn = ptn * 8 + (j >> 3);
    bool v = tn < M.ntn;
    if (!v) tn = M.ntn - 1;
    return v;
  }
  if (M.swz) {
    const int xcd = M.bid & 7, j = M.bid >> 3, half = j >> 5, q = j & 31;
    const int P = (it * 8 + xcd) * 2 + half;
    const int ptm = P / M.ntnp, ptn = P - ptm * M.ntnp;
    tm = ptm * 8 + (q & 7);
    tn = ptn * 4 + (q >> 3);
    bool v = tn < M.ntn;
    if (!v) tn = M.ntn - 1;
    return v;
  }
  int item = M.bid + it * M.G;
  bool v = item < M.ntm * M.ntn;
  if (!v) item = M.ntm * M.ntn - 1;
  tm = item / M.ntn; tn = item - tm * M.ntn;
  return v;
}
DEVI void gemm_gload(u32x4 (&RA)[4], u32x4 (&RB)[4], GemmCursor& L, const GemmMap& M, const u16* A, int lda, const u16* Bt,
                     int K, int nk, int lrow, int lkc, int tpr) {
#pragma unroll
  for (int i = 0; i < 4; ++i) {
    RA[i] = *reinterpret_cast<const u32x4*>(L.ap + (size_t)(32 * i) * lda);
    RB[i] = *reinterpret_cast<const u32x4*>(L.bp + (size_t)(32 * i) * K);
  }
  L.ap += 64; L.bp += 64;
  if (++L.kt == nk) {
    L.kt = 0;
    if (L.it + 1 < M.ni) L.it += 1;
    int tm_, tn_;
    gemm_map(M, L.it, tm_, tn_);
    L.ap = A + ((size_t)gemm_T(tm_, tpr) * 128 + lrow) * lda + lkc * 8;
    L.bp = Bt + ((size_t)tn_ * 128 + lrow) * K + lkc * 8;
  }
}
DEVI void gemm_sstore(const u32x4 (&RA)[4], const u32x4 (&RB)[4], char* As, char* Bs, const int (&soff)[4]) {
#pragma unroll
  for (int i = 0; i < 4; ++i) {
    *reinterpret_cast<u32x4*>(As + soff[i]) = RA[i];
    *reinterpret_cast<u32x4*>(Bs + soff[i]) = RB[i];
  }
}
DEVI void gemm_frags(bf16x8 (&a_)[2][4], bf16x8 (&b_)[2][4], const char* As, const char* Bs, const int (&aoff)[2],
                     const int (&boff)[2]) {
#pragma unroll
  for (int ks = 0; ks < 2; ++ks) {
#pragma unroll
    for (int m = 0; m < 4; ++m) a_[ks][m] = *reinterpret_cast<const bf16x8*>(As + aoff[ks] + m * 256);
#pragma unroll
    for (int n = 0; n < 4; ++n) b_[ks][n] = *reinterpret_cast<const bf16x8*>(Bs + boff[ks] + n * 256);
  }
}
template <int KS>
DEVI void gemm_mfma(f32x4 (&acc)[4][4], const bf16x8 (&a_)[2][4], const bf16x8 (&b_)[2][4]) {
  __builtin_amdgcn_s_setprio(1);
#pragma unroll
  for (int m = 0; m < 4; ++m)
#pragma unroll
    for (int n = 0; n < 4; ++n)
      acc[m][n] = __builtin_amdgcn_mfma_f32_16x16x32_bf16(a_[KS][m], b_[KS][n], acc[m][n], 0, 0, 0);
  __builtin_amdgcn_s_setprio(0);
}

template <int MODE>
__device__ void phase_gemm(const u16* __restrict__ A, int lda, const u16* __restrict__ Bt, int K, int ntm, int ntn,
                           int nvalid, const float* rowscale, u16* outb, int ldo, int tpr,
                           const float* ssqk, char* smem) {
  char* As = smem;
  char* Bs = smem + 32768;
  float* rsv = (float*)(smem + 65536);
  const int tid = otid(), lane = tid & 63, wid = tid >> 6, wr = wid >> 1, wc = wid & 1;
  const int fr = lane & 15, fq = lane >> 4;
  u16* Cw = (u16*)(smem + 66048) + wid * (16 * 72);
  const int lrow = tid >> 3, lkc = tid & 7;
  const int nk = K / 64;
  GemmMap M;
  M.bid = obid(); M.G = gridDim.x; M.ntm = ntm; M.ntn = ntn; M.ntnp = (ntn + 3) >> 2;
  M.swz = (M.G == 512 && ntm == 128) ? 1 : 0;
  if (M.swz && ((ntn + 7) >> 3) * 2 == M.ntnp) { M.swz = 2; M.ntnp = (ntn + 7) >> 3; }
  M.ni = (M.swz == 2) ? 2 * M.ntnp : (M.swz ? M.ntnp : (ntm * ntn + M.G - 1) / M.G);
  const int S = M.ni * nk;
  int soff[4];
#pragma unroll
  for (int i = 0; i < 4; ++i) soff[i] = lkc * 2048 + (((lrow + 32 * i) ^ lkc) * 16);
  int aoff[2], boff[2];
#pragma unroll
  for (int ks = 0; ks < 2; ++ks) {
    int kc = ks * 4 + fq;
    aoff[ks] = kc * 2048 + ((wr * 64 + (fr ^ kc)) * 16);
    boff[ks] = kc * 2048 + ((wc * 64 + (fr ^ kc)) * 16);
  }
  GemmCursor L;
  L.it = 0; L.kt = 0;
  {
    int tm, tn;
    gemm_map(M, 0, tm, tn);
    L.ap = A + ((size_t)gemm_T(tm, tpr) * 128 + lrow) * lda + lkc * 8;
    L.bp = Bt + ((size_t)tn * 128 + lrow) * K + lkc * 8;
  }
  u32x4 r0a[4], r0b[4], r1a[4], r1b[4];
  f32x4 acc[4][4];
#define GLOAD(RA, RB) gemm_gload(RA, RB, L, M, A, lda, Bt, K, nk, lrow, lkc, tpr)
#define SSTORE(RA, RB, BUF) gemm_sstore(RA, RB, As + (BUF) * 16384, Bs + (BUF) * 16384, soff)
#define FRAGS(BUF) gemm_frags(fa, fb, As + (BUF) * 16384, Bs + (BUF) * 16384, aoff, boff)
#define MFMAS(KS) gemm_mfma<KS>(acc, fa, fb)
  bf16x8 fa[2][4], fb[2][4];
  int cit = 0, ckt = 0;
  float rs_reg = 0.f;
  GLOAD(r0a, r0b);
  GLOAD(r1a, r1b);
  SSTORE(r0a, r0b, 0);
  __syncthreads();
  for (int s = 0; s < S; s += 2) {
    FRAGS(0);
    if (ckt == 0) {
#pragma unroll
      for (int m = 0; m < 4; ++m)
#pragma unroll
        for (int n = 0; n < 4; ++n) acc[m][n] = f32x4{0.f, 0.f, 0.f, 0.f};
      if (MODE == 0 && tid < 128) {
        int tmr_, tn_;
        gemm_map(M, cit, tmr_, tn_);
        rs_reg = rowscale[(size_t)gemm_T(tmr_, tpr) * 128 + tid];
      }
      if (MODE == 1 && ssqk != nullptr && tid < 128) {
        int tmr_, tn_;
        gemm_map(M, cit, tmr_, tn_);
        const int tm = gemm_T(tmr_, tpr);
        const float* q = ssqk + ((size_t)tm * 128 + tid) * 16;
        float t = 0.f;
#pragma unroll
        for (int i = 0; i < 16; ++i) t += q[i];
        rsv[tid] = rsqrtf(t * (1.f / 1024.f) + EPS);
      }
    }
    if (MODE == 0 && ckt == 2 && tid < 128) rsv[tid] = rs_reg;
    if (MODE == 1 && ssqk != nullptr && ckt == 16) {
#pragma unroll
      for (int m = 0; m < 4; ++m)
#pragma unroll
        for (int j = 0; j < 4; ++j) {
          float sc = rsv[wr * 64 + m * 16 + fq * 4 + j];
#pragma unroll
          for (int n = 0; n < 4; ++n) acc[m][n][j] *= sc;
        }
    }
    SSTORE(r1a, r1b, 1);
    MFMAS(0);
    MFMAS(1);
    GLOAD(r0a, r0b);
    __syncthreads();
    FRAGS(1);
    SSTORE(r0a, r0b, 0);
    MFMAS(0);
    MFMAS(1);
    GLOAD(r1a, r1b);
    ckt += 2;
    if (ckt == nk) {
      int tmr, tn;
      const bool valid = gemm_map(M, cit, tmr, tn);
      const int tm = gemm_T(tmr, tpr);
      if (!valid) {
      } else if (MODE == 0) {
#pragma unroll
        for (int m = 0; m < 4; ++m) {
#pragma unroll
          for (int j = 0; j < 4; ++j) {
            float sc = rsv[wr * 64 + m * 16 + fq * 4 + j];
#pragma unroll
            for (int n = 0; n < 4; ++n) Cw[(fq * 4 + j) * 72 + n * 16 + fr] = f2bf(acc[m][n][j] * sc);
          }
#pragma unroll
          for (int i = 0; i < 2; ++i) {
            int c = lane + 64 * i, row = c >> 3, ch = c & 7;
            int col = tn * 128 + wc * 64 + ch * 8;
            uint4 v = *reinterpret_cast<const uint4*>(Cw + row * 72 + ch * 8);
            if (col < nvalid)
              *reinterpret_cast<uint4*>(outb + ((size_t)tm * 128 + wr * 64 + m * 16 + row) * ldo + col) = v;
          }
        }
      } else {
#pragma unroll
        for (int m = 0; m < 4; ++m) {
#pragma unroll
          for (int j = 0; j < 4; ++j) {
#pragma unroll
            for (int n = 0; n < 4; ++n) Cw[(fq * 4 + j) * 72 + n * 16 + fr] = f2bf(acc[m][n][j]);
          }
#pragma unroll
          for (int i = 0; i < 2; ++i) {
            int c = lane + 64 * i, row = c >> 3, ch = c & 7;
            int col = tn * 128 + wc * 64 + ch * 8;
            uint4 v = *reinterpret_cast<const uint4*>(Cw + row * 72 + ch * 8);
            *reinterpret_cast<uint4*>(outb + ((size_t)tm * 128 + wr * 64 + m * 16 + row) * ldo + col) = v;
          }
        }
      }
      cit += 1; ckt = 0;
    }
    __syncthreads();
  }
#undef GLOAD
#undef SSTORE
#undef FRAGS
#undef MFMAS
}

template <int MODE>
__device__ void phase_gemm_w(const u16* __restrict__ A, int lda, const u16* __restrict__ Bt, int K, int ntm, int ntn,
                             int nvalid, const float* rowscale, u16* outb, int ldo, int tpr,
                             const float* ssqk, char* smem) {
  char* As = smem;
  char* Bs = smem + 16384;
  float* rsv = (float*)(smem + 49152);
  const int tid = otid(), lane = tid & 63, wid = tid >> 6, wr = wid >> 1, wc = wid & 1;
  const int fr = lane & 15, fq = lane >> 4;
  u16* Cw = (u16*)(smem + 49664) + wid * (16 * 136);
  const int lrow = tid >> 2, lkc = tid & 3;
  const int nk = K / 32;
  GemmMap M;
  M.bid = obid(); M.G = gridDim.x; M.ntm = ntm; M.ntn = ntn; M.ntnp = (ntn + 3) >> 2;
  M.swz = (M.G == 512 && ntm == 128) ? 1 : 0;
  M.ni = M.swz ? M.ntnp : (ntm * ntn + M.G - 1) / M.G;
  const int S = M.ni * nk;
  const int sa0 = lkc * 2048 + ((lrow ^ (lkc << 1)) * 16);
  const int sb0 = lkc * 4096 + ((lrow ^ (lkc << 1)) * 16);
  const int aoff = fq * 2048 + ((wr * 64 + (fr ^ (fq << 1))) * 16);
  const int boff = fq * 4096 + ((wc * 128 + (fr ^ (fq << 1))) * 16);
  int lit = 0, lkt = 0;
  const u16* ap; const u16* bp;
  {
    int tm, tn;
    gemm_map(M, 0, tm, tn);
    ap = A + ((size_t)gemm_T(tm, tpr) * 128 + lrow) * lda + lkc * 8;
    bp = Bt + ((size_t)tn * 256 + lrow) * K + lkc * 8;
  }
  u32x4 ra[2], rb[4];
  f32x4 acc[4][8];
  bf16x8 fa[4], fb[8];
  auto gload = [&]() __attribute__((always_inline)) {
#pragma unroll
    for (int i = 0; i < 2; ++i) ra[i] = *reinterpret_cast<const u32x4*>(ap + (size_t)(64 * i) * lda);
#pragma unroll
    for (int i = 0; i < 4; ++i) rb[i] = *reinterpret_cast<const u32x4*>(bp + (size_t)(64 * i) * K);
    ap += 32; bp += 32;
    if (++lkt == nk) {
      lkt = 0;
      if (lit + 1 < M.ni) lit += 1;
      int tm_, tn_;
      gemm_map(M, lit, tm_, tn_);
      ap = A + ((size_t)gemm_T(tm_, tpr) * 128 + lrow) * lda + lkc * 8;
      bp = Bt + ((size_t)tn_ * 256 + lrow) * K + lkc * 8;
    }
  };
  auto sstore = [&](int buf) __attribute__((always_inline)) {
#pragma unroll
    for (int i = 0; i < 2; ++i) *reinterpret_cast<u32x4*>(As + buf * 8192 + sa0 + i * 1024) = ra[i];
#pragma unroll
    for (int i = 0; i < 4; ++i) *reinterpret_cast<u32x4*>(Bs + buf * 16384 + sb0 + i * 1024) = rb[i];
  };
  auto frags = [&](int buf) __attribute__((always_inline)) {
#pragma unroll
    for (int m = 0; m < 4; ++m) fa[m] = *reinterpret_cast<const bf16x8*>(As + buf * 8192 + aoff + m * 256);
#pragma unroll
    for (int n = 0; n < 8; ++n) fb[n] = *reinterpret_cast<const bf16x8*>(Bs + buf * 16384 + boff + n * 256);
  };
  auto mfmas = [&]() __attribute__((always_inline)) {
    __builtin_amdgcn_s_setprio(1);
#pragma unroll
    for (int m = 0; m < 4; ++m)
#pragma unroll
      for (int n = 0; n < 8; ++n) acc[m][n] = __builtin_amdgcn_mfma_f32_16x16x32_bf16(fa[m], fb[n], acc[m][n], 0, 0, 0);
    __builtin_amdgcn_s_setprio(0);
  };
  int cit = 0, ckt = 0;
  float rs_reg = 0.f;
  gload();
  sstore(0);
  gload();
  __syncthreads();
  for (int s = 0; s < S; s += 2) {
    frags(0);
    if (ckt == 0) {
#pragma unroll
      for (int m = 0; m < 4; ++m)
#pragma unroll
        for (int n = 0; n < 8; ++n) acc[m][n] = f32x4{0.f, 0.f, 0.f, 0.f};
      if (tid < 128) {
        int tmr_, tn_;
        gemm_map(M, cit, tmr_, tn_);
        const size_t R = (size_t)gemm_T(tmr_, tpr) * 128 + tid;
        if (MODE == 0) rs_reg = rowscale[R];
        if (MODE == 1 && ssqk != nullptr) {
          const float* q = ssqk + R * 16;
          float t = 0.f;
#pragma unroll
          for (int i = 0; i < 16; ++i) t += q[i];
          rsv[tid] = rsqrtf(t * (1.f / 1024.f) + EPS);
        }
      }
    }
    if (MODE == 0 && ckt == 2 && tid < 128) rsv[tid] = rs_reg;
    if (MODE == 1 && ssqk != nullptr && ckt == 32) {
#pragma unroll
      for (int m = 0; m < 4; ++m)
#pragma unroll
        for (int j = 0; j < 4; ++j) {
          float sc = rsv[wr * 64 + m * 16 + fq * 4 + j];
#pragma unroll
          for (int n = 0; n < 8; ++n) acc[m][n][j] *= sc;
        }
    }
    sstore(1);
    mfmas();
    gload();
    __syncthreads();
    frags(1);
    sstore(0);
    mfmas();
    gload();
    ckt += 2;
    if (ckt == nk) {
      int tmr, tn;
      const bool valid = gemm_map(M, cit, tmr, tn);
      const int tm = gemm_T(tmr, tpr);
      if (valid) {
#pragma unroll
        for (int m = 0; m < 4; ++m) {
#pragma unroll
          for (int j = 0; j < 4; ++j) {
            float sc = 1.f;
            if (MODE == 0) sc = rsv[wr * 64 + m * 16 + fq * 4 + j];
#pragma unroll
            for (int n = 0; n < 8; ++n) Cw[(fq * 4 + j) * 136 + n * 16 + fr] = f2bf(acc[m][n][j] * sc);
          }
#pragma unroll
          for (int i = 0; i < 4; ++i) {
            int c = lane + 64 * i, row = c >> 4, ch = c & 15;
            int col = tn * 256 + wc * 128 + ch * 8;
            uint4 v = *reinterpret_cast<const uint4*>(Cw + row * 136 + ch * 8);
            if (col < nvalid)
              *reinterpret_cast<uint4*>(outb + ((size_t)tm * 128 + wr * 64 + m * 16 + row) * ldo + col) = v;
          }
        }
      }
      cit += 1; ckt = 0;
    }
    __syncthreads();
  }
}

template <int MODE, int BATCH>
DEVI void gemm_meta_items(const u16* __restrict__ A, int lda, const u16* __restrict__ Bt, int K, int tps, int nn16,
                          const float* rowscale, u16* outb, int ldo, const float* ssqk, int wid, int fr, int fq) {
  const int G = gridDim.x, bid = obid();
  const size_t R0 = (size_t)wid * tps * 128;
  const u16* ap = A + (R0 + fr) * lda + fq * 8;
  const int nks = K / 32;
  for (int it = G - 1 - bid; it < nn16; it += G) {
    const u16* bp = Bt + ((size_t)it * 16 + fr) * K + fq * 8;
    f32x4 acc = f32x4{0.f, 0.f, 0.f, 0.f};
    for (int ks0 = 0; ks0 < nks; ks0 += BATCH) {
      bf16x8 a[BATCH], b[BATCH];
#pragma unroll
      for (int i = 0; i < BATCH; ++i) {
        a[i] = *reinterpret_cast<const bf16x8*>(ap + (ks0 + i) * 32);
        b[i] = *reinterpret_cast<const bf16x8*>(bp + (ks0 + i) * 32);
      }
      if (MODE == 1 && ssqk != nullptr && ks0 == 32) {
#pragma unroll
        for (int j = 0; j < 4; ++j) {
          const float* q = ssqk + (R0 + fq * 4 + j) * 16;
          float t = 0.f;
#pragma unroll
          for (int i = 0; i < 16; ++i) t += q[i];
          acc[j] *= rsqrtf(t * (1.f / 1024.f) + EPS);
        }
      }
#pragma unroll
      for (int i = 0; i < BATCH; ++i) acc = __builtin_amdgcn_mfma_f32_16x16x32_bf16(a[i], b[i], acc, 0, 0, 0);
    }
#pragma unroll
    for (int j = 0; j < 4; ++j) {
      size_t R = R0 + fq * 4 + j;
      float v = acc[j];
      if (MODE == 0) v *= rowscale[R];
      outb[R * ldo + it * 16 + fr] = f2bf(v);
    }
  }
}
template <int MODE>
__device__ void phase_gemm_meta(const u16* __restrict__ A, int lda, const u16* __restrict__ Bt, int K, int nseq, int tps,
                                int nn16, const float* rowscale, u16* outb, int ldo, const float* ssqk) {
  const int tid = otid(), lane = tid & 63, wid = tid >> 6, fr = lane & 15, fq = lane >> 4;
  if (wid >= nseq) return;
  if (((K / 32) & 15) == 0) gemm_meta_items<MODE, 16>(A, lda, Bt, K, tps, nn16, rowscale, outb, ldo, ssqk, wid, fr, fq);
  else gemm_meta_items<MODE, 11>(A, lda, Bt, K, tps, nn16, rowscale, outb, ldo, ssqk, wid, fr, fq);
}

__device__ void phase_conv(const Params& p, int g, int layer) {
  int nseq, tps, seq0; ginfo(g, nseq, tps, seq0);
  const int ntiles = nseq * tps;
  const int L = (tps - 1) * 128 + 16;
  const u16* u = (const u16*)(p.ws + OFF_U);
  u16* xc = (u16*)(p.ws + OFF_XC);
  float* dtb = (float*)(p.ws + OFF_DT);
  const float* cw = p.conv_w + (size_t)layer * 5 * 1536;
  const float* cb = p.conv_b + (size_t)layer * 1536;
  const int total = ntiles * 8 * 192;
  for (int id = obid() * 256 + otid(); id < total; id += gridDim.x * 256) {
    const int ch = id % 192, ts = id / 192, seg = ts & 7, T = ts >> 3;
    const int sl = T / tps, c = T - sl * tps;
    const int col = ch * 8;
    const size_t Rseq = (size_t)sl * tps * 128;
    u16* orow = xc + ((size_t)T * 128 + seg * 16) * 1536 + col;
    const int nvalid = (c > 0) ? 16 : (seg == 0 ? 16 : 0);
    if (nvalid == 0) {
      uint4 z = make_uint4(0, 0, 0, 0);
#pragma unroll 4
      for (int r = 0; r < 16; ++r) *reinterpret_cast<uint4*>(orow + (size_t)r * 1536) = z;
      continue;
    }
    const int pos0 = (c == 0) ? 0 : 16 + (c - 1) * 128 + seg * 16;
    float w[5][8], bias[8];
#pragma unroll
    for (int j = 0; j < 5; ++j) {
      float4 w0 = *reinterpret_cast<const float4*>(cw + j * 1536 + col), w1 = *reinterpret_cast<const float4*>(cw + j * 1536 + col + 4);
      w[j][0] = w0.x; w[j][1] = w0.y; w[j][2] = w0.z; w[j][3] = w0.w; w[j][4] = w1.x; w[j][5] = w1.y; w[j][6] = w1.z; w[j][7] = w1.w;
    }
    {
      float4 b0 = *reinterpret_cast<const float4*>(cb + col), b1 = *reinterpret_cast<const float4*>(cb + col + 4);
      bias[0] = b0.x; bias[1] = b0.y; bias[2] = b0.z; bias[3] = b0.w; bias[4] = b1.x; bias[5] = b1.y; bias[6] = b1.z; bias[7] = b1.w;
    }
    float win[5][8];
    auto ldrow = [&](int pp, float* dst) {
      const bool ok = (pp >= 0) && (pp < L);
      const int pc = min(max(pp, 0), L - 1);
      const int prow = (pc < 16) ? pc : 112 + pc;
      uint4 v = *reinterpret_cast<const uint4*>(u + (Rseq + prow) * DIN + C_XBC + col);
      if (!ok) v = make_uint4(0, 0, 0, 0);
      unpack8(v, dst);
    };
    ldrow(pos0 - 2, win[0]); ldrow(pos0 - 1, win[1]); ldrow(pos0, win[2]); ldrow(pos0 + 1, win[3]);
#pragma unroll
    for (int r = 0; r < 16; ++r) {
      ldrow(pos0 + r + 2, win[(r + 4) % 5]);
      float acc[8];
#pragma unroll
      for (int i = 0; i < 8; ++i) {
        float a = bias[i];
#pragma unroll
        for (int j = 0; j < 5; ++j) a += win[(r + j) % 5][i] * w[j][i];
        acc[i] = silu_f(a);
      }
      *reinterpret_cast<uint4*>(orow + (size_t)r * 1536) = pack8(acc);
    }
  }
  const int nrows = ntiles * 128;
  for (int id = obid() * 256 + otid(); id < nrows * 4; id += gridDim.x * 256) {
    const int R = id >> 2, h0 = (id & 3) * 8;
    const int T = R >> 7, r = R & 127, sl = T / tps, c = T - sl * tps;
    const bool valid = (c > 0) || (r < 16);
    float o[8];
    uint4 v = *reinterpret_cast<const uint4*>(u + (size_t)R * DIN + C_DT + h0);
    float f[8]; unpack8(v, f);
#pragma unroll
    for (int i = 0; i < 8; ++i) {
      float x = f[i] + p.dt_bias[layer * 32 + h0 + i];
      float sp = (x > 20.f) ? x : log1pf(__expf(x));
      o[i] = valid ? sp : 0.f;
    }
    *reinterpret_cast<float4*>(dtb + (size_t)R * 32 + h0) = make_float4(o[0], o[1], o[2], o[3]);
    *reinterpret_cast<float4*>(dtb + (size_t)R * 32 + h0 + 4) = make_float4(o[4], o[5], o[6], o[7]);
  }
}

DEVI void ssd_cumsums(const float* dt, size_t R0, int hd, float Af, float Ab, float* acsf, float* rcs, float* dtf,
                      float* dtbk, int tid_) {
  const int lane = tid_ & 63, wid = tid_ >> 6;
  if (wid < 2) {
    const int dir = wid;
    float d0 = dt[(R0 + 2 * lane) * 32 + dir * 16 + hd], d1 = dt[(R0 + 2 * lane + 1) * 32 + dir * 16 + hd];
    float A_ = dir ? Ab : Af;
    float a0 = d0 * A_, a1 = d1 * A_;
    float s = a0 + a1, inc = s;
#pragma unroll
    for (int o = 1; o < 64; o <<= 1) {
      float t = __shfl_up(inc, o);
      if (lane >= o) inc += t;
    }
    float excl = inc - s;
    if (dir == 0) {
      acsf[2 * lane] = excl + a0; acsf[2 * lane + 1] = inc;
      dtf[2 * lane] = d0; dtf[2 * lane + 1] = d1;
    } else {
      float tot = __shfl(inc, 63);
      rcs[2 * lane] = tot - excl; rcs[2 * lane + 1] = tot - (excl + a0);
      dtbk[2 * lane] = d0; dtbk[2 * lane + 1] = d1;
    }
  }
}

__device__ void phase_ssdA(const Params& p, int g, int layer, char* smem) {
  int nseq, tps, seq0; ginfo(g, nseq, tps, seq0);
  const int ntiles = nseq * tps;
  u16* Bt = (u16*)smem;
  u16* Xt = Bt + 128 * 136;
  float* arr = (float*)(Xt + 64 * 136);
  float *acsf = arr, *rcs = arr + 128, *dtf = arr + 256, *dtbk = arr + 384;
  const int tid = otid(), lane = tid & 63, wid = tid >> 6, fr = lane & 15, fq = lane >> 4;
  const u16* xc = (const u16*)(p.ws + OFF_XC);
  const float* dt = (const float*)(p.ws + OFF_DT);
  u16* st = (u16*)(p.ws + OFF_ST);
  float* dec = (float*)(p.ws + OFF_DEC);
  for (int item = obid(); item < ntiles * 16; item += gridDim.x) {
    const int T = item >> 4, hd = item & 15, grp = hd >> 3;
    const size_t R0 = (size_t)T * 128;
    const float Af = -1.4426950408889634f * __expf(p.a_log[layer * 32 + hd]), Ab = -1.4426950408889634f * __expf(p.a_log[layer * 32 + 16 + hd]);
    ssd_cumsums(dt, R0, hd, Af, Ab, acsf, rcs, dtf, dtbk, tid);
    for (int id = tid; id < 128 * 16; id += 256) {
      int l = id & 127, ch = id >> 7;
      uint4 v = *reinterpret_cast<const uint4*>(xc + (R0 + l) * 1536 + 1024 + grp * 128 + ch * 8);
      u16* d = Bt + (ch * 8) * 136 + l;
      d[0 * 136] = (u16)(v.x & 0xffff); d[1 * 136] = (u16)(v.x >> 16);
      d[2 * 136] = (u16)(v.y & 0xffff); d[3 * 136] = (u16)(v.y >> 16);
      d[4 * 136] = (u16)(v.z & 0xffff); d[5 * 136] = (u16)(v.z >> 16);
      d[6 * 136] = (u16)(v.w & 0xffff); d[7 * 136] = (u16)(v.w >> 16);
    }
    __syncthreads();
#pragma unroll 1
    for (int dir = 0; dir < 2; ++dir) {
      const float ref = dir ? rcs[0] : acsf[127];
      for (int id = tid; id < 128 * 8; id += 256) {
        int l = id & 127, ch = id >> 7;
        uint4 v = *reinterpret_cast<const uint4*>(xc + (R0 + l) * 1536 + hd * 64 + ch * 8);
        float f[8]; unpack8(v, f);
        float w = dir ? dtbk[l] * __builtin_amdgcn_exp2f(ref - rcs[l]) : dtf[l] * __builtin_amdgcn_exp2f(ref - acsf[l]);
        u16* d = Xt + (ch * 8) * 136 + l;
#pragma unroll
        for (int i = 0; i < 8; ++i) d[i * 136] = f2bf(f[i] * w);
      }
      __syncthreads();
      f32x4 acc[4][2];
#pragma unroll
      for (int m = 0; m < 4; ++m)
#pragma unroll
        for (int n = 0; n < 2; ++n) acc[m][n] = f32x4{0.f, 0.f, 0.f, 0.f};
      wave_mma<4, 2, 4>(acc, Xt, 136, 16 * 136, Bt + (wid * 32) * 136, 136, 16 * 136, lane);
      u16* so = st + ((size_t)(T * 16 + hd) * 2 + dir) * 8192;
#pragma unroll
      for (int m = 0; m < 4; ++m)
#pragma unroll
        for (int n = 0; n < 2; ++n)
#pragma unroll
          for (int j = 0; j < 4; ++j) so[(16 * m + fq * 4 + j) * 128 + wid * 32 + 16 * n + fr] = f2bf(acc[m][n][j]);
      __syncthreads();
    }
    if (tid == 0) {
      dec[(size_t)(T * 16 + hd) * 2] = __builtin_amdgcn_exp2f(acsf[127]);
      dec[(size_t)(T * 16 + hd) * 2 + 1] = __builtin_amdgcn_exp2f(rcs[0]);
    }
    __syncthreads();
  }
}

__device__ void phase_scan(const Params& p, int g) {
  int nseq, tps, seq0; ginfo(g, nseq, tps, seq0);
  u16* st = (u16*)(p.ws + OFF_ST);
  const float* dec = (const float*)(p.ws + OFF_DEC);
  const int total = nseq * 32 * 4096;
  for (int i = obid() * 256 + otid(); i < total; i += gridDim.x * 256) {
    const int e2 = i & 4095, chn = i >> 12, dir = chn & 1, hd = (chn >> 1) & 15, sl = chn >> 5;
    float r0 = 0.f, r1 = 0.f;
    for (int cc = 0; cc < tps; cc += 16) {
      unsigned v[16]; float dc[16];
#pragma unroll
      for (int q = 0; q < 16; ++q) {
        int c = cc + q;
        v[q] = 0; dc[q] = 0.f;
        if (c < tps) {
          int ct = dir ? (tps - 1 - c) : c;
          size_t idx = ((size_t)(sl * tps + ct) * 16 + hd) * 2 + dir;
          v[q] = *reinterpret_cast<const unsigned*>(st + idx * 8192 + e2 * 2);
          dc[q] = dec[idx];
        }
      }
#pragma unroll
      for (int q = 0; q < 16; ++q) {
        int c = cc + q;
        if (c < tps) {
          int ct = dir ? (tps - 1 - c) : c;
          size_t idx = ((size_t)(sl * tps + ct) * 16 + hd) * 2 + dir;
          float s0 = __uint_as_float(v[q] << 16), s1 = __uint_as_float(v[q] & 0xffff0000u);
          *reinterpret_cast<unsigned*>(st + idx * 8192 + e2 * 2) = pack2(r0, r1);
          r0 = dc[q] * r0 + s0; r1 = dc[q] * r1 + s1;
        }
      }
    }
  }
}

__device__ void phase_ssdC(const Params& p, int g, int layer, char* smem) {
  int nseq, tps, seq0; ginfo(g, nseq, tps, seq0);
  const int ntiles = nseq * tps;
  u16* R0b = (u16*)smem;
  u16* R1b = R0b + 128 * 136;
  float* arr = (float*)(R1b + 128 * 136);
  float *acsf = arr, *rcs = arr + 128, *dtf = arr + 256, *dtbk = arr + 384;
  const int tid = otid(), lane = tid & 63, wid = tid >> 6, fr = lane & 15, fq = lane >> 4;
  const u16* xc = (const u16*)(p.ws + OFF_XC);
  const u16* u = (const u16*)(p.ws + OFF_U);
  const float* dt = (const float*)(p.ws + OFF_DT);
  const u16* st = (const u16*)(p.ws + OFF_ST);
  u16* ymix = (u16*)(p.ws + OFF_YMIX);
  float* ssqa = (float*)(p.ws + OFF_SSQA);
  for (int item = obid(); item < ntiles * 16; item += gridDim.x) {
    const int T = item >> 4, hd = item & 15, grp = hd >> 3;
    const size_t Rb = (size_t)T * 128;
    const float Af = -1.4426950408889634f * __expf(p.a_log[layer * 32 + hd]), Ab = -1.4426950408889634f * __expf(p.a_log[layer * 32 + 16 + hd]);
    const float Dh = p.ssd_d[layer * 16 + hd];
    ssd_cumsums(dt, Rb, hd, Af, Ab, acsf, rcs, dtf, dtbk, tid);
    for (int id = tid; id < 128 * 16; id += 256) {
      int l = id >> 4, ch = id & 15;
      const u16* s = xc + (Rb + l) * 1536 + 1024 + grp * 128 + ch * 8;
      *reinterpret_cast<uint4*>(R1b + l * 136 + ch * 8) = *reinterpret_cast<const uint4*>(s);
      *reinterpret_cast<uint4*>(R0b + l * 136 + ch * 8) = *reinterpret_cast<const uint4*>(s + 256);
    }
    __syncthreads();
    f32x4 cb[2][8];
#pragma unroll
    for (int m = 0; m < 2; ++m)
#pragma unroll
      for (int n = 0; n < 8; ++n) cb[m][n] = f32x4{0.f, 0.f, 0.f, 0.f};
    wave_mma<2, 8, 4>(cb, R0b + (wid * 32) * 136, 136, 16 * 136, R1b, 136, 16 * 136, lane);
    __syncthreads();
    for (int id = tid; id < 2 * 64 * 16; id += 256) {
      int d = id >> 10, pp = (id >> 4) & 63, ch = id & 15;
      *reinterpret_cast<uint4*>(R1b + (d * 64 + pp) * 136 + ch * 8) =
          *reinterpret_cast<const uint4*>(st + ((size_t)(T * 16 + hd) * 2 + d) * 8192 + pp * 128 + ch * 8);
    }
    __syncthreads();
    f32x4 y[2][4];
    {
      f32x4 yf[2][4], yb[2][4];
#pragma unroll
      for (int m = 0; m < 2; ++m)
#pragma unroll
        for (int n = 0; n < 4; ++n) { yf[m][n] = f32x4{0.f, 0.f, 0.f, 0.f}; yb[m][n] = f32x4{0.f, 0.f, 0.f, 0.f}; }
      {
        const u16* ap_ = R0b + (wid * 32 + fr) * 136 + fq * 8;
        const u16* bp_ = R1b + fr * 136 + fq * 8;
#pragma unroll
        for (int ks = 0; ks < 4; ++ks) {
          bf16x8 a_[2], f_[4], b_[4];
#pragma unroll
          for (int m = 0; m < 2; ++m) a_[m] = *reinterpret_cast<const bf16x8*>(ap_ + m * 16 * 136 + ks * 32);
#pragma unroll
          for (int n = 0; n < 4; ++n) {
            f_[n] = *reinterpret_cast<const bf16x8*>(bp_ + n * 16 * 136 + ks * 32);
            b_[n] = *reinterpret_cast<const bf16x8*>(bp_ + (64 + n * 16) * 136 + ks * 32);
          }
          __builtin_amdgcn_s_setprio(1);
#pragma unroll
          for (int m = 0; m < 2; ++m)
#pragma unroll
            for (int n = 0; n < 4; ++n) {
              yf[m][n] = __builtin_amdgcn_mfma_f32_16x16x32_bf16(a_[m], f_[n], yf[m][n], 0, 0, 0);
              yb[m][n] = __builtin_amdgcn_mfma_f32_16x16x32_bf16(a_[m], b_[n], yb[m][n], 0, 0, 0);
            }
          __builtin_amdgcn_s_setprio(0);
        }
      }
#pragma unroll
      for (int m = 0; m < 2; ++m)
#pragma unroll
        for (int j = 0; j < 4; ++j) {
          int l = wid * 32 + 16 * m + fq * 4 + j;
          float ef = __builtin_amdgcn_exp2f(acsf[l]), eb = __builtin_amdgcn_exp2f(rcs[l]);
#pragma unroll
          for (int n = 0; n < 4; ++n) y[m][n][j] = ef * yf[m][n][j] + eb * yb[m][n][j];
        }
    }
    __syncthreads();
    int frv = fr, lbase = wid * 32 + fq * 4;
    asm volatile("" : "+v"(frv), "+v"(lbase));
#pragma unroll
    for (int m = 0; m < 2; ++m) {
      float afl[4], rbl[4];
#pragma unroll
      for (int j = 0; j < 4; ++j) { afl[j] = acsf[lbase + 16 * m + j]; rbl[j] = rcs[lbase + 16 * m + j]; }
#pragma unroll
      for (int n = 0; n < 8; ++n) {
        const int s = 16 * n + frv;
        const int rel = 16 * n - (wid * 32 + 16 * m);
        if (rel < 0) {
          const float as_ = acsf[s], dfs = dtf[s];
#pragma unroll
          for (int j = 0; j < 4; ++j)
            R0b[(lbase + 16 * m + j) * 136 + s] = f2bf(cb[m][n][j] * (__builtin_amdgcn_exp2f(afl[j] - as_) * dfs));
        } else if (rel > 0) {
          const float rs_ = rcs[s], dbs = dtbk[s];
#pragma unroll
          for (int j = 0; j < 4; ++j)
            R0b[(lbase + 16 * m + j) * 136 + s] = f2bf(cb[m][n][j] * (__builtin_amdgcn_exp2f(rbl[j] - rs_) * dbs));
        } else {
          const float as_ = acsf[s], rs_ = rcs[s], dfs = dtf[s], dbs = dtbk[s];
#pragma unroll
          for (int j = 0; j < 4; ++j) {
            const int l = lbase + 16 * m + j;
            float gsum = 0.f;
            if (s <= l) gsum += __builtin_amdgcn_exp2f(afl[j] - as_) * dfs;
            if (s >= l) gsum += __builtin_amdgcn_exp2f(rbl[j] - rs_) * dbs;
            float val = cb[m][n][j] * gsum + ((s == l) ? Dh : 0.f);
            R0b[l * 136 + s] = f2bf(val);
          }
        }
      }
    }
    for (int id = tid; id < 128 * 8; id += 256) {
      int l = id & 127, ch = id >> 7;
      uint4 v = *reinterpret_cast<const uint4*>(xc + (Rb + l) * 1536 + hd * 64 + ch * 8);
      u16* d = R1b + (ch * 8) * 136 + l;
      d[0 * 136] = (u16)(v.x & 0xffff); d[1 * 136] = (u16)(v.x >> 16);
      d[2 * 136] = (u16)(v.y & 0xffff); d[3 * 136] = (u16)(v.y >> 16);
      d[4 * 136] = (u16)(v.z & 0xffff); d[5 * 136] = (u16)(v.z >> 16);
      d[6 * 136] = (u16)(v.w & 0xffff); d[7 * 136] = (u16)(v.w >> 16);
    }
    __syncthreads();
    wave_mma<2, 4, 4>(y, R0b + (wid * 32) * 136, 136, 16 * 136, R1b, 136, 16 * 136, lane);
#pragma unroll
    for (int m = 0; m < 2; ++m)
#pragma unroll
      for (int j = 0; j < 4; ++j) {
        size_t R = Rb + wid * 32 + 16 * m + fq * 4 + j;
        float sq = 0.f;
#pragma unroll
        for (int n = 0; n < 4; ++n) {
          int pc = hd * 64 + 16 * n + fr;
          float z = bf2f(u[R * DIN + pc]);
          float val = y[m][n][j] * silu_f(z);
          sq += val * val;
          ymix[R * DMIX + pc] = f2bf(val);
        }
        sq = red16_sum(sq);
        if (fr == 0) ssqa[R * 16 + hd] = sq;
      }
    __syncthreads();
  }
}

__device__ void phase_rope(const Params& p, int g) {
  int nseq, tps, seq0; ginfo(g, nseq, tps, seq0);
  const int nrows = nseq * tps * 128;
  u16* u = (u16*)(p.ws + OFF_U);
  for (int id = obid() * 256 + otid(); id < nrows * 10; id += gridDim.x * 256) {
    const int R = id / 10, hh = id - R * 10;
    const int T = R >> 7, r = R & 127, sl = T / tps, c = T - sl * tps;
    if (c == 0 && r >= 16) continue;
    const int pos = (c == 0) ? r : 16 + (c - 1) * 128 + r;
    u16* s = u + (size_t)R * DIN + (hh < 8 ? C_WQ + hh * 64 : C_WK + (hh - 8) * 64);
    uint4 v0 = *reinterpret_cast<const uint4*>(s), v1 = *reinterpret_cast<const uint4*>(s + 8);
    float x1[8], x2[8], o1[8], o2[8];
    unpack8(v0, x1); unpack8(v1, x2);
    const float posf = (float)pos;
#pragma unroll
    for (int i = 0; i < 8; ++i) {
      float ang = posf * c_inv[i];
      double rev = (double)ang * 0.15915494309189535;
      rev -= rint(rev);
      float rv = (float)rev;
      float sn = __builtin_amdgcn_sinf(rv), cs = __builtin_amdgcn_cosf(rv);
      o1[i] = x1[i] * cs - x2[i] * sn;
      o2[i] = x2[i] * cs + x1[i] * sn;
    }
    *reinterpret_cast<uint4*>(s) = pack8(o1);
    *reinterpret_cast<uint4*>(s + 8) = pack8(o2);
  }
}

DEVI void kv_prefetch(u32x4 (&pk)[2], u32x4 (&pv)[2], const u16* ksrc, const u16* vsrc, int tid) {
#pragma unroll
  for (int i = 0; i < 2; ++i) {
    int id = tid + i * 256;
    pk[i] = *reinterpret_cast<const u32x4*>(ksrc + (size_t)(id >> 3) * DIN + (id & 7) * 8);
    pv[i] = *reinterpret_cast<const u32x4*>(vsrc + (size_t)(id & 63) * DIN + (id >> 6) * 8);
  }
}
DEVI void kv_commit(const u32x4 (&pk)[2], const u32x4 (&pv)[2], u16* Ks, u16* Vt, int tid) {
#pragma unroll
  for (int i = 0; i < 2; ++i) {
    int id = tid + i * 256;
    *reinterpret_cast<u32x4*>(Ks + (id >> 3) * 72 + (id & 7) * 8) = pk[i];
    u16* d = Vt + ((id >> 6) * 8) * 72 + (id & 63);
    d[0 * 72] = (u16)(pv[i][0] & 0xffff); d[1 * 72] = (u16)(pv[i][0] >> 16);
    d[2 * 72] = (u16)(pv[i][1] & 0xffff); d[3 * 72] = (u16)(pv[i][1] >> 16);
    d[4 * 72] = (u16)(pv[i][2] & 0xffff); d[5 * 72] = (u16)(pv[i][2] >> 16);
    d[6 * 72] = (u16)(pv[i][3] & 0xffff); d[7 * 72] = (u16)(pv[i][3] >> 16);
  }
}
DEVI void stage_rope(u16* dst, const u16* src, int nrows, int pos0, int tid) {
  for (int id = tid; id < nrows * 7; id += 256) {
    int r = id / 7, cz = id - r * 7;
    const u16* s = src + (size_t)r * DIN;
    if (cz > 0) {
      *reinterpret_cast<uint4*>(dst + r * 72 + (cz + 1) * 8) = *reinterpret_cast<const uint4*>(s + (cz + 1) * 8);
    } else {
      uint4 v0 = *reinterpret_cast<const uint4*>(s), v1 = *reinterpret_cast<const uint4*>(s + 8);
      float x1[8], x2[8], o1[8], o2[8];
      unpack8(v0, x1); unpack8(v1, x2);
      float pos = (float)(pos0 + r);
#pragma unroll
      for (int i = 0; i < 8; ++i) {
        float ang = pos * c_inv[i];
        double rev = (double)ang * 0.15915494309189535;
        rev -= rint(rev);
        float rv = (float)rev;
        float sn = __builtin_amdgcn_sinf(rv), cs = __builtin_amdgcn_cosf(rv);
        o1[i] = x1[i] * cs - x2[i] * sn;
        o2[i] = x2[i] * cs + x1[i] * sn;
      }
      *reinterpret_cast<uint4*>(dst + r * 72) = pack8(o1);
      *reinterpret_cast<uint4*>(dst + r * 72 + 8) = pack8(o2);
    }
  }
}
DEVI void stage_plain(u16* dst, const u16* src, int nrows, int tid) {
  for (int id = tid; id < nrows * 8; id += 256) {
    int r = id >> 3, ch = id & 7;
    *reinterpret_cast<uint4*>(dst + r * 72 + ch * 8) = *reinterpret_cast<const uint4*>(src + (size_t)r * DIN + ch * 8);
  }
}
DEVI void stage_vt(u16* dst, const u16* src, int tid) {
  for (int id = tid; id < 64 * 8; id += 256) {
    int key = id & 63, ch = id >> 6;
    uint4 v = *reinterpret_cast<const uint4*>(src + (size_t)key * DIN + ch * 8);
    u16* d = dst + (ch * 8) * 72 + key;
    d[0 * 72] = (u16)(v.x & 0xffff); d[1 * 72] = (u16)(v.x >> 16);
    d[2 * 72] = (u16)(v.y & 0xffff); d[3 * 72] = (u16)(v.y >> 16);
    d[4 * 72] = (u16)(v.z & 0xffff); d[5 * 72] = (u16)(v.z >> 16);
    d[6 * 72] = (u16)(v.w & 0xffff); d[7 * 72] = (u16)(v.w >> 16);
  }
}

__device__ void phase_win(const Params& p, int g, int layer, char* smem) {
  int nseq, tps, seq0; ginfo(g, nseq, tps, seq0);
  const int ntiles = nseq * tps;
  u16* Qs = (u16*)smem;
  u16* Ks = Qs + 128 * 72;
  u16* Vt = Ks + 64 * 72;
  u16* Ps = Vt + 64 * 72;
  const int tid = otid(), lane = tid & 63, wid = tid >> 6, fr = lane & 15, fq = lane >> 4;
  const float C2 = 0.125f * 1.4426950408889634f;
  const u16* u = (const u16*)(p.ws + OFF_U);
  u16* ymix = (u16*)(p.ws + OFF_YMIX);
  for (int item = (obid() + gridDim.x - 64) % gridDim.x; item < ntiles * 8; item += gridDim.x) {
    const int T = item >> 3, qh = item & 7, kvh = qh >> 2;
    const int sl = T / tps, c = T - sl * tps, Ts0 = sl * tps;
    const int qpos0 = (c == 0) ? 0 : 16 + (c - 1) * 128;
    u32x4 pk[2], pv[2];
    kv_prefetch(pk, pv, u + (size_t)Ts0 * 128 * DIN + C_WK + kvh * 64, u + (size_t)Ts0 * 128 * DIN + C_WV + kvh * 64, tid);
    stage_plain(Qs, u + (size_t)T * 128 * DIN + C_WQ + qh * 64, 128, tid);
    float mrow[2][4], lrow[2][4];
    f32x4 o[2][4];
#pragma unroll
    for (int m = 0; m < 2; ++m) {
#pragma unroll
      for (int j = 0; j < 4; ++j) { mrow[m][j] = -1e30f; lrow[m][j] = 0.f; }
#pragma unroll
      for (int n = 0; n < 4; ++n) o[m][n] = f32x4{0.f, 0.f, 0.f, 0.f};
    }
    int kb = 0;
    while (kb < 7) {
      int kt = 0, half = 0;
      const bool meta = (kb == 0);
      if (!meta) { kt = c - 1 + ((kb - 1) >> 1); half = (kb - 1) & 1; }
      const int kpos0 = (kt == 0) ? 0 : 16 + (kt - 1) * 128 + half * 64;
      kv_commit(pk, pv, Ks, Vt, tid);
      __syncthreads();
      int nkb = kb + 1;
      while (nkb < 7) {
        int kt2 = c - 1 + ((nkb - 1) >> 1);
        if (kt2 >= 1 && kt2 < tps) break;
        ++nkb;
      }
      if (nkb < 7) {
        const int kt2 = c - 1 + ((nkb - 1) >> 1), half2 = (nkb - 1) & 1;
        const size_t krow2 = (size_t)(Ts0 + kt2) * 128 + half2 * 64;
        kv_prefetch(pk, pv, u + krow2 * DIN + C_WK + kvh * 64, u + krow2 * DIN + C_WV + kvh * 64, tid);
      }
      f32x4 s[2][4];
#pragma unroll
      for (int m = 0; m < 2; ++m)
#pragma unroll
        for (int n = 0; n < 4; ++n) s[m][n] = f32x4{0.f, 0.f, 0.f, 0.f};
      wave_mma<2, 4, 2>(s, Qs + (wid * 32) * 72, 72, 16 * 72, Ks, 72, 16 * 72, lane);
#pragma unroll
      for (int m = 0; m < 2; ++m)
#pragma unroll
        for (int j = 0; j < 4; ++j) {
          const int qrow = wid * 32 + 16 * m + fq * 4 + j;
          const int dbase = qpos0 + qrow - kpos0 - fr + 128;
          float mx = mrow[m][j];
#pragma unroll
          for (int n = 0; n < 4; ++n) {
            bool ok = meta ? (n == 0) : ((unsigned)(dbase - 16 * n) <= 256u);
            float v = ok ? s[m][n][j] : -1e30f;
            s[m][n][j] = v;
            mx = fmaxf(mx, v);
          }
          mx = red16_max(mx);
          const float mxc = mx * C2;
          float alpha = __builtin_amdgcn_exp2f(mrow[m][j] * C2 - mxc);
          float rsum = 0.f;
#pragma unroll
          for (int n = 0; n < 4; ++n) {
            float pv = __builtin_amdgcn_exp2f(s[m][n][j] * C2 - mxc);
            rsum += pv;
            Ps[(wid * 32 + 16 * m + fq * 4 + j) * 72 + 16 * n + fr] = f2bf(pv);
          }
          rsum = red16_sum(rsum);
          lrow[m][j] = lrow[m][j] * alpha + rsum;
          mrow[m][j] = mx;
#pragma unroll
          for (int n = 0; n < 4; ++n) o[m][n][j] *= alpha;
        }
      __syncthreads();
      wave_mma<2, 4, 2>(o, Ps + (wid * 32) * 72, 72, 16 * 72, Vt, 72, 16 * 72, lane);
      __syncthreads();
      kb = nkb;
    }
    const float sk = p.sink[layer * 8 + qh];
#pragma unroll
    for (int m = 0; m < 2; ++m)
#pragma unroll
      for (int j = 0; j < 4; ++j) {
        const float ms = mrow[m][j] * 0.125f;
        float mx = fmaxf(ms, sk);
        float a = __expf(ms - mx);
        float l = lrow[m][j] * a + __expf(sk - mx);
        float inv = a / l;
        size_t R = (size_t)T * 128 + wid * 32 + 16 * m + fq * 4 + j;
#pragma unroll
        for (int n = 0; n < 4; ++n) ymix[R * DMIX + 1024 + qh * 64 + 16 * n + fr] = f2bf(o[m][n][j] * inv);
      }
  }
}

__device__ void phase_na(const Params& p, int g, int layer, char* smem) {
  int nseq, tps, seq0; ginfo(g, nseq, tps, seq0);
  const int ntiles = nseq * tps;
  const int rows_total = (tps - 1) * 2;
  u16* Qs = (u16*)smem;
  u16* Ks = Qs + 128 * 72;
  u16* Vt = Ks + 64 * 72;
  u16* Ps = Vt + 64 * 72;
  float* rp = (float*)(Ps + 4 * 32 * 40);
  float* mb = rp + 480;
  const int tid = otid(), lane = tid & 63, wid = tid >> 6, fr = lane & 15, fq = lane >> 4;
  const float C2 = 0.125f * 1.4426950408889634f;
  const u16* u = (const u16*)(p.ws + OFF_U);
  u16* ymix = (u16*)(p.ws + OFF_YMIX);
  for (int item = (obid() + gridDim.x - 96) % gridDim.x; item < ntiles * 8; item += gridDim.x) {
    const int T = item >> 3, h = item & 7;
    const int sl = T / tps, c = T - sl * tps, Ts0 = sl * tps;
    u32x4 pk[2], pv[2];
    kv_prefetch(pk, pv, u + (size_t)Ts0 * 128 * DIN + C_NK + h * 64, u + (size_t)Ts0 * 128 * DIN + C_NV + h * 64, tid);
    stage_plain(Qs, u + (size_t)T * 128 * DIN + C_NQ + h * 64, 128, tid);
    for (int i = tid; i < 465; i += 256) rp[i] = 8.f * p.rpb[(size_t)(layer * 8 + h) * 465 + i];
    if (tid < 16) mb[tid] = 8.f * p.mbias[(layer * 8 + h) * 16 + tid];
    const int r0 = (c == 0) ? 0 : 2 * (c - 1);
    int qr[2], rsm[2];
#pragma unroll
    for (int m = 0; m < 2; ++m) {
      qr[m] = (c == 0) ? 0 : r0 + m;
      rsm[m] = min(max(qr[m] - 4, 0), rows_total - 8);
    }
    const int krlo = rsm[0], krhi = rsm[1] + 7;
    const int kc0w = min(max(16 * wid - 8, 0), 32);
    float mrow[2][4], lrow[2][4];
    f32x4 o[2][4];
#pragma unroll
    for (int m = 0; m < 2; ++m) {
#pragma unroll
      for (int j = 0; j < 4; ++j) { mrow[m][j] = -1e30f; lrow[m][j] = 0.f; }
#pragma unroll
      for (int n = 0; n < 4; ++n) o[m][n] = f32x4{0.f, 0.f, 0.f, 0.f};
    }
    for (int kb = -1; kb <= krhi - krlo; ++kb) {
      const bool meta = kb < 0;
      const int kr = krlo + kb;
      kv_commit(pk, pv, Ks, Vt, tid);
      __syncthreads();
      if (kb < krhi - krlo) {
        const int kr2 = kr + 1;
        const size_t krow2 = (size_t)(Ts0 + 1 + (kr2 >> 1)) * 128 + (kr2 & 1) * 64;
        kv_prefetch(pk, pv, u + krow2 * DIN + C_NK + h * 64, u + krow2 * DIN + C_NV + h * 64, tid);
      }
      const int kc0 = meta ? 0 : kc0w;
      f32x4 s[2][2];
#pragma unroll
      for (int m = 0; m < 2; ++m)
#pragma unroll
        for (int n = 0; n < 2; ++n) s[m][n] = f32x4{0.f, 0.f, 0.f, 0.f};
      wave_mma<2, 2, 2>(s, Qs + (16 * wid) * 72, 72, 64 * 72, Ks + kc0 * 72, 72, 16 * 72, lane);
#pragma unroll
      for (int m = 0; m < 2; ++m) {
        const bool rowok = (kr >= rsm[m]) && (kr <= rsm[m] + 7);
        const int rbase = (kr - qr[m] + 7) * 31 + 15;
#pragma unroll
        for (int j = 0; j < 4; ++j) {
          const int qc = (c == 0) ? 0 : 16 * wid + fq * 4 + j;
          const int qcs = min(max(qc - 8, 0), 48);
          const int kcb = kc0 + fr;
          float mx = mrow[m][j];
#pragma unroll
          for (int n = 0; n < 2; ++n) {
            const int kc = kcb + 16 * n;
            float v = -1e30f;
            if (meta) {
              if (n == 0) v = s[m][n][j] + mb[fr];
            } else if (rowok && (unsigned)(kc - qcs) < 16u) {
              v = s[m][n][j] + rp[rbase + kc - qc];
            }
            s[m][n][j] = v;
            mx = fmaxf(mx, v);
          }
          mx = red16_max(mx);
          const float mxc = mx * C2;
          float alpha = __builtin_amdgcn_exp2f(mrow[m][j] * C2 - mxc);
          float rsum = 0.f;
#pragma unroll
          for (int n = 0; n < 2; ++n) {
            float pv = __builtin_amdgcn_exp2f(s[m][n][j] * C2 - mxc);
            rsum += pv;
            Ps[(wid * 32 + 16 * m + fq * 4 + j) * 40 + 16 * n + fr] = f2bf(pv);
          }
          rsum = red16_sum(rsum);
          lrow[m][j] = lrow[m][j] * alpha + rsum;
          mrow[m][j] = mx;
#pragma unroll
          for (int n = 0; n < 4; ++n) o[m][n][j] *= alpha;
        }
      }
      __syncthreads();
      wave_mma<2, 4, 1>(o, Ps + (wid * 32) * 40, 40, 16 * 40, Vt + kc0, 72, 16 * 72, lane);
      __syncthreads();
    }
#pragma unroll
    for (int m = 0; m < 2; ++m)
#pragma unroll
      for (int j = 0; j < 4; ++j) {
        float inv = 1.f / lrow[m][j];
        size_t R = (size_t)T * 128 + m * 64 + 16 * wid + fq * 4 + j;
#pragma unroll
        for (int n = 0; n < 4; ++n) ymix[R * DMIX + 1536 + h * 64 + 16 * n + fr] = f2bf(o[m][n][j] * inv);
      }
  }
}

__device__ void phase_act(const Params& p, int g, int layer) {
  int nseq, tps, seq0; ginfo(g, nseq, tps, seq0);
  const int ntiles = nseq * tps;
  const int L = (tps - 1) * 128 + 16;
  const u16* gb = (const u16*)(p.ws + OFF_U);
  u16* act = (u16*)(p.ws + OFF_ST);
  const float* cw = p.fconv_w + (size_t)layer * 3 * DUP;
  const float* cb = p.fconv_b + (size_t)layer * DUP;
  const int total = ntiles * 8 * 352;
  for (int id = obid() * 256 + otid(); id < total; id += gridDim.x * 256) {
    const int ch = id % 352, ts = id / 352, seg = ts & 7, T = ts >> 3;
    const int sl = T / tps, c = T - sl * tps;
    const int col = ch * 8;
    const size_t Rseq = (size_t)sl * tps * 128;
    u16* orow = act + ((size_t)T * 128 + seg * 16) * DFF + col;
    const int nvalid = (c > 0) ? 16 : (seg == 0 ? 16 : 0);
    if (nvalid == 0) {
      uint4 z = make_uint4(0, 0, 0, 0);
#pragma unroll 4
      for (int r = 0; r < 16; ++r) *reinterpret_cast<uint4*>(orow + (size_t)r * DFF) = z;
      continue;
    }
    const int pos0 = (c == 0) ? 0 : 16 + (c - 1) * 128 + seg * 16;
    float wg[3][8], wu[3][8], bg[8], bu[8];
#pragma unroll
    for (int j = 0; j < 3; ++j) {
      float4 a0 = *reinterpret_cast<const float4*>(cw + j * DUP + col), a1 = *reinterpret_cast<const float4*>(cw + j * DUP + col + 4);
      float4 c0 = *reinterpret_cast<const float4*>(cw + j * DUP + DFF + col), c1 = *reinterpret_cast<const float4*>(cw + j * DUP + DFF + col + 4);
      wg[j][0] = a0.x; wg[j][1] = a0.y; wg[j][2] = a0.z; wg[j][3] = a0.w; wg[j][4] = a1.x; wg[j][5] = a1.y; wg[j][6] = a1.z; wg[j][7] = a1.w;
      wu[j][0] = c0.x; wu[j][1] = c0.y; wu[j][2] = c0.z; wu[j][3] = c0.w; wu[j][4] = c1.x; wu[j][5] = c1.y; wu[j][6] = c1.z; wu[j][7] = c1.w;
    }
    {
      float4 a0 = *reinterpret_cast<const float4*>(cb + col), a1 = *reinterpret_cast<const float4*>(cb + col + 4);
      float4 c0 = *reinterpret_cast<const float4*>(cb + DFF + col), c1 = *reinterpret_cast<const float4*>(cb + DFF + col + 4);
      bg[0] = a0.x; bg[1] = a0.y; bg[2] = a0.z; bg[3] = a0.w; bg[4] = a1.x; bg[5] = a1.y; bg[6] = a1.z; bg[7] = a1.w;
      bu[0] = c0.x; bu[1] = c0.y; bu[2] = c0.z; bu[3] = c0.w; bu[4] = c1.x; bu[5] = c1.y; bu[6] = c1.z; bu[7] = c1.w;
    }
    float xg[3][8], xu[3][8];
    auto ldrow = [&](int pp, float* dg, float* du) {
      const bool ok = (pp >= 0) && (pp < L);
      const int pc = min(max(pp, 0), L - 1);
      const int prow = (pc < 16) ? pc : 112 + pc;
      const u16* sp = gb + (Rseq + prow) * DUP + col;
      uint4 v0 = *reinterpret_cast<const uint4*>(sp), v1 = *reinterpret_cast<const uint4*>(sp + DFF);
      if (!ok) { v0 = make_uint4(0, 0, 0, 0); v1 = make_uint4(0, 0, 0, 0); }
      unpack8(v0, dg); unpack8(v1, du);
    };
    ldrow(pos0 - 1, xg[0], xu[0]); ldrow(pos0, xg[1], xu[1]);
#pragma unroll
    for (int r = 0; r < 16; ++r) {
      ldrow(pos0 + r + 1, xg[(r + 2) % 3], xu[(r + 2) % 3]);
      float res[8];
#pragma unroll
      for (int i = 0; i < 8; ++i) {
        float ga = bg[i], up = bu[i];
#pragma unroll
        for (int j = 0; j < 3; ++j) { ga += xg[(r + j) % 3][i] * wg[j][i]; up += xu[(r + j) % 3][i] * wu[j][i]; }
        float yv = 0.7978845608028654f * (ga + 0.044715f * ga * ga * ga);
        float th = 1.f - 2.f * __builtin_amdgcn_rcpf(__expf(2.f * yv) + 1.f);
        res[i] = 0.5f * ga * (1.f + th) * up;
      }
      *reinterpret_cast<uint4*>(orow + (size_t)r * DFF) = pack8(res);
    }
  }
}

#define XB_TMO      128
#define XB_XCNT(j)  (256  + 64 * (j))
#define XB_XSUB(j)  (1280 + 64 * (j))
#define XB_XGEN(j)  (2304 + 64 * (j))
#define XB_TOP      3328
#define XB_TOPGEN   3392
#define XCD_BAR_WORDS 3456
#define XB_SPIN_CAP (1u << 22)
#define LAS __attribute__((address_space(3)))
DEVI unsigned xb_ld(unsigned* p) { return __hip_atomic_load(p, __ATOMIC_RELAXED, __HIP_MEMORY_SCOPE_AGENT); }
DEVI unsigned xb_add(unsigned* p, unsigned v) { return __hip_atomic_fetch_add(p, v, __ATOMIC_RELAXED, __HIP_MEMORY_SCOPE_AGENT); }
DEVI unsigned xb_xcc_id() { return (unsigned)__builtin_amdgcn_s_getreg((3 << 11) | 20) & 0xFu; }
#define XB_SPIN(cond, bar) do { unsigned _sp = 0; while (cond) { __builtin_amdgcn_s_sleep(1); \
    if ((++_sp & 255u) == 0u) { if (xb_ld(&(bar)[XB_TMO])) break; if (_sp > XB_SPIN_CAP) { atomicAdd(&(bar)[XB_TMO], 1u); break; } } } } while (0)
struct XcdBarrier { unsigned* bar; unsigned x; volatile LAS unsigned* st; };
DEVI XcdBarrier xcd_barrier_post(unsigned* bar, volatile LAS unsigned* st) {
  XcdBarrier b; b.bar = bar; b.x = xb_xcc_id(); b.st = st;
  if (threadIdx.x == 0) (void)xb_add(&bar[XB_XCNT(b.x)], 1u);
  return b;
}
DEVI void xcd_barrier_complete(unsigned* bar, unsigned x, unsigned& nloc, unsigned& nx) {
  const unsigned G = gridDim.x * gridDim.y * gridDim.z;
  unsigned sum, cnt, mine, sp = 0u;
  for (;;) {
    sum = 0u; cnt = 0u; mine = 0u;
#pragma unroll
    for (unsigned j = 0; j < 16; ++j) { const unsigned c = xb_ld(&bar[XB_XCNT(j)]); sum += c; cnt += (c > 0u) ? 1u : 0u; mine = (j == x) ? c : mine; }
    if (sum == G) break;
    __builtin_amdgcn_s_sleep(1);
    if ((++sp & 255u) == 0u) { if (xb_ld(&bar[XB_TMO])) break; if (sp > XB_SPIN_CAP) { atomicAdd(&bar[XB_TMO], 1u); break; } }
  }
  nloc = mine > 0u ? mine : 1u; nx = cnt > 0u ? cnt : 1u;
}
DEVI void xcd_barrier(const XcdBarrier& b) {
  asm volatile("s_waitcnt vmcnt(0)" ::: "memory");
  __syncthreads();
  if (threadIdx.x == 0) {
    unsigned* bar = b.bar;
    __builtin_amdgcn_s_waitcnt(0);
    unsigned nloc = b.st[0], nx = b.st[1];
    if (nloc == 0u) { xcd_barrier_complete(bar, b.x, nloc, nx); b.st[0] = nloc; b.st[1] = nx; }
    const unsigned old = xb_add(&bar[XB_XSUB(b.x)], 1u);
    const unsigned gen = old / nloc;
    if (old + 1u == (gen + 1u) * nloc) {
      __builtin_amdgcn_fence(__ATOMIC_RELEASE, "agent");
      asm volatile("s_waitcnt vmcnt(0)" ::: "memory");
      const unsigned og = xb_add(&bar[XB_TOP], 1u);
      const unsigned tg = og / nx;
      if (og + 1u == (tg + 1u) * nx) xb_add(&bar[XB_TOPGEN], 1u);
      else XB_SPIN(xb_ld(&bar[XB_TOPGEN]) == tg, bar);
      __builtin_amdgcn_fence(__ATOMIC_ACQUIRE, "agent");
      xb_add(&bar[XB_XGEN(b.x)], 1u);
      asm volatile("s_waitcnt vmcnt(0)" ::: "memory");
    } else {
      XB_SPIN(xb_ld(&bar[XB_XGEN(b.x)]) == gen, bar);
      __builtin_amdgcn_fence(__ATOMIC_ACQUIRE, "agent");
      asm volatile("s_waitcnt vmcnt(0)" ::: "memory");
    }
  }
  __syncthreads();
}

#ifndef REP_GEMM
#define REP_GEMM 1
#endif
#ifndef REP_SSD
#define REP_SSD 1
#endif
#ifndef REP_WIN
#define REP_WIN 1
#endif
#ifndef REP_NA
#define REP_NA 1
#endif
#ifndef REP_EW
#define REP_EW 1
#endif
__global__ void __launch_bounds__(256, 2) mega(Params p) {
  extern __shared__ __attribute__((aligned(16))) char smem[];
  cg::grid_group grid = cg::this_grid();
  __shared__ uint4 xb_words;
  if (threadIdx.x == 0) xb_words = make_uint4(0u, 0u, 0u, 0u);
  __syncthreads();
  XcdBarrier xb = xcd_barrier_post((unsigned*)(p.ws + OFF_BAR), (volatile LAS unsigned*)&xb_words);
#pragma unroll 1
  for (int step = 0; step < 93; ++step) {
    int ph = 100, g = 0, layer = 0;
    if (step > 0) {
      int s = step - 1;
      g = s / 23;
      int r = s - g * 23;
      if (r == 0) ph = 101;
      else { layer = (r - 1) / 11; ph = (r - 1) - layer * 11; }
    }
    int nseq, tps, seq0; ginfo(g, nseq, tps, seq0);
    const int ntm = nseq * (tps - 1), tpr = tps - 1;
    if (step == 1) continue;
    if (ph == 100) {
      phase_prep(p, smem);
      phase_rowupd(p, 0, 0, (const u16*)(p.ws + OFF_U), nullptr);
    } else if (ph == 101 || ph == 6 || ph == 10) {
      const float* w = (ph == 6) ? p.n_mix_post + layer * DM : p.n_ffn_post + layer * DM;
      const int mode = (ph == 101) ? 0 : ((ph == 10 && layer == 1) ? 2 : 1);
      phase_rowupd(p, g, mode, (const u16*)(p.ws + OFF_U), w);
    } else if (ph == 0 || ph == 7) {
      const u16* Bt = (ph == 0) ? (const u16*)(p.ws + OFF_WIN) + (size_t)layer * DINP * DM
                                : (const u16*)(p.ws + OFF_WUP) + (size_t)layer * DUP * DM;
      const int nv = (ph == 0) ? DIN : DUP;
      for (int rep = 0; rep < REP_GEMM; ++rep) {
        phase_gemm_w<0>((const u16*)(p.ws + OFF_HB), DM, Bt, DM, ntm, 20, (ph == 0) ? DIN : 5120,
                        (const float*)(p.ws + OFF_RS), (u16*)(p.ws + OFF_U), nv, tpr, nullptr, smem);
        if (ph == 7)
          phase_gemm<0>((const u16*)(p.ws + OFF_HB), DM, Bt + (size_t)5120 * DM, DM, ntm, 4, 512,
                        (const float*)(p.ws + OFF_RS), (u16*)(p.ws + OFF_U) + 5120, nv, tpr, nullptr, smem);
        phase_gemm_meta<0>((const u16*)(p.ws + OFF_HB), DM, Bt, DM, nseq, tps, nv / 16, (const float*)(p.ws + OFF_RS),
                           (u16*)(p.ws + OFF_U), nv, nullptr);
      }
    } else if (ph == 5 || ph == 9) {
      const u16* A = (ph == 5) ? (const u16*)(p.ws + OFF_YMIX) : (const u16*)(p.ws + OFF_ST);
      const u16* Bt = (ph == 5) ? (const u16*)(p.ws + OFF_WOUT) + (size_t)layer * DM * DMIX
                                : (const u16*)(p.ws + OFF_WDN) + (size_t)layer * DM * DFF;
      const int K = (ph == 5) ? DMIX : DFF;
      const float* ssqk = (ph == 5) ? (const float*)(p.ws + OFF_SSQA) : nullptr;
      for (int rep = 0; rep < REP_GEMM; ++rep) {
        phase_gemm_w<1>(A, K, Bt, K, ntm, 4, DM, nullptr, (u16*)(p.ws + OFF_U), DM, tpr, ssqk, smem);
        phase_gemm_meta<1>(A, K, Bt, K, nseq, tps, DM / 16, nullptr, (u16*)(p.ws + OFF_U), DM, ssqk);
      }
    } else if (ph == 1) {
      for (int rep = 0; rep < REP_EW; ++rep) phase_conv(p, g, layer);
      phase_rope(p, g);
    } else if (ph == 2) {
      for (int rep = 0; rep < REP_SSD; ++rep) phase_ssdA(p, g, layer, smem);
    } else if (ph == 3) {
      phase_scan(p, g);
    } else if (ph == 4) {
      for (int rep = 0; rep < REP_SSD; ++rep) phase_ssdC(p, g, layer, smem);
      for (int rep = 0; rep < REP_WIN; ++rep) phase_win(p, g, layer, smem);
      for (int rep = 0; rep < REP_NA; ++rep) phase_na(p, g, layer, smem);
    } else if (ph == 8) {
      for (int rep = 0; rep < REP_EW; ++rep) phase_act(p, g, layer);
    }
    if (step == 0) grid.sync();
    else if (step < 92) xcd_barrier(xb);
  }
}

extern "C" void kernel_launch(void* const* d_in, const int* in_sizes, int n_in, void* d_out, int out_size,
                              void* d_ws, size_t ws_size, hipStream_t stream) {
  static int grid_blocks = 0;
  if (!grid_blocks) {
    int dev = 0, cus = 0, per_cu = 0;
    hipGetDevice(&dev);
    hipDeviceGetAttribute(&cus, hipDeviceAttributeMultiprocessorCount, dev);
    hipFuncSetAttribute((const void*)mega, hipFuncAttributeMaxDynamicSharedMemorySize, LDS_BYTES);
    hipOccupancyMaxActiveBlocksPerMultiprocessor(&per_cu, mega, 256, LDS_BYTES);
    if (per_cu > 2) per_cu = 2;
    if (per_cu < 1) per_cu = 1;
    grid_blocks = cus * per_cu;
  }
  Params p{};
  const float* const* in = (const float* const*)d_in;
  p.xp = in[0]; p.xs = in[1]; p.meta = in[2]; p.n_mix_pre = in[3]; p.n_mix_post = in[4]; p.w_in = in[5];
  p.conv_w = in[6]; p.conv_b = in[7]; p.dt_bias = in[8]; p.a_log = in[9]; p.ssd_d = in[10]; p.ssd_nw = in[11];
  p.sink = in[12]; p.rpb = in[13]; p.mbias = in[14]; p.w_out = in[15]; p.n_ffn_pre = in[16]; p.n_ffn_post = in[17];
  p.w_up = in[18]; p.fconv_w = in[19]; p.fconv_b = in[20]; p.w_down = in[21];
  p.out = (float*)d_out; p.ws = (char*)d_ws;
  if (ws_size < WS_NEED) fprintf(stderr, "workspace too small: %zu < %zu\n", ws_size, (size_t)WS_NEED);
  hipMemsetAsync((char*)d_ws + OFF_BAR, 0, XCD_BAR_WORDS * 4, stream);
  void* args[] = {&p};
  hipError_t e = hipLaunchCooperativeKernel((void*)mega, dim3(grid_blocks), dim3(256), args, LDS_BYTES, stream);
  if (e != hipSuccess) fprintf(stderr, "cooperative launch failed: %s (grid %d)\n", hipGetErrorString(e), grid_blocks);
}
```

```cpp
#include <hip/hip_runtime.h>
#include <hip/hip_cooperative_groups.h>
#include <cstdio>
namespace cg = cooperative_groups;

typedef unsigned short u16;
typedef __attribute__((ext_vector_type(8))) short bf16x8;
typedef __attribute__((ext_vector_type(4))) float f32x4;
typedef __attribute__((ext_vector_type(4))) unsigned int u32x4;
#define DEVI __device__ __forceinline__

constexpr int DM = 1024, DIN = 4896, DINP = 5120, DMIX = 2048, DFF = 2816, DUP = 5632;
constexpr int C_XBC = 1024, C_DT = 2560, C_WQ = 2592, C_WK = 3104, C_WV = 3232, C_NQ = 3360, C_NK = 3872, C_NV = 4384;
constexpr size_t RMAX = 16896;
constexpr int TMAX = 132;
constexpr float EPS = 1e-6f;
constexpr int LDS_BYTES = 77824;

constexpr size_t SZ_WIN = (size_t)2 * DINP * DM * 2;
constexpr size_t SZ_WOUT = (size_t)2 * DM * DMIX * 2;
constexpr size_t SZ_WUP = (size_t)2 * DUP * DM * 2;
constexpr size_t SZ_WDN = (size_t)2 * DM * DFF * 2;
constexpr size_t OFF_WIN = 0;
constexpr size_t OFF_WOUT = OFF_WIN + SZ_WIN;
constexpr size_t OFF_WUP = OFF_WOUT + SZ_WOUT;
constexpr size_t OFF_WDN = OFF_WUP + SZ_WUP;
constexpr size_t OFF_HMETA = OFF_WDN + SZ_WDN;
constexpr size_t OFF_HB = OFF_HMETA + (size_t)10 * 16 * DM * 4;
constexpr size_t OFF_U = OFF_HB + RMAX * DM * 2;
constexpr size_t OFF_XC = OFF_U + RMAX * DIN * 2;
constexpr size_t OFF_DT = OFF_XC + RMAX * 1536 * 2;
constexpr size_t OFF_ST = OFF_DT + RMAX * 32 * 4;
constexpr size_t OFF_YMIX = OFF_ST + (size_t)TMAX * 16 * 2 * 8192 * 2;
constexpr size_t OFF_SSQA = OFF_YMIX + RMAX * DMIX * 2;
constexpr size_t OFF_SSQB = OFF_SSQA + RMAX * 16 * 4;
constexpr size_t OFF_RS = OFF_SSQB + RMAX * 16 * 4;
constexpr size_t OFF_DEC = OFF_RS + RMAX * 4;
constexpr size_t WS_TOTAL = OFF_DEC + (size_t)TMAX * 16 * 2 * 4;
constexpr size_t OFF_BAR = (WS_TOTAL + 255) / 256 * 256;
constexpr size_t WS_NEED = OFF_BAR + 3456 * 4;
static_assert(RMAX * DUP * 2 <= RMAX * DIN * 2 + RMAX * 1536 * 2, "g alias");
static_assert(RMAX * DFF * 2 <= (size_t)TMAX * 16 * 2 * 8192 * 2 + RMAX * DMIX * 2, "act alias");
static_assert(WS_NEED < (size_t)512 * 1024 * 1024, "ws");

__constant__ float c_inv[8] = {1.0f, 0.1939227447486858f, 0.03760603093086394f, 0.007292664737217109f,
                               0.0014142135623730955f, 0.00027424817567620724f, 5.318295896944988e-05f,
                               1.0313385377212461e-05f};

struct Params {
  const float *xp, *xs, *meta, *n_mix_pre, *n_mix_post, *w_in, *conv_w, *conv_b, *dt_bias, *a_log, *ssd_d, *ssd_nw,
      *sink, *rpb, *mbias, *w_out, *n_ffn_pre, *n_ffn_post, *w_up, *fconv_w, *fconv_b, *w_down;
  float* out;
  char* ws;
};

typedef __attribute__((ext_vector_type(2))) __bf16 bf16x2_t;
typedef __attribute__((ext_vector_type(2))) float f32x2_t;
DEVI unsigned cvt_pk_bf16(float a, float b) {
  f32x2_t v = {a, b};
  return __builtin_bit_cast(unsigned, __builtin_convertvector(v, bf16x2_t));
}
DEVI u16 f2bf(float f) { return (u16)(cvt_pk_bf16(f, 0.f) & 0xffffu); }
DEVI float bf2f(u16 h) { return __uint_as_float(((unsigned)h) << 16); }
DEVI float silu_f(float x) { return x * __builtin_amdgcn_rcpf(1.f + __expf(-x)); }
DEVI void unpack8(uint4 v, float* f) {
  f[0] = __uint_as_float(v.x << 16); f[1] = __uint_as_float(v.x & 0xffff0000u);
  f[2] = __uint_as_float(v.y << 16); f[3] = __uint_as_float(v.y & 0xffff0000u);
  f[4] = __uint_as_float(v.z << 16); f[5] = __uint_as_float(v.z & 0xffff0000u);
  f[6] = __uint_as_float(v.w << 16); f[7] = __uint_as_float(v.w & 0xffff0000u);
}
DEVI unsigned pack2(float a, float b) { return cvt_pk_bf16(a, b); }
DEVI uint4 pack8(const float* f) {
  uint4 v; v.x = pack2(f[0], f[1]); v.y = pack2(f[2], f[3]); v.z = pack2(f[4], f[5]); v.w = pack2(f[6], f[7]);
  return v;
}
DEVI void ginfo(int g, int& nseq, int& tps, int& seq0) {
  if (g < 2) { nseq = 4; tps = 33; seq0 = 4 * g; } else { nseq = 1; tps = 129; seq0 = 8 + (g - 2); }
}
DEVI size_t seq_outrow(int seq) { return seq < 8 ? (size_t)seq * 4096 : (size_t)32768 + (size_t)(seq - 8) * 16384; }
template <int N>
DEVI float dpp_ror(float v) {
  return __builtin_bit_cast(float, __builtin_amdgcn_update_dpp(0, __builtin_bit_cast(int, v), 0x120 + N, 0xf, 0xf, false));
}
DEVI float red16_sum(float v) {
  v += dpp_ror<8>(v); v += dpp_ror<4>(v); v += dpp_ror<2>(v); v += dpp_ror<1>(v); return v;
}
DEVI float red16_max(float v) {
  v = fmaxf(v, dpp_ror<8>(v)); v = fmaxf(v, dpp_ror<4>(v)); v = fmaxf(v, dpp_ror<2>(v)); v = fmaxf(v, dpp_ror<1>(v));
  return v;
}
DEVI float red64_sum(float v) {
  v = red16_sum(v);
  v += __shfl_xor(v, 16); v += __shfl_xor(v, 32); return v;
}

DEVI int otid() { int t = threadIdx.x; asm volatile("" : "+v"(t)); return t; }
DEVI int obid() { return blockIdx.x; }

template <int MT, int NT, int KT>
DEVI void wave_mma(f32x4 (&acc)[MT][NT], const u16* A, int lda, int mstep, const u16* B, int ldb, int nstep, int lane) {
  const int fr = lane & 15, fq = lane >> 4;
  const u16* ap = A + fr * lda + fq * 8;
  const u16* bp = B + fr * ldb + fq * 8;
#pragma unroll
  for (int ks = 0; ks < KT; ++ks) {
    bf16x8 a[MT], b[NT];
#pragma unroll
    for (int m = 0; m < MT; ++m) a[m] = *reinterpret_cast<const bf16x8*>(ap + m * mstep + ks * 32);
#pragma unroll
    for (int n = 0; n < NT; ++n) b[n] = *reinterpret_cast<const bf16x8*>(bp + n * nstep + ks * 32);
    __builtin_amdgcn_s_setprio(1);
#pragma unroll
    for (int m = 0; m < MT; ++m)
#pragma unroll
      for (int n = 0; n < NT; ++n) acc[m][n] = __builtin_amdgcn_mfma_f32_16x16x32_bf16(a[m], b[n], acc[m][n], 0, 0, 0);
    __builtin_amdgcn_s_setprio(0);
  }
}

__device__ void prep_one(const float* src, u16* dst, int K, int N, int tk, int tn, const float* kscale, int klim,
                         char* smem) {
  float* tile = (float*)smem;
  const int tid = otid();
  const int k0 = tk * 64, n0 = tn * 64;
#pragma unroll 4
  for (int i = 0; i < 16; ++i) {
    int k = i * 4 + (tid >> 6), n = tid & 63;
    float v = 0.f;
    if (n0 + n < N) {
      v = src[(size_t)(k0 + k) * N + n0 + n];
      if (kscale && (k0 + k) < klim) v *= kscale[k0 + k];
    }
    tile[k * 65 + n] = v;
  }
  __syncthreads();
#pragma unroll 4
  for (int i = 0; i < 16; ++i) {
    int n = i * 4 + (tid >> 6), k = tid & 63;
    dst[(size_t)(n0 + n) * K + k0 + k] = f2bf(tile[k * 65 + n]);
  }
  __syncthreads();
}

__device__ void phase_prep(const Params& p, char* smem) {
  for (int it = obid(); it < 2 * 3904; it += gridDim.x) {
    int layer = it / 3904, r = it % 3904;
    if (r < 1280) {
      prep_one(p.w_in + (size_t)layer * DM * DIN, (u16*)(p.ws + OFF_WIN) + (size_t)layer * DINP * DM, DM, DIN, r / 80,
               r % 80, p.n_mix_pre + layer * DM, DM, smem);
    } else if (r < 1792) {
      r -= 1280;
      prep_one(p.w_out + (size_t)layer * DMIX * DM, (u16*)(p.ws + OFF_WOUT) + (size_t)layer * DM * DMIX, DMIX, DM,
               r / 16, r % 16, p.ssd_nw + layer * 1024, 1024, smem);
    } else if (r < 3200) {
      r -= 1792;
      prep_one(p.w_up + (size_t)layer * DM * DUP, (u16*)(p.ws + OFF_WUP) + (size_t)layer * DUP * DM, DM, DUP, r / 88,
               r % 88, p.n_ffn_pre + layer * DM, DM, smem);
    } else {
      r -= 3200;
      prep_one(p.w_down + (size_t)layer * DFF * DM, (u16*)(p.ws + OFF_WDN) + (size_t)layer * DM * DFF, DFF, DM, r / 16,
               r % 16, nullptr, 0, smem);
    }
  }
}

__device__ void phase_rowupd(const Params& p, int g, int mode, const u16* src, const float* w) {
  int nseq, tps, seq0; ginfo(g, nseq, tps, seq0);
  const int nrows = nseq * tps * 128;
  const int tid_ = otid(); const int lane = tid_ & 63, wid = tid_ >> 6;
  u16* hb = (u16*)(p.ws + OFF_HB);
  float* rs = (float*)(p.ws + OFF_RS);
  for (int Rp = obid() * 8 + wid * 2; Rp < nrows; Rp += gridDim.x * 8) {
    const int T = Rp >> 7, r = Rp & 127, sl = T / tps, c = T - sl * tps, seq = seq0 + sl;
    u16* hbrow = hb + (size_t)Rp * DM;
    const bool valid = (c > 0) || (r < 16);
    if (!valid) {
      if (mode == 0) {
        uint4 z = make_uint4(0, 0, 0, 0);
#pragma unroll
        for (int q = 0; q < 2; ++q) {
          *reinterpret_cast<uint4*>(hbrow + q * DM + lane * 16) = z;
          *reinterpret_cast<uint4*>(hbrow + q * DM + lane * 16 + 8) = z;
        }
        if (lane < 2) rs[Rp + lane] = 0.f;
      }
      continue;
    }
    if (mode == 2 && c == 0) continue;
    float4 v[2][4];
    if (mode == 0) {
      const float* xr;
      if (c == 0) xr = p.meta + (size_t)r * DM;
      else if (seq < 8) xr = p.xp + ((size_t)seq * 4096 + (size_t)(c - 1) * 128 + r) * DM;
      else xr = p.xs + ((size_t)(seq - 8) * 16384 + (size_t)(c - 1) * 128 + r) * DM;
#pragma unroll
      for (int q = 0; q < 2; ++q)
#pragma unroll
        for (int i = 0; i < 4; ++i) v[q][i] = *reinterpret_cast<const float4*>(xr + q * DM + lane * 4 + i * 256);
    } else {
      const u16* sr = src + (size_t)Rp * DM;
      uint2 sv[2][4], hv[2][4];
      float4 wv[4];
#pragma unroll
      for (int q = 0; q < 2; ++q)
#pragma unroll
        for (int i = 0; i < 4; ++i) {
          sv[q][i] = *reinterpret_cast<const uint2*>(sr + q * DM + lane * 4 + i * 256);
          hv[q][i] = *reinterpret_cast<const uint2*>(hbrow + q * DM + lane * 4 + i * 256);
        }
#pragma unroll
      for (int i = 0; i < 4; ++i) wv[i] = *reinterpret_cast<const float4*>(w + lane * 4 + i * 256);
#pragma unroll
      for (int q = 0; q < 2; ++q) {
        float tot = 0.f;
#pragma unroll
        for (int i = 0; i < 4; ++i) {
          float a0 = __uint_as_float(sv[q][i].x << 16), a1 = __uint_as_float(sv[q][i].x & 0xffff0000u);
          float a2 = __uint_as_float(sv[q][i].y << 16), a3 = __uint_as_float(sv[q][i].y & 0xffff0000u);
          tot += a0 * a0 + a1 * a1 + a2 * a2 + a3 * a3;
        }
        tot = red64_sum(tot);
        const float sc = rsqrtf(tot * (1.f / 1024.f) + EPS);
#pragma unroll
        for (int i = 0; i < 4; ++i) {
          float4 o;
          o.x = __uint_as_float(hv[q][i].x << 16) + __uint_as_float(sv[q][i].x << 16) * sc * wv[i].x;
          o.y = __uint_as_float(hv[q][i].x & 0xffff0000u) + __uint_as_float(sv[q][i].x & 0xffff0000u) * sc * wv[i].y;
          o.z = __uint_as_float(hv[q][i].y << 16) + __uint_as_float(sv[q][i].y << 16) * sc * wv[i].z;
          o.w = __uint_as_float(hv[q][i].y & 0xffff0000u) + __uint_as_float(sv[q][i].y & 0xffff0000u) * sc * wv[i].w;
          v[q][i] = o;
        }
      }
    }
    if (mode == 2) {
      float* op = p.out + (seq_outrow(seq) + (size_t)(c - 1) * 128 + r) * DM;
#pragma unroll
      for (int q = 0; q < 2; ++q)
#pragma unroll
        for (int i = 0; i < 4; ++i) *reinterpret_cast<float4*>(op + q * DM + lane * 4 + i * 256) = v[q][i];
      continue;
    }
#pragma unroll
    for (int q = 0; q < 2; ++q) {
      float ss = 0.f;
#pragma unroll
      for (int i = 0; i < 4; ++i) {
        ss += v[q][i].x * v[q][i].x + v[q][i].y * v[q][i].y + v[q][i].z * v[q][i].z + v[q][i].w * v[q][i].w;
        uint2 bb; bb.x = pack2(v[q][i].x, v[q][i].y); bb.y = pack2(v[q][i].z, v[q][i].w);
        *reinterpret_cast<uint2*>(hbrow + q * DM + lane * 4 + i * 256) = bb;
      }
      ss = red64_sum(ss);
      if (lane == 0) rs[Rp + q] = rsqrtf(ss * (1.f / 1024.f) + EPS);
    }
  }
}

struct GemmCursor { int it, kt; const u16* ap; const u16* bp; };
struct GemmMap { int bid, G, ntm, ntn, ntnp, swz, ni; };
DEVI int gemm_T(int tm, int tpr) { return tm + tm / tpr + 1; }
DEVI bool gemm_map(const GemmMap& M, int it, int& tm, int& tn) {
  if (M.swz == 2) {
    const int xcd = M.bid & 7, j = M.bid >> 3;
    const int P = it * 8 + xcd;
    const int ptm = P / M.ntnp, ptn = P - ptm * M.ntnp;
    tm = ptm * 8 + (j & 7);
    tn = ptn * 8 + (j >> 3);
    bool v = tn < M.ntn;
    if (!v) tn = M.ntn - 1;
    return v;
  }
  if (M.swz) {
    const int xcd = M.bid & 7, j = M.bid >> 3, half = j >> 5, q = j & 31;
    const int P = (it * 8 + xcd) * 2 + half;
    const int ptm = P / M.ntnp, ptn = P - ptm * M.ntnp;
    tm = ptm * 8 + (q & 7);
    tn = ptn * 4 + (q >> 3);
    bool v = tn < M.ntn;
    if (!v) tn = M.ntn - 1;
    return v;
  }
  int item = M.bid + it * M.G;
  bool v = item < M.ntm * M.ntn;
  if (!v) item = M.ntm * M.ntn - 1;
  tm = item / M.ntn; tn = item - tm * M.ntn;
  return v;
}
DEVI void gemm_gload(u32x4 (&RA)[4], u32x4 (&RB)[4], GemmCursor& L, const GemmMap& M, const u16* A, int lda, const u16* Bt,
                     int K, int nk, int lrow, int lkc, int tpr) {
#pragma unroll
  for (int i = 0; i < 4; ++i) {
    RA[i] = *reinterpret_cast<const u32x4*>(L.ap + (size_t)(32 * i) * lda);
    RB[i] = *reinterpret_cast<const u32x4*>(L.bp + (size_t)(32 * i) * K);
  }
  L.ap += 64; L.bp += 64;
  if (++L.kt == nk) {
    L.kt = 0;
    if (L.it + 1 < M.ni) L.it += 1;
    int tm_, tn_;
    gemm_map(M, L.it, tm_, tn_);
    L.ap = A + ((size_t)gemm_T(tm_, tpr) * 128 + lrow) * lda + lkc * 8;
    L.bp = Bt + ((size_t)tn_ * 128 + lrow) * K + lkc * 8;
  }
}
DEVI void gemm_sstore(const u32x4 (&RA)[4], const u32x4 (&RB)[4], char* As, char* Bs, const int (&soff)[4]) {
#pragma unroll
  for (int i = 0; i < 4; ++i) {
    *reinterpret_cast<u32x4*>(As + soff[i]) = RA[i];
    *reinterpret_cast<u32x4*>(Bs + soff[i]) = RB[i];
  }
}
DEVI void gemm_frags(bf16x8 (&a_)[2][4], bf16x8 (&b_)[2][4], const char* As, const char* Bs, const int (&aoff)[2],
                     const int (&boff)[2]) {
#pragma unroll
  for (int ks = 0; ks < 2; ++ks) {
#pragma unroll
    for (int m = 0; m < 4; ++m) a_[ks][m] = *reinterpret_cast<const bf16x8*>(As + aoff[ks] + m * 256);
#pragma unroll
    for (int n = 0; n < 4; ++n) b_[ks][n] = *reinterpret_cast<const bf16x8*>(Bs + boff[ks] + n * 256);
  }
}
template <int KS>
DEVI void gemm_mfma(f32x4 (&acc)[4][4], const bf16x8 (&a_)[2][4], const bf16x8 (&b_)[2][4]) {
  __builtin_amdgcn_s_setprio(1);
#pragma unroll
  for (int m = 0; m < 4; ++m)
#pragma unroll
    for (int n = 0; n < 4; ++n)
      acc[m][n] = __builtin_amdgcn_mfma_f32_16x16x32_bf16(a_[KS][m], b_[KS][n], acc[m][n], 0, 0, 0);
  __builtin_amdgcn_s_setprio(0);
}

template <int MODE>
__device__ void phase_gemm(const u16* __restrict__ A, int lda, const u16* __restrict__ Bt, int K, int ntm, int ntn,
                           int nvalid, const float* rowscale, u16* outb, int ldo, int tpr,
                           const float* ssqk, char* smem) {
  char* As = smem;
  char* Bs = smem + 32768;
  float* rsv = (float*)(smem + 65536);
  const int tid = otid(), lane = tid & 63, wid = tid >> 6, wr = wid >> 1, wc = wid & 1;
  const int fr = lane & 15, fq = lane >> 4;
  u16* Cw = (u16*)(smem + 66048) + wid * (16 * 72);
  const int lrow = tid >> 3, lkc = tid & 7;
  const int nk = K / 64;
  GemmMap M;
  M.bid = obid(); M.G = gridDim.x; M.ntm = ntm; M.ntn = ntn; M.ntnp = (ntn + 3) >> 2;
  M.swz = (M.G == 512 && ntm == 128) ? 1 : 0;
  if (M.swz && ((ntn + 7) >> 3) * 2 == M.ntnp) { M.swz = 2; M.ntnp = (ntn + 7) >> 3; }
  M.ni = (M.swz == 2) ? 2 * M.ntnp : (M.swz ? M.ntnp : (ntm * ntn + M.G - 1) / M.G);
  const int S = M.ni * nk;
  int soff[4];
#pragma unroll
  for (int i = 0; i < 4; ++i) soff[i] = lkc * 2048 + (((lrow + 32 * i) ^ lkc) * 16);
  int aoff[2], boff[2];
#pragma unroll
  for (int ks = 0; ks < 2; ++ks) {
    int kc = ks * 4 + fq;
    aoff[ks] = kc * 2048 + ((wr * 64 + (fr ^ kc)) * 16);
    boff[ks] = kc * 2048 + ((wc * 64 + (fr ^ kc)) * 16);
  }
  GemmCursor L;
  L.it = 0; L.kt = 0;
  {
    int tm, tn;
    gemm_map(M, 0, tm, tn);
    L.ap = A + ((size_t)gemm_T(tm, tpr) * 128 + lrow) * lda + lkc * 8;
    L.bp = Bt + ((size_t)tn * 128 + lrow) * K + lkc * 8;
  }
  u32x4 r0a[4], r0b[4], r1a[4], r1b[4];
  f32x4 acc[4][4];
#define GLOAD(RA, RB) gemm_gload(RA, RB, L, M, A, lda, Bt, K, nk, lrow, lkc, tpr)
#define SSTORE(RA, RB, BUF) gemm_sstore(RA, RB, As + (BUF) * 16384, Bs + (BUF) * 16384, soff)
#define FRAGS(BUF) gemm_frags(fa, fb, As + (BUF) * 16384, Bs + (BUF) * 16384, aoff, boff)
#define MFMAS(KS) gemm_mfma<KS>(acc, fa, fb)
  bf16x8 fa[2][4], fb[2][4];
  int cit = 0, ckt = 0;
  float rs_reg = 0.f;
  GLOAD(r0a, r0b);
  GLOAD(r1a, r1b);
  SSTORE(r0a, r0b, 0);
  __syncthreads();
  for (int s = 0; s < S; s += 2) {
    FRAGS(0);
    if (ckt == 0) {
#pragma unroll
      for (int m = 0; m < 4; ++m)
#pragma unroll
        for (int n = 0; n < 4; ++n) acc[m][n] = f32x4{0.f, 0.f, 0.f, 0.f};
      if (MODE == 0 && tid < 128) {
        int tmr_, tn_;
        gemm_map(M, cit, tmr_, tn_);
        rs_reg = rowscale[(size_t)gemm_T(tmr_, tpr) * 128 + tid];
      }
      if (MODE == 1 && ssqk != nullptr && tid < 128) {
        int tmr_, tn_;
        gemm_map(M, cit, tmr_, tn_);
        const int tm = gemm_T(tmr_, tpr);
        const float* q = ssqk + ((size_t)tm * 128 + tid) * 16;
        float t = 0.f;
#pragma unroll
        for (int i = 0; i < 16; ++i) t += q[i];
        rsv[tid] = rsqrtf(t * (1.f / 1024.f) + EPS);
      }
    }
    if (MODE == 0 && ckt == 2 && tid < 128) rsv[tid] = rs_reg;
    if (MODE == 1 && ssqk != nullptr && ckt == 16) {
#pragma unroll
      for (int m = 0; m < 4; ++m)
#pragma unroll
        for (int j = 0; j < 4; ++j) {
          float sc = rsv[wr * 64 + m * 16 + fq * 4 + j];
#pragma unroll
          for (int n = 0; n < 4; ++n) acc[m][n][j] *= sc;
        }
    }
    SSTORE(r1a, r1b, 1);
    MFMAS(0);
    MFMAS(1);
    GLOAD(r0a, r0b);
    __syncthreads();
    FRAGS(1);
    SSTORE(r0a, r0b, 0);
    MFMAS(0);
    MFMAS(1);
    GLOAD(r1a, r1b);
    ckt += 2;
    if (ckt == nk) {
      int tmr, tn;
      const bool valid = gemm_map(M, cit, tmr, tn);
      const int tm = gemm_T(tmr, tpr);
      if (!valid) {
      } else if (MODE == 0) {
#pragma unroll
        for (int m = 0; m < 4; ++m) {
#pragma unroll
          for (int j = 0; j < 4; ++j) {
            float sc = rsv[wr * 64 + m * 16 + fq * 4 + j];
#pragma unroll
            for (int n = 0; n < 4; ++n) Cw[(fq * 4 + j) * 72 + n * 16 + fr] = f2bf(acc[m][n][j] * sc);
          }
#pragma unroll
          for (int i = 0; i < 2; ++i) {
            int c = lane + 64 * i, row = c >> 3, ch = c & 7;
            int col = tn * 128 + wc * 64 + ch * 8;
            uint4 v = *reinterpret_cast<const uint4*>(Cw + row * 72 + ch * 8);
            if (col < nvalid)
              *reinterpret_cast<uint4*>(outb + ((size_t)tm * 128 + wr * 64 + m * 16 + row) * ldo + col) = v;
          }
        }
      } else {
#pragma unroll
        for (int m = 0; m < 4; ++m) {
#pragma unroll
          for (int j = 0; j < 4; ++j) {
#pragma unroll
            for (int n = 0; n < 4; ++n) Cw[(fq * 4 + j) * 72 + n * 16 + fr] = f2bf(acc[m][n][j]);
          }
#pragma unroll
          for (int i = 0; i < 2; ++i) {
            int c = lane + 64 * i, row = c >> 3, ch = c & 7;
            int col = tn * 128 + wc * 64 + ch * 8;
            uint4 v = *reinterpret_cast<const uint4*>(Cw + row * 72 + ch * 8);
            *reinterpret_cast<uint4*>(outb + ((size_t)tm * 128 + wr * 64 + m * 16 + row) * ldo + col) = v;
          }
        }
      }
      cit += 1; ckt = 0;
    }
    __syncthreads();
  }
#undef GLOAD
#undef SSTORE
#undef FRAGS
#undef MFMAS
}

template <int MODE>
__device__ void phase_gemm_w(const u16* __restrict__ A, int lda, const u16* __restrict__ Bt, int K, int ntm, int ntn,
                             int nvalid, const float* rowscale, u16* outb, int ldo, int tpr,
                             const float* ssqk, char* smem) {
  char* As = smem;
  char* Bs = smem + 16384;
  float* rsv = (float*)(smem + 49152);
  const int tid = otid(), lane = tid & 63, wid = tid >> 6, wr = wid >> 1, wc = wid & 1;
  const int fr = lane & 15, fq = lane >> 4;
  u16* Cw = (u16*)(smem + 49664) + wid * (16 * 136);
  const int lrow = tid >> 2, lkc = tid & 3;
  const int nk = K / 32;
  GemmMap M;
  M.bid = obid(); M.G = gridDim.x; M.ntm = ntm; M.ntn = ntn; M.ntnp = (ntn + 3) >> 2;
  M.swz = (M.G == 512 && ntm == 128) ? 1 : 0;
  M.ni = M.swz ? M.ntnp : (ntm * ntn + M.G - 1) / M.G;
  const int S = M.ni * nk;
  const int sa0 = lkc * 2048 + ((lrow ^ (lkc << 1)) * 16);
  const int sb0 = lkc * 4096 + ((lrow ^ (lkc << 1)) * 16);
  const int aoff = fq * 2048 + ((wr * 64 + (fr ^ (fq << 1))) * 16);
  const int boff = fq * 4096 + ((wc * 128 + (fr ^ (fq << 1))) * 16);
  int lit = 0, lkt = 0;
  const u16* ap; const u16* bp;
  {
    int tm, tn;
    gemm_map(M, 0, tm, tn);
    ap = A + ((size_t)gemm_T(tm, tpr) * 128 + lrow) * lda + lkc * 8;
    bp = Bt + ((size_t)tn * 256 + lrow) * K + lkc * 8;
  }
  u32x4 ra[2], rb[4];
  f32x4 acc[4][8];
  bf16x8 fa[4], fb[8];
  auto gload = [&]() __attribute__((always_inline)) {
#pragma unroll
    for (int i = 0; i < 2; ++i) ra[i] = *reinterpret_cast<const u32x4*>(ap + (size_t)(64 * i) * lda);
#pragma unroll
    for (int i = 0; i < 4; ++i) rb[i] = *reinterpret_cast<const u32x4*>(bp + (size_t)(64 * i) * K);
    ap += 32; bp += 32;
    if (++lkt == nk) {
      lkt = 0;
      if (lit + 1 < M.ni) lit += 1;
      int tm_, tn_;
      gemm_map(M, lit, tm_, tn_);
      ap = A + ((size_t)gemm_T(tm_, tpr) * 128 + lrow) * lda + lkc * 8;
      bp = Bt + ((size_t)tn_ * 256 + lrow) * K + lkc * 8;
    }
  };
  auto sstore = [&](int buf) __attribute__((always_inline)) {
#pragma unroll
    for (int i = 0; i < 2; ++i) *reinterpret_cast<u32x4*>(As + buf * 8192 + sa0 + i * 1024) = ra[i];
#pragma unroll
    for (int i = 0; i < 4; ++i) *reinterpret_cast<u32x4*>(Bs + buf * 16384 + sb0 + i * 1024) = rb[i];
  };
  auto frags = [&](int buf) __attribute__((always_inline)) {
#pragma unroll
    for (int m = 0; m < 4; ++m) fa[m] = *reinterpret_cast<const bf16x8*>(As + buf * 8192 + aoff + m * 256);
#pragma unroll
    for (int n = 0; n < 8; ++n) fb[n] = *reinterpret_cast<const bf16x8*>(Bs + buf * 16384 + boff + n * 256);
  };
  auto mfmas = [&]() __attribute__((always_inline)) {
    __builtin_amdgcn_s_setprio(1);
#pragma unroll
    for (int m = 0; m < 4; ++m)
#pragma unroll
      for (int n = 0; n < 8; ++n) acc[m][n] = __builtin_amdgcn_mfma_f32_16x16x32_bf16(fa[m], fb[n], acc[m][n], 0, 0, 0);
    __builtin_amdgcn_s_setprio(0);
  };
  int cit = 0, ckt = 0;
  float rs_reg = 0.f;
  gload();
  sstore(0);
  gload();
  __syncthreads();
  for (int s = 0; s < S; s += 2) {
    frags(0);
    if (ckt == 0) {
#pragma unroll
      for (int m = 0; m < 4; ++m)
#pragma unroll
        for (int n = 0; n < 8; ++n) acc[m][n] = f32x4{0.f, 0.f, 0.f, 0.f};
      if (tid < 128) {
        int tmr_, tn_;
        gemm_map(M, cit, tmr_, tn_);
        const size_t R = (size_t)gemm_T(tmr_, tpr) * 128 + tid;
        if (MODE == 0) rs_reg = rowscale[R];
        if (MODE == 1 && ssqk != nullptr) {
          const float* q = ssqk + R * 16;
          float t = 0.f;
#pragma unroll
          for (int i = 0; i < 16; ++i) t += q[i];
          rsv[tid] = rsqrtf(t * (1.f / 1024.f) + EPS);
        }
      }
    }
    if (MODE == 0 && ckt == 2 && tid < 128) rsv[tid] = rs_reg;
    if (MODE == 1 && ssqk != nullptr && ckt == 32) {
#pragma unroll
      for (int m = 0; m < 4; ++m)
#pragma unroll
        for (int j = 0; j < 4; ++j) {
          float sc = rsv[wr * 64 + m * 16 + fq * 4 + j];
#pragma unroll
          for (int n = 0; n < 8; ++n) acc[m][n][j] *= sc;
        }
    }
    sstore(1);
    mfmas();
    gload();
    __syncthreads();
    frags(1);
    sstore(0);
    mfmas();
    gload();
    ckt += 2;
    if (ckt == nk) {
      int tmr, tn;
      const bool valid = gemm_map(M, cit, tmr, tn);
      const int tm = gemm_T(tmr, tpr);
      if (valid) {
#pragma unroll
        for (int m = 0; m < 4; ++m) {
#pragma unroll
          for (int j = 0; j < 4; ++j) {
            float sc = 1.f;
            if (MODE == 0) sc = rsv[wr * 64 + m * 16 + fq * 4 + j];
#pragma unroll
            for (int n = 0; n < 8; ++n) Cw[(fq * 4 + j) * 136 + n * 16 + fr] = f2bf(acc[m][n][j] * sc);
          }
#pragma unroll
          for (int i = 0; i < 4; ++i) {
            int c = lane + 64 * i, row = c >> 4, ch = c & 15;
            int col = tn * 256 + wc * 128 + ch * 8;
            uint4 v = *reinterpret_cast<const uint4*>(Cw + row * 136 + ch * 8);
            if (col < nvalid)
              *reinterpret_cast<uint4*>(outb + ((size_t)tm * 128 + wr * 64 + m * 16 + row) * ldo + col) = v;
          }
        }
      }
      cit += 1; ckt = 0;
    }
    __syncthreads();
  }
}

template <int MODE, int BATCH>
DEVI void gemm_meta_items(const u16* __restrict__ A, int lda, const u16* __restrict__ Bt, int K, int tps, int nn16,
                          const float* rowscale, u16* outb, int ldo, const float* ssqk, int wid, int fr, int fq) {
  const int G = gridDim.x, bid = obid();
  const size_t R0 = (size_t)wid * tps * 128;
  const u16* ap = A + (R0 + fr) * lda + fq * 8;
  const int nks = K / 32;
  for (int it = G - 1 - bid; it < nn16; it += G) {
    const u16* bp = Bt + ((size_t)it * 16 + fr) * K + fq * 8;
    f32x4 acc = f32x4{0.f, 0.f, 0.f, 0.f};
    for (int ks0 = 0; ks0 < nks; ks0 += BATCH) {
      bf16x8 a[BATCH], b[BATCH];
#pragma unroll
      for (int i = 0; i < BATCH; ++i) {
        a[i] = *reinterpret_cast<const bf16x8*>(ap + (ks0 + i) * 32);
        b[i] = *reinterpret_cast<const bf16x8*>(bp + (ks0 + i) * 32);
      }
      if (MODE == 1 && ssqk != nullptr && ks0 == 32) {
#pragma unroll
        for (int j = 0; j < 4; ++j) {
          const float* q = ssqk + (R0 + fq * 4 + j) * 16;
          float t = 0.f;
#pragma unroll
          for (int i = 0; i < 16; ++i) t += q[i];
          acc[j] *= rsqrtf(t * (1.f / 1024.f) + EPS);
        }
      }
#pragma unroll
      for (int i = 0; i < BATCH; ++i) acc = __builtin_amdgcn_mfma_f32_16x16x32_bf16(a[i], b[i], acc, 0, 0, 0);
    }
#pragma unroll
    for (int j = 0; j < 4; ++j) {
      size_t R = R0 + fq * 4 + j;
      float v = acc[j];
      if (MODE == 0) v *= rowscale[R];
      outb[R * ldo + it * 16 + fr] = f2bf(v);
    }
  }
}
template <int MODE>
__device__ void phase_gemm_meta(const u16* __restrict__ A, int lda, const u16* __restrict__ Bt, int K, int nseq, int tps,
                                int nn16, const float* rowscale, u16* outb, int ldo, const float* ssqk) {
  const int tid = otid(), lane = tid & 63, wid = tid >> 6, fr = lane & 15, fq = lane >> 4;
  if (wid >= nseq) return;
  if (((K / 32) & 15) == 0) gemm_meta_items<MODE, 16>(A, lda, Bt, K, tps, nn16, rowscale, outb, ldo, ssqk, wid, fr, fq);
  else gemm_meta_items<MODE, 11>(A, lda, Bt, K, tps, nn16, rowscale, outb, ldo, ssqk, wid, fr, fq);
}

__device__ void phase_conv(const Params& p, int g, int layer) {
  int nseq, tps, seq0; ginfo(g, nseq, tps, seq0);
  const int ntiles = nseq * tps;
  const int L = (tps - 1) * 128 + 16;
  const u16* u = (const u16*)(p.ws + OFF_U);
  u16* xc = (u16*)(p.ws + OFF_XC);
  float* dtb = (float*)(p.ws + OFF_DT);
  const float* cw = p.conv_w + (size_t)layer * 5 * 1536;
  const float* cb = p.conv_b + (size_t)layer * 1536;
  const int total = ntiles * 8 * 192;
  for (int id = obid() * 256 + otid(); id < total; id += gridDim.x * 256) {
    const int ch = id % 192, ts = id / 192, seg = ts & 7, T = ts >> 3;
    const int sl = T / tps, c = T - sl * tps;
    const int col = ch * 8;
    const size_t Rseq = (size_t)sl * tps * 128;
    u16* orow = xc + ((size_t)T * 128 + seg * 16) * 1536 + col;
    const int nvalid = (c > 0) ? 16 : (seg == 0 ? 16 : 0);
    if (nvalid == 0) {
      uint4 z = make_uint4(0, 0, 0, 0);
#pragma unroll 4
      for (int r = 0; r < 16; ++r) *reinterpret_cast<uint4*>(orow + (size_t)r * 1536) = z;
      continue;
    }
    const int pos0 = (c == 0) ? 0 : 16 + (c - 1) * 128 + seg * 16;
    float w[5][8], bias[8];
#pragma unroll
    for (int j = 0; j < 5; ++j) {
      float4 w0 = *reinterpret_cast<const float4*>(cw + j * 1536 + col), w1 = *reinterpret_cast<const float4*>(cw + j * 1536 + col + 4);
      w[j][0] = w0.x; w[j][1] = w0.y; w[j][2] = w0.z; w[j][3] = w0.w; w[j][4] = w1.x; w[j][5] = w1.y; w[j][6] = w1.z; w[j][7] = w1.w;
    }
    {
      float4 b0 = *reinterpret_cast<const float4*>(cb + col), b1 = *reinterpret_cast<const float4*>(cb + col + 4);
      bias[0] = b0.x; bias[1] = b0.y; bias[2] = b0.z; bias[3] = b0.w; bias[4] = b1.x; bias[5] = b1.y; bias[6] = b1.z; bias[7] = b1.w;
    }
    float win[5][8];
    auto ldrow = [&](int pp, float* dst) {
      const bool ok = (pp >= 0) && (pp < L);
      const int pc = min(max(pp, 0), L - 1);
      const int prow = (pc < 16) ? pc : 112 + pc;
      uint4 v = *reinterpret_cast<const uint4*>(u + (Rseq + prow) * DIN + C_XBC + col);
      if (!ok) v = make_uint4(0, 0, 0, 0);
      unpack8(v, dst);
    };
    ldrow(pos0 - 2, win[0]); ldrow(pos0 - 1, win[1]); ldrow(pos0, win[2]); ldrow(pos0 + 1, win[3]);
#pragma unroll
    for (int r = 0; r < 16; ++r) {
      ldrow(pos0 + r + 2, win[(r + 4) % 5]);
      float acc[8];
#pragma unroll
      for (int i = 0; i < 8; ++i) {
        float a = bias[i];
#pragma unroll
        for (int j = 0; j < 5; ++j) a += win[(r + j) % 5][i] * w[j][i];
        acc[i] = silu_f(a);
      }
      *reinterpret_cast<uint4*>(orow + (size_t)r * 1536) = pack8(acc);
    }
  }
  const int nrows = ntiles * 128;
  for (int id = obid() * 256 + otid(); id < nrows * 4; id += gridDim.x * 256) {
    const int R = id >> 2, h0 = (id & 3) * 8;
    const int T = R >> 7, r = R & 127, sl = T / tps, c = T - sl * tps;
    const bool valid = (c > 0) || (r < 16);
    float o[8];
    uint4 v = *reinterpret_cast<const uint4*>(u + (size_t)R * DIN + C_DT + h0);
    float f[8]; unpack8(v, f);
#pragma unroll
    for (int i = 0; i < 8; ++i) {
      float x = f[i] + p.dt_bias[layer * 32 + h0 + i];
      float sp = (x > 20.f) ? x : log1pf(__expf(x));
      o[i] = valid ? sp : 0.f;
    }
    *reinterpret_cast<float4*>(dtb + (size_t)R * 32 + h0) = make_float4(o[0], o[1], o[2], o[3]);
    *reinterpret_cast<float4*>(dtb + (size_t)R * 32 + h0 + 4) = make_float4(o[4], o[5], o[6], o[7]);
  }
}

DEVI void ssd_cumsums(const float* dt, size_t R0, int hd, float Af, float Ab, float* acsf, float* rcs, float* dtf,
                      float* dtbk, int tid_) {
  const int lane = tid_ & 63, wid = tid_ >> 6;
  if (wid < 2) {
    const int dir = wid;
    float d0 = dt[(R0 + 2 * lane) * 32 + dir * 16 + hd], d1 = dt[(R0 + 2 * lane + 1) * 32 + dir * 16 + hd];
    float A_ = dir ? Ab : Af;
    float a0 = d0 * A_, a1 = d1 * A_;
    float s = a0 + a1, inc = s;
#pragma unroll
    for (int o = 1; o < 64; o <<= 1) {
      float t = __shfl_up(inc, o);
      if (lane >= o) inc += t;
    }
    float excl = inc - s;
    if (dir == 0) {
      acsf[2 * lane] = excl + a0; acsf[2 * lane + 1] = inc;
      dtf[2 * lane] = d0; dtf[2 * lane + 1] = d1;
    } else {
      float tot = __shfl(inc, 63);
      rcs[2 * lane] = tot - excl; rcs[2 * lane + 1] = tot - (excl + a0);
      dtbk[2 * lane] = d0; dtbk[2 * lane + 1] = d1;
    }
  }
}

__device__ void phase_ssdA(const Params& p, int g, int layer, char* smem) {
  int nseq, tps, seq0; ginfo(g, nseq, tps, seq0);
  const int ntiles = nseq * tps;
  u16* Bt = (u16*)smem;
  u16* Xt = Bt + 128 * 136;
  float* arr = (float*)(Xt + 64 * 136);
  float *acsf = arr, *rcs = arr + 128, *dtf = arr + 256, *dtbk = arr + 384;
  const int tid = otid(), lane = tid & 63, wid = tid >> 6, fr = lane & 15, fq = lane >> 4;
  const u16* xc = (const u16*)(p.ws + OFF_XC);
  const float* dt = (const float*)(p.ws + OFF_DT);
  u16* st = (u16*)(p.ws + OFF_ST);
  float* dec = (float*)(p.ws + OFF_DEC);
  for (int item = obid(); item < ntiles * 16; item += gridDim.x) {
    const int T = item >> 4, hd = item & 15, grp = hd >> 3;
    const size_t R0 = (size_t)T * 128;
    const float Af = -1.4426950408889634f * __expf(p.a_log[layer * 32 + hd]), Ab = -1.4426950408889634f * __expf(p.a_log[layer * 32 + 16 + hd]);
    ssd_cumsums(dt, R0, hd, Af, Ab, acsf, rcs, dtf, dtbk, tid);
    for (int id = tid; id < 128 * 16; id += 256) {
      int l = id & 127, ch = id >> 7;
      uint4 v = *reinterpret_cast<const uint4*>(xc + (R0 + l) * 1536 + 1024 + grp * 128 + ch * 8);
      u16* d = Bt + (ch * 8) * 136 + l;
      d[0 * 136] = (u16)(v.x & 0xffff); d[1 * 136] = (u16)(v.x >> 16);
      d[2 * 136] = (u16)(v.y & 0xffff); d[3 * 136] = (u16)(v.y >> 16);
      d[4 * 136] = (u16)(v.z & 0xffff); d[5 * 136] = (u16)(v.z >> 16);
      d[6 * 136] = (u16)(v.w & 0xffff); d[7 * 136] = (u16)(v.w >> 16);
    }
    __syncthreads();
#pragma unroll 1
    for (int dir = 0; dir < 2; ++dir) {
      const float ref = dir ? rcs[0] : acsf[127];
      for (int id = tid; id < 128 * 8; id += 256) {
        int l = id & 127, ch = id >> 7;
        uint4 v = *reinterpret_cast<const uint4*>(xc + (R0 + l) * 1536 + hd * 64 + ch * 8);
        float f[8]; unpack8(v, f);
        float w = dir ? dtbk[l] * __builtin_amdgcn_exp2f(ref - rcs[l]) : dtf[l] * __builtin_amdgcn_exp2f(ref - acsf[l]);
        u16* d = Xt + (ch * 8) * 136 + l;
#pragma unroll
        for (int i = 0; i < 8; ++i) d[i * 136] = f2bf(f[i] * w);
      }
      __syncthreads();
      f32x4 acc[4][2];
#pragma unroll
      for (int m = 0; m < 4; ++m)
#pragma unroll
        for (int n = 0; n < 2; ++n) acc[m][n] = f32x4{0.f, 0.f, 0.f, 0.f};
      wave_mma<4, 2, 4>(acc, Xt, 136, 16 * 136, Bt + (wid * 32) * 136, 136, 16 * 136, lane);
      u16* so = st + ((size_t)(T * 16 + hd) * 2 + dir) * 8192;
#pragma unroll
      for (int m = 0; m < 4; ++m)
#pragma unroll
        for (int n = 0; n < 2; ++n)
#pragma unroll
          for (int j = 0; j < 4; ++j) so[(16 * m + fq * 4 + j) * 128 + wid * 32 + 16 * n + fr] = f2bf(acc[m][n][j]);
      __syncthreads();
    }
    if (tid == 0) {
      dec[(size_t)(T * 16 + hd) * 2] = __builtin_amdgcn_exp2f(acsf[127]);
      dec[(size_t)(T * 16 + hd) * 2 + 1] = __builtin_amdgcn_exp2f(rcs[0]);
    }
    __syncthreads();
  }
}

__device__ void phase_scan(const Params& p, int g) {
  int nseq, tps, seq0; ginfo(g, nseq, tps, seq0);
  u16* st = (u16*)(p.ws + OFF_ST);
  const float* dec = (const float*)(p.ws + OFF_DEC);
  const int total = nseq * 32 * 4096;
  for (int i = obid() * 256 + otid(); i < total; i += gridDim.x * 256) {
    const int e2 = i & 4095, chn = i >> 12, dir = chn & 1, hd = (chn >> 1) & 15, sl = chn >> 5;
    float r0 = 0.f, r1 = 0.f;
    for (int cc = 0; cc < tps; cc += 16) {
      unsigned v[16]; float dc[16];
#pragma unroll
      for (int q = 0; q < 16; ++q) {
        const int c = min(cc + q, tps - 1);
        const int ct = dir ? (tps - 1 - c) : c;
        const size_t idx = ((size_t)(sl * tps + ct) * 16 + hd) * 2 + dir;
        v[q] = *reinterpret_cast<const unsigned*>(st + idx * 8192 + e2 * 2);
        dc[q] = dec[idx];
      }
#pragma unroll
      for (int q = 0; q < 16; ++q) {
        int c = cc + q;
        if (c < tps) {
          int ct = dir ? (tps - 1 - c) : c;
          size_t idx = ((size_t)(sl * tps + ct) * 16 + hd) * 2 + dir;
          float s0 = __uint_as_float(v[q] << 16), s1 = __uint_as_float(v[q] & 0xffff0000u);
          *reinterpret_cast<unsigned*>(st + idx * 8192 + e2 * 2) = pack2(r0, r1);
          r0 = dc[q] * r0 + s0; r1 = dc[q] * r1 + s1;
        }
      }
    }
  }
}

__device__ void phase_ssdC(const Params& p, int g, int layer, char* smem) {
  int nseq, tps, seq0; ginfo(g, nseq, tps, seq0);
  const int ntiles = nseq * tps;
  u16* R0b = (u16*)smem;
  u16* R1b = R0b + 128 * 136;
  float* arr = (float*)(R1b + 128 * 136);
  float *acsf = arr, *rcs = arr + 128, *dtf = arr + 256, *dtbk = arr + 384;
  const int tid = otid(), lane = tid & 63, wid = tid >> 6, fr = lane & 15, fq = lane >> 4;
  const u16* xc = (const u16*)(p.ws + OFF_XC);
  const u16* u = (const u16*)(p.ws + OFF_U);
  const float* dt = (const float*)(p.ws + OFF_DT);
  const u16* st = (const u16*)(p.ws + OFF_ST);
  u16* ymix = (u16*)(p.ws + OFF_YMIX);
  float* ssqa = (float*)(p.ws + OFF_SSQA);
  for (int item = obid(); item < ntiles * 16; item += gridDim.x) {
    const int T = item >> 4, hd = item & 15, grp = hd >> 3;
    const size_t Rb = (size_t)T * 128;
    const float Af = -1.4426950408889634f * __expf(p.a_log[layer * 32 + hd]), Ab = -1.4426950408889634f * __expf(p.a_log[layer * 32 + 16 + hd]);
    const float Dh = p.ssd_d[layer * 16 + hd];
    ssd_cumsums(dt, Rb, hd, Af, Ab, acsf, rcs, dtf, dtbk, tid);
    for (int id = tid; id < 128 * 16; id += 256) {
      int l = id >> 4, ch = id & 15;
      const u16* s = xc + (Rb + l) * 1536 + 1024 + grp * 128 + ch * 8;
      *reinterpret_cast<uint4*>(R1b + l * 136 + ch * 8) = *reinterpret_cast<const uint4*>(s);
      *reinterpret_cast<uint4*>(R0b + l * 136 + ch * 8) = *reinterpret_cast<const uint4*>(s + 256);
    }
    __syncthreads();
    f32x4 cb[2][8];
#pragma unroll
    for (int m = 0; m < 2; ++m)
#pragma unroll
      for (int n = 0; n < 8; ++n) cb[m][n] = f32x4{0.f, 0.f, 0.f, 0.f};
    wave_mma<2, 8, 4>(cb, R0b + (wid * 32) * 136, 136, 16 * 136, R1b, 136, 16 * 136, lane);
    __syncthreads();
    for (int id = tid; id < 2 * 64 * 16; id += 256) {
      int d = id >> 10, pp = (id >> 4) & 63, ch = id & 15;
      *reinterpret_cast<uint4*>(R1b + (d * 64 + pp) * 136 + ch * 8) =
          *reinterpret_cast<const uint4*>(st + ((size_t)(T * 16 + hd) * 2 + d) * 8192 + pp * 128 + ch * 8);
    }
    __syncthreads();
    f32x4 y[2][4];
    {
      f32x4 yf[2][4], yb[2][4];
#pragma unroll
      for (int m = 0; m < 2; ++m)
#pragma unroll
        for (int n = 0; n < 4; ++n) { yf[m][n] = f32x4{0.f, 0.f, 0.f, 0.f}; yb[m][n] = f32x4{0.f, 0.f, 0.f, 0.f}; }
      {
        const u16* ap_ = R0b + (wid * 32 + fr) * 136 + fq * 8;
        const u16* bp_ = R1b + fr * 136 + fq * 8;
#pragma unroll
        for (int ks = 0; ks < 4; ++ks) {
          bf16x8 a_[2], f_[4], b_[4];
#pragma unroll
          for (int m = 0; m < 2; ++m) a_[m] = *reinterpret_cast<const bf16x8*>(ap_ + m * 16 * 136 + ks * 32);
#pragma unroll
          for (int n = 0; n < 4; ++n) {
            f_[n] = *reinterpret_cast<const bf16x8*>(bp_ + n * 16 * 136 + ks * 32);
            b_[n] = *reinterpret_cast<const bf16x8*>(bp_ + (64 + n * 16) * 136 + ks * 32);
          }
          __builtin_amdgcn_s_setprio(1);
#pragma unroll
          for (int m = 0; m < 2; ++m)
#pragma unroll
            for (int n = 0; n < 4; ++n) {
              yf[m][n] = __builtin_amdgcn_mfma_f32_16x16x32_bf16(a_[m], f_[n], yf[m][n], 0, 0, 0);
              yb[m][n] = __builtin_amdgcn_mfma_f32_16x16x32_bf16(a_[m], b_[n], yb[m][n], 0, 0, 0);
            }
          __builtin_amdgcn_s_setprio(0);
        }
      }
#pragma unroll
      for (int m = 0; m < 2; ++m)
#pragma unroll
        for (int j = 0; j < 4; ++j) {
          int l = wid * 32 + 16 * m + fq * 4 + j;
          float ef = __builtin_amdgcn_exp2f(acsf[l]), eb = __builtin_amdgcn_exp2f(rcs[l]);
#pragma unroll
          for (int n = 0; n < 4; ++n) y[m][n][j] = ef * yf[m][n][j] + eb * yb[m][n][j];
        }
    }
    __syncthreads();
    int frv = fr, lbase = wid * 32 + fq * 4;
    asm volatile("" : "+v"(frv), "+v"(lbase));
#pragma unroll
    for (int m = 0; m < 2; ++m) {
      float afl[4], rbl[4];
#pragma unroll
      for (int j = 0; j < 4; ++j) { afl[j] = acsf[lbase + 16 * m + j]; rbl[j] = rcs[lbase + 16 * m + j]; }
#pragma unroll
      for (int n = 0; n < 8; ++n) {
        const int s = 16 * n + frv;
        const int rel = 16 * n - (wid * 32 + 16 * m);
        if (rel < 0) {
          const float as_ = acsf[s], dfs = dtf[s];
#pragma unroll
          for (int j = 0; j < 4; ++j)
            R0b[(lbase + 16 * m + j) * 136 + s] = f2bf(cb[m][n][j] * (__builtin_amdgcn_exp2f(afl[j] - as_) * dfs));
        } else if (rel > 0) {
          const float rs_ = rcs[s], dbs = dtbk[s];
#pragma unroll
          for (int j = 0; j < 4; ++j)
            R0b[(lbase + 16 * m + j) * 136 + s] = f2bf(cb[m][n][j] * (__builtin_amdgcn_exp2f(rbl[j] - rs_) * dbs));
        } else {
          const float as_ = acsf[s], rs_ = rcs[s], dfs = dtf[s], dbs = dtbk[s];
#pragma unroll
          for (int j = 0; j < 4; ++j) {
            const int l = lbase + 16 * m + j;
            float gsum = 0.f;
            if (s <= l) gsum += __builtin_amdgcn_exp2f(afl[j] - as_) * dfs;
            if (s >= l) gsum += __builtin_amdgcn_exp2f(rbl[j] - rs_) * dbs;
            float val = cb[m][n][j] * gsum + ((s == l) ? Dh : 0.f);
            R0b[l * 136 + s] = f2bf(val);
          }
        }
      }
    }
    for (int id = tid; id < 128 * 8; id += 256) {
      int l = id & 127, ch = id >> 7;
      uint4 v = *reinterpret_cast<const uint4*>(xc + (Rb + l) * 1536 + hd * 64 + ch * 8);
      u16* d = R1b + (ch * 8) * 136 + l;
      d[0 * 136] = (u16)(v.x & 0xffff); d[1 * 136] = (u16)(v.x >> 16);
      d[2 * 136] = (u16)(v.y & 0xffff); d[3 * 136] = (u16)(v.y >> 16);
      d[4 * 136] = (u16)(v.z & 0xffff); d[5 * 136] = (u16)(v.z >> 16);
      d[6 * 136] = (u16)(v.w & 0xffff); d[7 * 136] = (u16)(v.w >> 16);
    }
    __syncthreads();
    wave_mma<2, 4, 4>(y, R0b + (wid * 32) * 136, 136, 16 * 136, R1b, 136, 16 * 136, lane);
#pragma unroll
    for (int m = 0; m < 2; ++m)
#pragma unroll
      for (int j = 0; j < 4; ++j) {
        size_t R = Rb + wid * 32 + 16 * m + fq * 4 + j;
        float sq = 0.f;
#pragma unroll
        for (int n = 0; n < 4; ++n) {
          int pc = hd * 64 + 16 * n + fr;
          float z = bf2f(u[R * DIN + pc]);
          float val = y[m][n][j] * silu_f(z);
          sq += val * val;
          ymix[R * DMIX + pc] = f2bf(val);
        }
        sq = red16_sum(sq);
        if (fr == 0) ssqa[R * 16 + hd] = sq;
      }
    __syncthreads();
  }
}

__device__ void phase_rope(const Params& p, int g) {
  int nseq, tps, seq0; ginfo(g, nseq, tps, seq0);
  const int nrows = nseq * tps * 128;
  u16* u = (u16*)(p.ws + OFF_U);
  for (int id = obid() * 256 + otid(); id < nrows * 10; id += gridDim.x * 256) {
    const int R = id / 10, hh = id - R * 10;
    const int T = R >> 7, r = R & 127, sl = T / tps, c = T - sl * tps;
    if (c == 0 && r >= 16) continue;
    const int pos = (c == 0) ? r : 16 + (c - 1) * 128 + r;
    u16* s = u + (size_t)R * DIN + (hh < 8 ? C_WQ + hh * 64 : C_WK + (hh - 8) * 64);
    uint4 v0 = *reinterpret_cast<const uint4*>(s), v1 = *reinterpret_cast<const uint4*>(s + 8);
    float x1[8], x2[8], o1[8], o2[8];
    unpack8(v0, x1); unpack8(v1, x2);
    const float posf = (float)pos;
#pragma unroll
    for (int i = 0; i < 8; ++i) {
      float ang = posf * c_inv[i];
      double rev = (double)ang * 0.15915494309189535;
      rev -= rint(rev);
      float rv = (float)rev;
      float sn = __builtin_amdgcn_sinf(rv), cs = __builtin_amdgcn_cosf(rv);
      o1[i] = x1[i] * cs - x2[i] * sn;
      o2[i] = x2[i] * cs + x1[i] * sn;
    }
    *reinterpret_cast<uint4*>(s) = pack8(o1);
    *reinterpret_cast<uint4*>(s + 8) = pack8(o2);
  }
}

DEVI void kv_prefetch(u32x4 (&pk)[2], u32x4 (&pv)[2], const u16* ksrc, const u16* vsrc, int tid) {
#pragma unroll
  for (int i = 0; i < 2; ++i) {
    int id = tid + i * 256;
    pk[i] = *reinterpret_cast<const u32x4*>(ksrc + (size_t)(id >> 3) * DIN + (id & 7) * 8);
    pv[i] = *reinterpret_cast<const u32x4*>(vsrc + (size_t)(id & 63) * DIN + (id >> 6) * 8);
  }
}
DEVI void kv_commit(const u32x4 (&pk)[2], const u32x4 (&pv)[2], u16* Ks, u16* Vt, int tid) {
#pragma unroll
  for (int i = 0; i < 2; ++i) {
    int id = tid + i * 256;
    *reinterpret_cast<u32x4*>(Ks + (id >> 3) * 72 + (id & 7) * 8) = pk[i];
    u16* d = Vt + ((id >> 6) * 8) * 72 + (id & 63);
    d[0 * 72] = (u16)(pv[i][0] & 0xffff); d[1 * 72] = (u16)(pv[i][0] >> 16);
    d[2 * 72] = (u16)(pv[i][1] & 0xffff); d[3 * 72] = (u16)(pv[i][1] >> 16);
    d[4 * 72] = (u16)(pv[i][2] & 0xffff); d[5 * 72] = (u16)(pv[i][2] >> 16);
    d[6 * 72] = (u16)(pv[i][3] & 0xffff); d[7 * 72] = (u16)(pv[i][3] >> 16);
  }
}
DEVI void stage_rope(u16* dst, const u16* src, int nrows, int pos0, int tid) {
  for (int id = tid; id < nrows * 7; id += 256) {
    int r = id / 7, cz = id - r * 7;
    const u16* s = src + (size_t)r * DIN;
    if (cz > 0) {
      *reinterpret_cast<uint4*>(dst + r * 72 + (cz + 1) * 8) = *reinterpret_cast<const uint4*>(s + (cz + 1) * 8);
    } else {
      uint4 v0 = *reinterpret_cast<const uint4*>(s), v1 = *reinterpret_cast<const uint4*>(s + 8);
      float x1[8], x2[8], o1[8], o2[8];
      unpack8(v0, x1); unpack8(v1, x2);
      float pos = (float)(pos0 + r);
#pragma unroll
      for (int i = 0; i < 8; ++i) {
        float ang = pos * c_inv[i];
        double rev = (double)ang * 0.15915494309189535;
        rev -= rint(rev);
        float rv = (float)rev;
        float sn = __builtin_amdgcn_sinf(rv), cs = __builtin_amdgcn_cosf(rv);
        o1[i] = x1[i] * cs - x2[i] * sn;
        o2[i] = x2[i] * cs + x1[i] * sn;
      }
      *reinterpret_cast<uint4*>(dst + r * 72) = pack8(o1);
      *reinterpret_cast<uint4*>(dst + r * 72 + 8) = pack8(o2);
    }
  }
}
DEVI void stage_plain(u16* dst, const u16* src, int nrows, int tid) {
  for (int id = tid; id < nrows * 8; id += 256) {
    int r = id >> 3, ch = id & 7;
    *reinterpret_cast<uint4*>(dst + r * 72 + ch * 8) = *reinterpret_cast<const uint4*>(src + (size_t)r * DIN + ch * 8);
  }
}
DEVI void stage_vt(u16* dst, const u16* src, int tid) {
  for (int id = tid; id < 64 * 8; id += 256) {
    int key = id & 63, ch = id >> 6;
    uint4 v = *reinterpret_cast<const uint4*>(src + (size_t)key * DIN + ch * 8);
    u16* d = dst + (ch * 8) * 72 + key;
    d[0 * 72] = (u16)(v.x & 0xffff); d[1 * 72] = (u16)(v.x >> 16);
    d[2 * 72] = (u16)(v.y & 0xffff); d[3 * 72] = (u16)(v.y >> 16);
    d[4 * 72] = (u16)(v.z & 0xffff); d[5 * 72] = (u16)(v.z >> 16);
    d[6 * 72] = (u16)(v.w & 0xffff); d[7 * 72] = (u16)(v.w >> 16);
  }
}

__device__ void phase_win(const Params& p, int g, int layer, char* smem) {
  int nseq, tps, seq0; ginfo(g, nseq, tps, seq0);
  const int ntiles = nseq * tps;
  u16* Qs = (u16*)smem;
  u16* Ks = Qs + 128 * 72;
  u16* Vt = Ks + 64 * 72;
  u16* Ps = Vt + 64 * 72;
  const int tid = otid(), lane = tid & 63, wid = tid >> 6, fr = lane & 15, fq = lane >> 4;
  const float C2 = 0.125f * 1.4426950408889634f;
  const u16* u = (const u16*)(p.ws + OFF_U);
  u16* ymix = (u16*)(p.ws + OFF_YMIX);
  for (int item = (obid() + gridDim.x - 64) % gridDim.x; item < ntiles * 8; item += gridDim.x) {
    const int T = item >> 3, qh = item & 7, kvh = qh >> 2;
    const int sl = T / tps, c = T - sl * tps, Ts0 = sl * tps;
    const int qpos0 = (c == 0) ? 0 : 16 + (c - 1) * 128;
    u32x4 pk[2], pv[2];
    kv_prefetch(pk, pv, u + (size_t)Ts0 * 128 * DIN + C_WK + kvh * 64, u + (size_t)Ts0 * 128 * DIN + C_WV + kvh * 64, tid);
    stage_plain(Qs, u + (size_t)T * 128 * DIN + C_WQ + qh * 64, 128, tid);
    float mrow[2][4], lrow[2][4];
    f32x4 o[2][4];
#pragma unroll
    for (int m = 0; m < 2; ++m) {
#pragma unroll
      for (int j = 0; j < 4; ++j) { mrow[m][j] = -1e30f; lrow[m][j] = 0.f; }
#pragma unroll
      for (int n = 0; n < 4; ++n) o[m][n] = f32x4{0.f, 0.f, 0.f, 0.f};
    }
    int kb = 0;
    while (kb < 7) {
      int kt = 0, half = 0;
      const bool meta = (kb == 0);
      if (!meta) { kt = c - 1 + ((kb - 1) >> 1); half = (kb - 1) & 1; }
      const int kpos0 = (kt == 0) ? 0 : 16 + (kt - 1) * 128 + half * 64;
      kv_commit(pk, pv, Ks, Vt, tid);
      __syncthreads();
      int nkb = kb + 1;
      while (nkb < 7) {
        int kt2 = c - 1 + ((nkb - 1) >> 1);
        if (kt2 >= 1 && kt2 < tps) break;
        ++nkb;
      }
      if (nkb < 7) {
        const int kt2 = c - 1 + ((nkb - 1) >> 1), half2 = (nkb - 1) & 1;
        const size_t krow2 = (size_t)(Ts0 + kt2) * 128 + half2 * 64;
        kv_prefetch(pk, pv, u + krow2 * DIN + C_WK + kvh * 64, u + krow2 * DIN + C_WV + kvh * 64, tid);
      }
      f32x4 s[2][4];
#pragma unroll
      for (int m = 0; m < 2; ++m)
#pragma unroll
        for (int n = 0; n < 4; ++n) s[m][n] = f32x4{0.f, 0.f, 0.f, 0.f};
      wave_mma<2, 4, 2>(s, Qs + (wid * 32) * 72, 72, 16 * 72, Ks, 72, 16 * 72, lane);
#pragma unroll
      for (int m = 0; m < 2; ++m)
#pragma unroll
        for (int j = 0; j < 4; ++j) {
          const int qrow = wid * 32 + 16 * m + fq * 4 + j;
          const int dbase = qpos0 + qrow - kpos0 - fr + 128;
          float mx = mrow[m][j];
#pragma unroll
          for (int n = 0; n < 4; ++n) {
            bool ok = meta ? (n == 0) : ((unsigned)(dbase - 16 * n) <= 256u);
            float v = ok ? s[m][n][j] : -1e30f;
            s[m][n][j] = v;
            mx = fmaxf(mx, v);
          }
          mx = red16_max(mx);
          const float mxc = mx * C2;
          float alpha = __builtin_amdgcn_exp2f(mrow[m][j] * C2 - mxc);
          float rsum = 0.f;
#pragma unroll
          for (int n = 0; n < 4; ++n) {
            float pv = __builtin_amdgcn_exp2f(s[m][n][j] * C2 - mxc);
            rsum += pv;
            Ps[(wid * 32 + 16 * m + fq * 4 + j) * 72 + 16 * n + fr] = f2bf(pv);
          }
          rsum = red16_sum(rsum);
          lrow[m][j] = lrow[m][j] * alpha + rsum;
          mrow[m][j] = mx;
#pragma unroll
          for (int n = 0; n < 4; ++n) o[m][n][j] *= alpha;
        }
      __syncthreads();
      wave_mma<2, 4, 2>(o, Ps + (wid * 32) * 72, 72, 16 * 72, Vt, 72, 16 * 72, lane);
      __syncthreads();
      kb = nkb;
    }
    const float sk = p.sink[layer * 8 + qh];
#pragma unroll
    for (int m = 0; m < 2; ++m)
#pragma unroll
      for (int j = 0; j < 4; ++j) {
        const float ms = mrow[m][j] * 0.125f;
        float mx = fmaxf(ms, sk);
        float a = __expf(ms - mx);
        float l = lrow[m][j] * a + __expf(sk - mx);
        float inv = a / l;
        size_t R = (size_t)T * 128 + wid * 32 + 16 * m + fq * 4 + j;
#pragma unroll
        for (int n = 0; n < 4; ++n) ymix[R * DMIX + 1024 + qh * 64 + 16 * n + fr] = f2bf(o[m][n][j] * inv);
      }
  }
}

__device__ void phase_na(const Params& p, int g, int layer, char* smem) {
  int nseq, tps, seq0; ginfo(g, nseq, tps, seq0);
  const int ntiles = nseq * tps;
  const int rows_total = (tps - 1) * 2;
  u16* Qs = (u16*)smem;
  u16* Ks = Qs + 128 * 72;
  u16* Vt = Ks + 64 * 72;
  u16* Ps = Vt + 64 * 72;
  float* rp = (float*)(Ps + 4 * 32 * 40);
  float* mb = rp + 480;
  const int tid = otid(), lane = tid & 63, wid = tid >> 6, fr = lane & 15, fq = lane >> 4;
  const float C2 = 0.125f * 1.4426950408889634f;
  const u16* u = (const u16*)(p.ws + OFF_U);
  u16* ymix = (u16*)(p.ws + OFF_YMIX);
  for (int item = (obid() + gridDim.x - 96) % gridDim.x; item < ntiles * 8; item += gridDim.x) {
    const int T = item >> 3, h = item & 7;
    const int sl = T / tps, c = T - sl * tps, Ts0 = sl * tps;
    u32x4 pk[2], pv[2];
    kv_prefetch(pk, pv, u + (size_t)Ts0 * 128 * DIN + C_NK + h * 64, u + (size_t)Ts0 * 128 * DIN + C_NV + h * 64, tid);
    stage_plain(Qs, u + (size_t)T * 128 * DIN + C_NQ + h * 64, 128, tid);
    for (int i = tid; i < 465; i += 256) rp[i] = 8.f * p.rpb[(size_t)(layer * 8 + h) * 465 + i];
    if (tid < 16) mb[tid] = 8.f * p.mbias[(layer * 8 + h) * 16 + tid];
    const int r0 = (c == 0) ? 0 : 2 * (c - 1);
    int qr[2], rsm[2];
#pragma unroll
    for (int m = 0; m < 2; ++m) {
      qr[m] = (c == 0) ? 0 : r0 + m;
      rsm[m] = min(max(qr[m] - 4, 0), rows_total - 8);
    }
    const int krlo = rsm[0], krhi = rsm[1] + 7;
    const int kc0w = min(max(16 * wid - 8, 0), 32);
    float mrow[2][4], lrow[2][4];
    f32x4 o[2][4];
#pragma unroll
    for (int m = 0; m < 2; ++m) {
#pragma unroll
      for (int j = 0; j < 4; ++j) { mrow[m][j] = -1e30f; lrow[m][j] = 0.f; }
#pragma unroll
      for (int n = 0; n < 4; ++n) o[m][n] = f32x4{0.f, 0.f, 0.f, 0.f};
    }
    for (int kb = -1; kb <= krhi - krlo; ++kb) {
      const bool meta = kb < 0;
      const int kr = krlo + kb;
      kv_commit(pk, pv, Ks, Vt, tid);
      __syncthreads();
      if (kb < krhi - krlo) {
        const int kr2 = kr + 1;
        const size_t krow2 = (size_t)(Ts0 + 1 + (kr2 >> 1)) * 128 + (kr2 & 1) * 64;
        kv_prefetch(pk, pv, u + krow2 * DIN + C_NK + h * 64, u + krow2 * DIN + C_NV + h * 64, tid);
      }
      const int kc0 = meta ? 0 : kc0w;
      f32x4 s[2][2];
#pragma unroll
      for (int m = 0; m < 2; ++m)
#pragma unroll
        for (int n = 0; n < 2; ++n) s[m][n] = f32x4{0.f, 0.f, 0.f, 0.f};
      wave_mma<2, 2, 2>(s, Qs + (16 * wid) * 72, 72, 64 * 72, Ks + kc0 * 72, 72, 16 * 72, lane);
#pragma unroll
      for (int m = 0; m < 2; ++m) {
        const bool rowok = (kr >= rsm[m]) && (kr <= rsm[m] + 7);
        const int rbase = (kr - qr[m] + 7) * 31 + 15;
#pragma unroll
        for (int j = 0; j < 4; ++j) {
          const int qc = (c == 0) ? 0 : 16 * wid + fq * 4 + j;
          const int qcs = min(max(qc - 8, 0), 48);
          const int kcb = kc0 + fr;
          float mx = mrow[m][j];
#pragma unroll
          for (int n = 0; n < 2; ++n) {
            const int kc = kcb + 16 * n;
            float v = -1e30f;
            if (meta) {
              if (n == 0) v = s[m][n][j] + mb[fr];
            } else if (rowok && (unsigned)(kc - qcs) < 16u) {
              v = s[m][n][j] + rp[rbase + kc - qc];
            }
            s[m][n][j] = v;
            mx = fmaxf(mx, v);
          }
          mx = red16_max(mx);
          const float mxc = mx * C2;
          float alpha = __builtin_amdgcn_exp2f(mrow[m][j] * C2 - mxc);
          float rsum = 0.f;
#pragma unroll
          for (int n = 0; n < 2; ++n) {
            float pv = __builtin_amdgcn_exp2f(s[m][n][j] * C2 - mxc);
            rsum += pv;
            Ps[(wid * 32 + 16 * m + fq * 4 + j) * 40 + 16 * n + fr] = f2bf(pv);
          }
          rsum = red16_sum(rsum);
          lrow[m][j] = lrow[m][j] * alpha + rsum;
          mrow[m][j] = mx;
#pragma unroll
          for (int n = 0; n < 4; ++n) o[m][n][j] *= alpha;
        }
      }
      __syncthreads();
      wave_mma<2, 4, 1>(o, Ps + (wid * 32) * 40, 40, 16 * 40, Vt + kc0, 72, 16 * 72, lane);
      __syncthreads();
    }
#pragma unroll
    for (int m = 0; m < 2; ++m)
#pragma unroll
      for (int j = 0; j < 4; ++j) {
        float inv = 1.f / lrow[m][j];
        size_t R = (size_t)T * 128 + m * 64 + 16 * wid + fq * 4 + j;
#pragma unroll
        for (int n = 0; n < 4; ++n) ymix[R * DMIX + 1536 + h * 64 + 16 * n + fr] = f2bf(o[m][n][j] * inv);
      }
  }
}

__device__ void phase_act(const Params& p, int g, int layer) {
  int nseq, tps, seq0; ginfo(g, nseq, tps, seq0);
  const int ntiles = nseq * tps;
  const int L = (tps - 1) * 128 + 16;
  const u16* gb = (const u16*)(p.ws + OFF_U);
  u16* act = (u16*)(p.ws + OFF_ST);
  const float* cw = p.fconv_w + (size_t)layer * 3 * DUP;
  const float* cb = p.fconv_b + (size_t)layer * DUP;
  const int total = ntiles * 8 * 352;
  for (int id = obid() * 256 + otid(); id < total; id += gridDim.x * 256) {
    const int ch = id % 352, ts = id / 352, seg = ts & 7, T = ts >> 3;
    const int sl = T / tps, c = T - sl * tps;
    const int col = ch * 8;
    const size_t Rseq = (size_t)sl * tps * 128;
    u16* orow = act + ((size_t)T * 128 + seg * 16) * DFF + col;
    const int nvalid = (c > 0) ? 16 : (seg == 0 ? 16 : 0);
    if (nvalid == 0) {
      uint4 z = make_uint4(0, 0, 0, 0);
#pragma unroll 4
      for (int r = 0; r < 16; ++r) *reinterpret_cast<uint4*>(orow + (size_t)r * DFF) = z;
      continue;
    }
    const int pos0 = (c == 0) ? 0 : 16 + (c - 1) * 128 + seg * 16;
    float wg[3][8], wu[3][8], bg[8], bu[8];
#pragma unroll
    for (int j = 0; j < 3; ++j) {
      float4 a0 = *reinterpret_cast<const float4*>(cw + j * DUP + col), a1 = *reinterpret_cast<const float4*>(cw + j * DUP + col + 4);
      float4 c0 = *reinterpret_cast<const float4*>(cw + j * DUP + DFF + col), c1 = *reinterpret_cast<const float4*>(cw + j * DUP + DFF + col + 4);
      wg[j][0] = a0.x; wg[j][1] = a0.y; wg[j][2] = a0.z; wg[j][3] = a0.w; wg[j][4] = a1.x; wg[j][5] = a1.y; wg[j][6] = a1.z; wg[j][7] = a1.w;
      wu[j][0] = c0.x; wu[j][1] = c0.y; wu[j][2] = c0.z; wu[j][3] = c0.w; wu[j][4] = c1.x; wu[j][5] = c1.y; wu[j][6] = c1.z; wu[j][7] = c1.w;
    }
    {
      float4 a0 = *reinterpret_cast<const float4*>(cb + col), a1 = *reinterpret_cast<const float4*>(cb + col + 4);
      float4 c0 = *reinterpret_cast<const float4*>(cb + DFF + col), c1 = *reinterpret_cast<const float4*>(cb + DFF + col + 4);
      bg[0] = a0.x; bg[1] = a0.y; bg[2] = a0.z; bg[3] = a0.w; bg[4] = a1.x; bg[5] = a1.y; bg[6] = a1.z; bg[7] = a1.w;
      bu[0] = c0.x; bu[1] = c0.y; bu[2] = c0.z; bu[3] = c0.w; bu[4] = c1.x; bu[5] = c1.y; bu[6] = c1.z; bu[7] = c1.w;
    }
    float xg[3][8], xu[3][8];
    auto ldrow = [&](int pp, float* dg, float* du) {
      const bool ok = (pp >= 0) && (pp < L);
      const int pc = min(max(pp, 0), L - 1);
      const int prow = (pc < 16) ? pc : 112 + pc;
      const u16* sp = gb + (Rseq + prow) * DUP + col;
      uint4 v0 = *reinterpret_cast<const uint4*>(sp), v1 = *reinterpret_cast<const uint4*>(sp + DFF);
      if (!ok) { v0 = make_uint4(0, 0, 0, 0); v1 = make_uint4(0, 0, 0, 0); }
      unpack8(v0, dg); unpack8(v1, du);
    };
    ldrow(pos0 - 1, xg[0], xu[0]); ldrow(pos0, xg[1], xu[1]);
#pragma unroll
    for (int r = 0; r < 16; ++r) {
      ldrow(pos0 + r + 1, xg[(r + 2) % 3], xu[(r + 2) % 3]);
      float res[8];
#pragma unroll
      for (int i = 0; i < 8; ++i) {
        float ga = bg[i], up = bu[i];
#pragma unroll
        for (int j = 0; j < 3; ++j) { ga += xg[(r + j) % 3][i] * wg[j][i]; up += xu[(r + j) % 3][i] * wu[j][i]; }
        float yv = 0.7978845608028654f * (ga + 0.044715f * ga * ga * ga);
        float th = 1.f - 2.f * __builtin_amdgcn_rcpf(__expf(2.f * yv) + 1.f);
        res[i] = 0.5f * ga * (1.f + th) * up;
      }
      *reinterpret_cast<uint4*>(orow + (size_t)r * DFF) = pack8(res);
    }
  }
}

#define XB_TMO      128
#define XB_XCNT(j)  (256  + 64 * (j))
#define XB_XSUB(j)  (1280 + 64 * (j))
#define XB_XGEN(j)  (2304 + 64 * (j))
#define XB_TOP      3328
#define XB_TOPGEN   3392
#define XCD_BAR_WORDS 3456
#define XB_SPIN_CAP (1u << 22)
#define LAS __attribute__((address_space(3)))
DEVI unsigned xb_ld(unsigned* p) { return __hip_atomic_load(p, __ATOMIC_RELAXED, __HIP_MEMORY_SCOPE_AGENT); }
DEVI unsigned xb_add(unsigned* p, unsigned v) { return __hip_atomic_fetch_add(p, v, __ATOMIC_RELAXED, __HIP_MEMORY_SCOPE_AGENT); }
DEVI unsigned xb_xcc_id() { return (unsigned)__builtin_amdgcn_s_getreg((3 << 11) | 20) & 0xFu; }
#define XB_SPIN(cond, bar) do { unsigned _sp = 0; while (cond) { __builtin_amdgcn_s_sleep(1); \
    if ((++_sp & 255u) == 0u) { if (xb_ld(&(bar)[XB_TMO])) break; if (_sp > XB_SPIN_CAP) { atomicAdd(&(bar)[XB_TMO], 1u); break; } } } } while (0)
struct XcdBarrier { unsigned* bar; unsigned x; volatile LAS unsigned* st; };
DEVI XcdBarrier xcd_barrier_post(unsigned* bar, volatile LAS unsigned* st) {
  XcdBarrier b; b.bar = bar; b.x = xb_xcc_id(); b.st = st;
  if (threadIdx.x == 0) (void)xb_add(&bar[XB_XCNT(b.x)], 1u);
  return b;
}
DEVI void xcd_barrier_complete(unsigned* bar, unsigned x, unsigned& nloc, unsigned& nx) {
  const unsigned G = gridDim.x * gridDim.y * gridDim.z;
  unsigned sum, cnt, mine, sp = 0u;
  for (;;) {
    sum = 0u; cnt = 0u; mine = 0u;
#pragma unroll
    for (unsigned j = 0; j < 16; ++j) { const unsigned c = xb_ld(&bar[XB_XCNT(j)]); sum += c; cnt += (c > 0u) ? 1u : 0u; mine = (j == x) ? c : mine; }
    if (sum == G) break;
    __builtin_amdgcn_s_sleep(1);
    if ((++sp & 255u) == 0u) { if (xb_ld(&bar[XB_TMO])) break; if (sp > XB_SPIN_CAP) { atomicAdd(&bar[XB_TMO], 1u); break; } }
  }
  nloc = mine > 0u ? mine : 1u; nx = cnt > 0u ? cnt : 1u;
}
DEVI void xcd_barrier(const XcdBarrier& b) {
  asm volatile("s_waitcnt vmcnt(0)" ::: "memory");
  __syncthreads();
  if (threadIdx.x == 0) {
    unsigned* bar = b.bar;
    __builtin_amdgcn_s_waitcnt(0);
    unsigned nloc = b.st[0], nx = b.st[1];
    if (nloc == 0u) { xcd_barrier_complete(bar, b.x, nloc, nx); b.st[0] = nloc; b.st[1] = nx; }
    const unsigned old = xb_add(&bar[XB_XSUB(b.x)], 1u);
    const unsigned gen = old / nloc;
    if (old + 1u == (gen + 1u) * nloc) {
      __builtin_amdgcn_fence(__ATOMIC_RELEASE, "agent");
      asm volatile("s_waitcnt vmcnt(0)" ::: "memory");
      const unsigned og = xb_add(&bar[XB_TOP], 1u);
      const unsigned tg = og / nx;
      if (og + 1u == (tg + 1u) * nx) xb_add(&bar[XB_TOPGEN], 1u);
      else XB_SPIN(xb_ld(&bar[XB_TOPGEN]) == tg, bar);
      __builtin_amdgcn_fence(__ATOMIC_ACQUIRE, "agent");
      xb_add(&bar[XB_XGEN(b.x)], 1u);
      asm volatile("s_waitcnt vmcnt(0)" ::: "memory");
    } else {
      XB_SPIN(xb_ld(&bar[XB_XGEN(b.x)]) == gen, bar);
      __builtin_amdgcn_fence(__ATOMIC_ACQUIRE, "agent");
      asm volatile("s_waitcnt vmcnt(0)" ::: "memory");
    }
  }
  __syncthreads();
}

#ifndef REP_GEMM
#define REP_GEMM 1
#endif
#ifndef REP_SSD
#define REP_SSD 1
#endif
#ifndef REP_WIN
#define REP_WIN 1
#endif
#ifndef REP_NA
#define REP_NA 1
#endif
#ifndef REP_EW
#define REP_EW 1
#endif
__global__ void __launch_bounds__(256, 2) mega(Params p) {
  extern __shared__ __attribute__((aligned(16))) char smem[];
  cg::grid_group grid = cg::this_grid();
  __shared__ uint4 xb_words;
  if (threadIdx.x == 0) xb_words = make_uint4(0u, 0u, 0u, 0u);
  __syncthreads();
  XcdBarrier xb = xcd_barrier_post((unsigned*)(p.ws + OFF_BAR), (volatile LAS unsigned*)&xb_words);
#pragma unroll 1
  for (int step = 0; step < 93; ++step) {
    int ph = 100, g = 0, layer = 0;
    if (step > 0) {
      int s = step - 1;
      g = s / 23;
      int r = s - g * 23;
      if (r == 0) ph = 101;
      else { layer = (r - 1) / 11; ph = (r - 1) - layer * 11; }
    }
    int nseq, tps, seq0; ginfo(g, nseq, tps, seq0);
    const int ntm = nseq * (tps - 1), tpr = tps - 1;
    if (step == 1) continue;
    if (ph == 100) {
      phase_prep(p, smem);
      phase_rowupd(p, 0, 0, (const u16*)(p.ws + OFF_U), nullptr);
    } else if (ph == 101 || ph == 6 || ph == 10) {
      const float* w = (ph == 6) ? p.n_mix_post + layer * DM : p.n_ffn_post + layer * DM;
      const int mode = (ph == 101) ? 0 : ((ph == 10 && layer == 1) ? 2 : 1);
      phase_rowupd(p, g, mode, (const u16*)(p.ws + OFF_U), w);
    } else if (ph == 0 || ph == 7) {
      const u16* Bt = (ph == 0) ? (const u16*)(p.ws + OFF_WIN) + (size_t)layer * DINP * DM
                                : (const u16*)(p.ws + OFF_WUP) + (size_t)layer * DUP * DM;
      const int nv = (ph == 0) ? DIN : DUP;
      for (int rep = 0; rep < REP_GEMM; ++rep) {
        phase_gemm_w<0>((const u16*)(p.ws + OFF_HB), DM, Bt, DM, ntm, 20, (ph == 0) ? DIN : 5120,
                        (const float*)(p.ws + OFF_RS), (u16*)(p.ws + OFF_U), nv, tpr, nullptr, smem);
        if (ph == 7)
          phase_gemm<0>((const u16*)(p.ws + OFF_HB), DM, Bt + (size_t)5120 * DM, DM, ntm, 4, 512,
                        (const float*)(p.ws + OFF_RS), (u16*)(p.ws + OFF_U) + 5120, nv, tpr, nullptr, smem);
        phase_gemm_meta<0>((const u16*)(p.ws + OFF_HB), DM, Bt, DM, nseq, tps, nv / 16, (const float*)(p.ws + OFF_RS),
                           (u16*)(p.ws + OFF_U), nv, nullptr);
      }
    } else if (ph == 5 || ph == 9) {
      const u16* A = (ph == 5) ? (const u16*)(p.ws + OFF_YMIX) : (const u16*)(p.ws + OFF_ST);
      const u16* Bt = (ph == 5) ? (const u16*)(p.ws + OFF_WOUT) + (size_t)layer * DM * DMIX
                                : (const u16*)(p.ws + OFF_WDN) + (size_t)layer * DM * DFF;
      const int K = (ph == 5) ? DMIX : DFF;
      const float* ssqk = (ph == 5) ? (const float*)(p.ws + OFF_SSQA) : nullptr;
      for (int rep = 0; rep < REP_GEMM; ++rep) {
        phase_gemm_w<1>(A, K, Bt, K, ntm, 4, DM, nullptr, (u16*)(p.ws + OFF_U), DM, tpr, ssqk, smem);
        phase_gemm_meta<1>(A, K, Bt, K, nseq, tps, DM / 16, nullptr, (u16*)(p.ws + OFF_U), DM, ssqk);
      }
    } else if (ph == 1) {
      for (int rep = 0; rep < REP_EW; ++rep) phase_conv(p, g, layer);
      phase_rope(p, g);
    } else if (ph == 2) {
      for (int rep = 0; rep < REP_SSD; ++rep) phase_ssdA(p, g, layer, smem);
    } else if (ph == 3) {
      phase_scan(p, g);
    } else if (ph == 4) {
      for (int rep = 0; rep < REP_SSD; ++rep) phase_ssdC(p, g, layer, smem);
      for (int rep = 0; rep < REP_WIN; ++rep) phase_win(p, g, layer, smem);
      for (int rep = 0; rep < REP_NA; ++rep) phase_na(p, g, layer, smem);
    } else if (ph == 8) {
      for (int rep = 0; rep < REP_EW; ++rep) phase_act(p, g, layer);
    }
    if (step == 0) grid.sync();
    else if (step < 92) xcd_barrier(xb);
  }
}

extern "C" void kernel_launch(void* const* d_in, const int* in_sizes, int n_in, void* d_out, int out_size,
                              void* d_ws, size_t ws_size, hipStream_t stream) {
  static int grid_blocks = 0;
  if (!grid_blocks) {
    int dev = 0, cus = 0, per_cu = 0;
    hipGetDevice(&dev);
    hipDeviceGetAttribute(&cus, hipDeviceAttributeMultiprocessorCount, dev);
    hipFuncSetAttribute((const void*)mega, hipFuncAttributeMaxDynamicSharedMemorySize, LDS_BYTES);
    hipOccupancyMaxActiveBlocksPerMultiprocessor(&per_cu, mega, 256, LDS_BYTES);
    if (per_cu > 2) per_cu = 2;
    if (per_cu < 1) per_cu = 1;
    grid_blocks = cus * per_cu;
  }
  Params p{};
  const float* const* in = (const float* const*)d_in;
  p.xp = in[0]; p.xs = in[1]; p.meta = in[2]; p.n_mix_pre = in[3]; p.n_mix_post = in[4]; p.w_in = in[5];
  p.conv_w = in[6]; p.conv_b = in[7]; p.dt_bias = in[8]; p.a_log = in[9]; p.ssd_d = in[10]; p.ssd_nw = in[11];
  p.sink = in[12]; p.rpb = in[13]; p.mbias = in[14]; p.w_out = in[15]; p.n_ffn_pre = in[16]; p.n_ffn_post = in[17];
  p.w_up = in[18]; p.fconv_w = in[19]; p.fconv_b = in[20]; p.w_down = in[21];
  p.out = (float*)d_out; p.ws = (char*)d_ws;
  if (ws_size < WS_NEED) fprintf(stderr, "workspace too small: %zu < %zu\n", ws_size, (size_t)WS_NEED);
  hipMemsetAsync((char*)d_ws + OFF_BAR, 0, XCD_BAR_WORDS * 4, stream);
  void* args[] = {&p};
  hipError_t e = hipLaunchCooperativeKernel((void*)mega, dim3(grid_blocks), dim3(256), args, LDS_BYTES, stream);
  if (e != hipSuccess) fprintf(stderr, "cooperative launch failed: %s (grid %d)\n", hipGetErrorString(e), grid_blocks);
}
```
